# Optimizing an MI355X kernel written in HIP

```python
import math
import jax, jax.numpy as jnp
from jax import lax
import numpy as np

D_MODEL = 1024
BATCH = 2
SEQ = 16384
DEPTH = 1
DEC_BATCH = 8
DEC_SEQ = 4096
PAST_LEN = 128

H_D = 4
DH = 64
DV_D = 2 * DH
W_D = H_D * DV_D
H_G = 4
DK_G = 64
DV_G = 128
W_G = H_G * DV_G
GATE_RANK = 16
GATE_TAU = 16.0
CHUNK = 64
Q_BLOCK = 128
D_FF = 4 * D_MODEL
EPS = 1e-5
ALPHA = (2.0 * DEPTH) ** 0.25
BETA = (8.0 * DEPTH) ** -0.25

O_DQ = 0
O_DK = O_DQ + H_D * 2 * DH
O_DV = O_DK + H_D * 2 * DH
O_GQ = O_DV + W_D
O_GK = O_GQ + H_G * DK_G
O_GV = O_GK + H_G * DK_G
O_GR = O_GV + W_G
O_LRF = O_GR + W_G
O_LRB = O_LRF + GATE_RANK
D_IN = O_LRB + GATE_RANK

kernel_name = "hybrid_diffattn_gla_encoder"


def layer_norm(x, g, b):
    xf = x.astype(jnp.float32)
    mu = jnp.mean(xf, axis=-1, keepdims=True)
    xc = xf - mu
    var = jnp.mean(xc * xc, axis=-1, keepdims=True)
    return (xc * lax.rsqrt(var + EPS) * g.astype(jnp.float32) + b.astype(jnp.float32)).astype(x.dtype)


def rms_norm(x, g):
    xf = x.astype(jnp.float32)
    return xf * lax.rsqrt(jnp.mean(xf * xf, axis=-1, keepdims=True) + EPS) * g.astype(jnp.float32)


def alibi_slopes(n_heads):
    return jnp.asarray(np.array([2.0 ** (-8.0 * (h + 1) / n_heads) for h in range(n_heads)], dtype=np.float32))


def diff_attention(q, k, v, lam):
    B, S = q.shape[0], q.shape[1]
    nblk = S // Q_BLOCK
    slopes = alibi_slopes(H_D)
    scale = DH ** -0.5
    qb = q.reshape(B, nblk, Q_BLOCK, H_D, 2, DH).transpose(1, 0, 2, 3, 4, 5)
    starts = jnp.arange(nblk, dtype=jnp.int32) * Q_BLOCK
    pos_k = jnp.arange(S, dtype=jnp.int32)

    def block(args):
        q_blk, start = args
        s = jnp.einsum('bqhcd,bkhcd->bhcqk', q_blk, k) * scale
        pos_q = start + jnp.arange(Q_BLOCK, dtype=jnp.int32)
        dist = jnp.abs(pos_q[:, None] - pos_k[None, :]).astype(jnp.float32)
        s = s - slopes[None, :, None, None, None] * dist[None, None, None]
        p = jax.nn.softmax(s, axis=-1)
        w = p[:, :, 0] - lam * p[:, :, 1]
        return jnp.einsum('bhqk,bkhe->bqhe', w, v)

    out = lax.map(block, (qb, starts))
    return out.transpose(1, 0, 2, 3, 4).reshape(B, S, H_D, DV_D)


def gla_direction(q, k, v, log_a):
    B, S, H, dk = q.shape
    dv = v.shape[-1]
    n = S // CHUNK

    def to_chunks(t):
        return t.reshape(B, n, CHUNK, H, t.shape[-1]).transpose(1, 0, 3, 2, 4)

    qc, kc, vc, ac = to_chunks(q), to_chunks(k), to_chunks(v), to_chunks(log_a)
    bc = jnp.cumsum(ac, axis=3)
    mask = jnp.tril(jnp.ones((CHUNK, CHUNK), dtype=bool))

    def step(state, inp):
        q_, k_, v_, b_ = inp
        inter = jnp.einsum('bhcd,bhde->bhce', q_ * jnp.exp(b_), state)
        diff = b_[:, :, :, None, :] - b_[:, :, None, :, :]
        decay = jnp.exp(jnp.where(mask[None, None, :, :, None], diff, -jnp.inf))
        attn = jnp.einsum('bhijd,bhjd->bhij', q_[:, :, :, None, :] * decay, k_)
        intra = jnp.einsum('bhij,bhje->bhie', attn, v_)
        b_last = b_[:, :, -1:, :]
        new_state = jnp.exp(b_last[:, :, 0, :])[..., None] * state + jnp.einsum(
            'bhjd,bhje->bhde', k_ * jnp.exp(b_last - b_), v_)
        return new_state, inter + intra

    s0 = jnp.zeros((B, H, dk, dv), dtype=jnp.float32)
    _, out = lax.scan(step, s0, (qc, kc, vc, bc))
    return out.transpose(1, 0, 3, 2, 4).reshape(B, S, H, dv)


def encoder_layer(x, layer_idx, w_in, w_o, lam_q1, lam_k1, lam_q2, lam_k2, diff_norm_g,
                  gla_wa2_f, gla_ba_f, gla_wa2_b, gla_ba_b, gla_norm_g,
                  ln1_g, ln1_b, w_ff1, w_ff2, ln2_g, ln2_b):
    B, S, _ = x.shape
    f32 = jnp.float32
    h = (x @ w_in).astype(f32)

    dq = h[..., O_DQ:O_DK].reshape(B, S, H_D, 2, DH)
    dk = h[..., O_DK:O_DV].reshape(B, S, H_D, 2, DH)
    dvv = h[..., O_DV:O_GQ].reshape(B, S, H_D, DV_D)
    lam_init = 0.8 - 0.6 * math.exp(-0.3 * layer_idx)
    lam = (jnp.exp(jnp.sum(lam_q1.astype(f32) * lam_k1.astype(f32)))
           - jnp.exp(jnp.sum(lam_q2.astype(f32) * lam_k2.astype(f32))) + lam_init)
    od = diff_attention(dq, dk, dvv, lam)
    od = rms_norm(od, diff_norm_g) * (1.0 - lam_init)

    gq = h[..., O_GQ:O_GK].reshape(B, S, H_G, DK_G) * (DK_G ** -0.5)
    gk = h[..., O_GK:O_GV].reshape(B, S, H_G, DK_G)
    gv = h[..., O_GV:O_GR].reshape(B, S, H_G, DV_G)
    gr = h[..., O_GR:O_LRF]
    z_f = h[..., O_LRF:O_LRB] @ gla_wa2_f.astype(f32) + gla_ba_f.astype(f32)
    z_b = h[..., O_LRB:D_IN] @ gla_wa2_b.astype(f32) + gla_ba_b.astype(f32)
    la_f = (jax.nn.log_sigmoid(z_f) / GATE_TAU).reshape(B, S, H_G, DK_G)
    la_b = (jax.nn.log_sigmoid(z_b) / GATE_TAU).reshape(B, S, H_G, DK_G)
    o_f = gla_direction(gq, gk, gv, la_f)
    flip = lambda t: jnp.flip(t, axis=1)
    o_b = flip(gla_direction(flip(gq), flip(gk), flip(gv), flip(la_b)))
    og = rms_norm(o_f + o_b, gla_norm_g).reshape(B, S, W_G)
    og = jax.nn.silu(gr) * og

    mix = jnp.concatenate([od.reshape(B, S, W_D), og], axis=-1).astype(x.dtype) @ w_o
    x = layer_norm(ALPHA * x + mix, ln1_g, ln1_b)

    hid = jnp.square(jax.nn.relu(x @ w_ff1))
    x = layer_norm(ALPHA * x + hid @ w_ff2, ln2_g, ln2_b)
    return x


def setup_inputs(seed: int = 0) -> dict:
    key = jax.random.key(seed)
    ks = jax.random.split(key, 20)
    f32 = jnp.float32
    nrm = lambda k, shape, s: jax.random.normal(k, shape, dtype=f32) * s
    x_prompt = jax.random.normal(ks[0], (BATCH, SEQ, D_MODEL), dtype=f32)
    x_sample = jax.random.normal(ks[1], (DEC_BATCH, DEC_SEQ, D_MODEL), dtype=f32)
    w_in = nrm(ks[2], (DEPTH, D_MODEL, D_IN), D_MODEL ** -0.5)
    col_scale = np.ones((D_IN,), dtype=np.float32)
    col_scale[O_DV:O_GQ] = BETA
    col_scale[O_GV:O_GR] = BETA
    w_in = w_in * jnp.asarray(col_scale)
    w_o = nrm(ks[3], (DEPTH, W_D + W_G, D_MODEL), (W_D + W_G) ** -0.5 * BETA)
    lam_q1 = nrm(ks[4], (DEPTH, DH), 0.1)
    lam_k1 = nrm(ks[5], (DEPTH, DH), 0.1)
    lam_q2 = nrm(ks[6], (DEPTH, DH), 0.1)
    lam_k2 = nrm(ks[7], (DEPTH, DH), 0.1)
    diff_norm_g = 1.0 + nrm(ks[8], (DEPTH, DV_D), 0.02)
    gla_wa2_f = nrm(ks[9], (DEPTH, GATE_RANK, H_G * DK_G), GATE_RANK ** -0.5)
    gla_ba_f = nrm(ks[10], (DEPTH, H_G * DK_G), 0.01)
    gla_wa2_b = nrm(ks[11], (DEPTH, GATE_RANK, H_G * DK_G), GATE_RANK ** -0.5)
    gla_ba_b = nrm(ks[12], (DEPTH, H_G * DK_G), 0.01)
    gla_norm_g = 1.0 + nrm(ks[13], (DEPTH, DV_G), 0.02)
    ln1_g = 1.0 + nrm(ks[14], (DEPTH, D_MODEL), 0.02)
    ln1_b = nrm(ks[15], (DEPTH, D_MODEL), 0.02)
    w_ff1 = nrm(ks[16], (DEPTH, D_MODEL, D_FF), D_MODEL ** -0.5 * BETA)
    w_ff2 = nrm(ks[17], (DEPTH, D_FF, D_MODEL), D_FF ** -0.5 * BETA)
    ln2_g = 1.0 + nrm(ks[18], (DEPTH, D_MODEL), 0.02)
    ln2_b = nrm(ks[19], (DEPTH, D_MODEL), 0.02)
    return {"x_prompt": x_prompt, "x_sample": x_sample, "w_in": w_in, "w_o": w_o,
            "lam_q1": lam_q1, "lam_k1": lam_k1, "lam_q2": lam_q2, "lam_k2": lam_k2,
            "diff_norm_g": diff_norm_g, "gla_wa2_f": gla_wa2_f, "gla_ba_f": gla_ba_f,
            "gla_wa2_b": gla_wa2_b, "gla_ba_b": gla_ba_b, "gla_norm_g": gla_norm_g,
            "ln1_g": ln1_g, "ln1_b": ln1_b, "w_ff1": w_ff1, "w_ff2": w_ff2,
            "ln2_g": ln2_g, "ln2_b": ln2_b}


def reference(x_prompt, x_sample, w_in, w_o, lam_q1, lam_k1, lam_q2, lam_k2, diff_norm_g,
              gla_wa2_f, gla_ba_f, gla_wa2_b, gla_ba_b, gla_norm_g,
              ln1_g, ln1_b, w_ff1, w_ff2, ln2_g, ln2_b):
    def run(x):
        for l in range(DEPTH):
            x = encoder_layer(x, l, w_in[l], w_o[l], lam_q1[l], lam_k1[l], lam_q2[l], lam_k2[l],
                              diff_norm_g[l], gla_wa2_f[l], gla_ba_f[l], gla_wa2_b[l], gla_ba_b[l],
                              gla_norm_g[l], ln1_g[l], ln1_b[l], w_ff1[l], w_ff2[l], ln2_g[l], ln2_b[l])
        return x

    y_prompt = run(x_prompt)
    y_sample = run(x_sample)
    return (y_prompt, y_sample)
```

```cpp
#include <hip/hip_runtime.h>
#include <hip/hip_cooperative_groups.h>
#include <cstdio>
#include <cstdint>
namespace cg = cooperative_groups;
__device__ __forceinline__ int tid_of(int wave_u) { int t; asm volatile("v_mbcnt_lo_u32_b32 %0, -1, 0\n\tv_mbcnt_hi_u32_b32 %0, -1, %0" : "=v"(t)); return t | (wave_u << 6); }
#define MIXER_STAGE 2
namespace pg8 {
#define PG8_LAS __attribute__((address_space(3)))
typedef unsigned short bf16_t;
typedef short bf16x8 __attribute__((ext_vector_type(8)));
typedef float f32x4 __attribute__((ext_vector_type(4)));
typedef unsigned u32x4 __attribute__((ext_vector_type(4)));
constexpr int BM = 256, BK = 64, HALF = 128, HTB = HALF * BK * 2  , STAGE_BYTES = 8 * HTB, NXCD = 8, WGM = 8;

__host__ __device__ __forceinline__ int lds_byte(int r, int c) { const int st = (r >> 4) * 2 + (c >> 5), rr = r & 15, cc = c & 31, ob = rr * 64 + cc * 2; return st * 1024 + (ob ^ (((ob >> 9) & 1) << 5)); }
__host__ __device__ __forceinline__ void stage_rc(int b, int& R, int& C) { const int st = b / 1024, sb = b % 1024, swz = sb ^ (((sb >> 9) & 1) << 5); R = (st >> 1) * 16 + swz / 64; C = (st & 1) * 32 + (swz % 64) / 2; }
__host__ __device__ __forceinline__ int perm32(int rho) { const int n = rho >> 4, i = rho & 15; return 8 * (i >> 2) + 4 * n + (i & 3); }

struct Unit { int pm, pn; };
struct Gemm { const bf16_t* A; const bf16_t* Bt; int M, N, K; };

struct StaticOrder {
    int nM, nN, nwg, G, c;
    __host__ __device__ void init(int M, int N, int G_, int c_) { nM = M / BM; nN = N / BM; nwg = nM * nN; G = G_; c = c_; }
    __host__ __device__ bool next(int i, Unit& u) const {
        const long L = (long)i * G + c; if (L >= nwg) return false;
        int wgid = (int)L; { const int q = nwg / NXCD, r = nwg % NXCD, xcd = wgid % NXCD, off = wgid / NXCD; wgid = (xcd < r ? xcd * (q + 1) : r * (q + 1) + (xcd - r) * q) + off; }
        const int nig = WGM * nN, gid = wgid / nig, fm = gid * WGM, gsz = (nM - fm) < WGM ? (nM - fm) : WGM;
        u.pm = fm + ((wgid % nig) % gsz); u.pn = (wgid % nig) / gsz; return true;
    }
    __device__ __forceinline__ void a_ready(const Unit&) const {}
    __device__ __forceinline__ void done(const Unit&) const {}
};

__device__ __forceinline__ unsigned cvt_pk_bf16(float lo, float hi) { unsigned r; asm volatile("v_cvt_pk_bf16_f32 %0, %1, %2" : "=v"(r) : "v"(lo), "v"(hi)); return r; }
constexpr int M_TOK = 65536, NPROMPT = 32768, DMODEL = 1024;
struct EpiH {
    static constexpr bool PERM = true, AFTER_DRAIN = false;
    bf16_t* O; int ldc; int nvalid; float c1; bf16_t* KD; bf16_t* VD;
    __device__ __forceinline__ void operator()(const f32x4 (&acc)[2][2][4][2], const Unit& u, int wr, int wc, int fr, int fq) const {
        const int row0 = u.pm * BM + wr * 64 + fr;
        const int col0 = u.pn * BM + wc * 32 + 8 * fq;
        const float sc = (u.pn < 2) ? c1 : (u.pn == 6 ? 0.125f : 1.0f);
        const bool dense = (u.pn >= 2) && (u.pn < 6);
        bf16_t* db = (u.pn < 4) ? KD : VD;
        const int crel = col0 - ((u.pn < 4) ? 512 : 1024);
#pragma unroll
        for (int ai = 0; ai < 2; ++ai)
#pragma unroll
            for (int m = 0; m < 4; ++m) { const int row = row0 + ai * HALF + m * 16; bf16_t* rowp = O + (size_t)row * ldc + col0;
#pragma unroll
                for (int bj = 0; bj < 2; ++bj) { if (col0 + bj * HALF < nvalid) { const f32x4 v0 = acc[ai][bj][m][0] * sc, v1 = acc[ai][bj][m][1] * sc;
                    u32x4 w; w.x = cvt_pk_bf16(v0[0], v0[1]); w.y = cvt_pk_bf16(v0[2], v0[3]); w.z = cvt_pk_bf16(v1[0], v1[1]); w.w = cvt_pk_bf16(v1[2], v1[3]);
                    if (dense) { const int cr = crel + bj * HALF; *(u32x4*)(db + ((size_t)(cr >> 7) * M_TOK + row) * 128 + (cr & 127)) = w; }
                    else *(u32x4*)(rowp + bj * HALF) = w; } } }
    }
};
struct EpiHid {
    static constexpr bool PERM = true, AFTER_DRAIN = false;
    bf16_t* O; int ldc;
    __device__ __forceinline__ void operator()(const f32x4 (&acc)[2][2][4][2], const Unit& u, int wr, int wc, int fr, int fq) const {
        const int row0 = u.pm * BM + wr * 64 + fr;
        const int col0 = u.pn * BM + wc * 32 + 8 * fq;
#pragma unroll
        for (int ai = 0; ai < 2; ++ai)
#pragma unroll
            for (int m = 0; m < 4; ++m) { bf16_t* rowp = O + (size_t)(row0 + ai * HALF + m * 16) * ldc + col0;
#pragma unroll
                for (int bj = 0; bj < 2; ++bj) { f32x4 v0 = acc[ai][bj][m][0], v1 = acc[ai][bj][m][1];
#pragma unroll
                    for (int e = 0; e < 4; ++e) { const float a = fmaxf(v0[e], 0.f), b = fmaxf(v1[e], 0.f); v0[e] = a * a; v1[e] = b * b; }
                    u32x4 w; w.x = cvt_pk_bf16(v0[0], v0[1]); w.y = cvt_pk_bf16(v0[2], v0[3]); w.z = cvt_pk_bf16(v1[0], v1[1]); w.w = cvt_pk_bf16(v1[2], v1[3]);
                    *(u32x4*)(rowp + bj * HALF) = w; } }
    }
};
struct EpiRes {
    static constexpr bool PERM = false, AFTER_DRAIN = false;
    const float* xp; const float* xs; float* out; float alpha;
    __device__ __forceinline__ void operator()(const f32x4 (&acc)[2][2][4][2], const Unit& u, int wr, int wc, int fr, int fq) const {
        const int col0 = u.pn * BM + wc * 32 + 4 * fq;
#pragma unroll
        for (int ai = 0; ai < 2; ++ai)
#pragma unroll
            for (int m = 0; m < 4; ++m) { const int row = u.pm * BM + ai * HALF + wr * 64 + m * 16 + fr;
                float* orow = out + (size_t)row * DMODEL;
                const float* xr = xp ? ((row < NPROMPT) ? xp + (size_t)row * DMODEL : xs + (size_t)(row - NPROMPT) * DMODEL) : orow;
#pragma unroll
                for (int bj = 0; bj < 2; ++bj)
#pragma unroll
                    for (int n = 0; n < 2; ++n) { const int c = col0 + bj * HALF + n * 16; const f32x4 xv = *(const f32x4*)(xr + c); *(f32x4*)(orow + c) = xv * alpha + acc[ai][bj][m][n]; } }
    }
};


struct EpiResB {
    static constexpr bool PERM = true, AFTER_DRAIN = false;
    const float* xp; const float* xs; const bf16_t* RB; bf16_t* Y; float alpha;
    __device__ __forceinline__ void operator()(const f32x4 (&acc)[2][2][4][2], const Unit& u, int wr, int wc, int fr, int fq) const {
        const int col0 = u.pn * BM + wc * 32 + 8 * fq;
#pragma unroll
        for (int ai = 0; ai < 2; ++ai)
#pragma unroll
            for (int m = 0; m < 4; ++m) { const int row = u.pm * BM + ai * HALF + wr * 64 + m * 16 + fr;
#pragma unroll
                for (int bj = 0; bj < 2; ++bj) { const int c = col0 + bj * HALF;
                    f32x4 r0, r1;
                    if (xp) { const float* xr = ((row < NPROMPT) ? xp + (size_t)row * DMODEL : xs + (size_t)(row - NPROMPT) * DMODEL) + c; r0 = *(const f32x4*)xr; r1 = *(const f32x4*)(xr + 4); }
                    else { const u32x4 w = *(const u32x4*)(RB + (size_t)row * DMODEL + c);
                        r0 = (f32x4){__uint_as_float(w.x << 16), __uint_as_float(w.x & 0xffff0000u), __uint_as_float(w.y << 16), __uint_as_float(w.y & 0xffff0000u)};
                        r1 = (f32x4){__uint_as_float(w.z << 16), __uint_as_float(w.z & 0xffff0000u), __uint_as_float(w.w << 16), __uint_as_float(w.w & 0xffff0000u)}; }
                    const f32x4 v0 = r0 * alpha + acc[ai][bj][m][0], v1 = r1 * alpha + acc[ai][bj][m][1];
                    u32x4 o; o.x = cvt_pk_bf16(v0[0], v0[1]); o.y = cvt_pk_bf16(v0[2], v0[3]); o.z = cvt_pk_bf16(v1[0], v1[1]); o.w = cvt_pk_bf16(v1[2], v1[3]);
                    *(u32x4*)(Y + (size_t)row * DMODEL + c) = o; } }
    }
};

template <class Epi, class Sched, bool ALIGN_EPI = false, bool SP2 = false>
__device__ __forceinline__ void gemm_phase(PG8_LAS unsigned char* lds, const Gemm g, const Sched& S, const Epi& E, int wave_u) {
    const int tid_l = tid_of(wave_u);
    const int tid = tid_l, wid = __builtin_amdgcn_readfirstlane(tid >> 6), lane = tid & 63, wr = wid >> 2, wc = wid & 3, fr = lane & 15, fq = lane >> 4;
    const int K = g.K, nt = K / BK;
    unsigned voffA[2], voffB[2];
#pragma unroll
    for (int i = 0; i < 2; ++i) { int R, C; stage_rc(tid * 16 + i * 8192, R, C); const int Rb = Epi::PERM ? ((R & ~31) + perm32(R & 31)) : R;
        voffA[i] = (unsigned)(R * K + C) * 2u; voffB[i] = (unsigned)(Rb * K + C) * 2u; }
    const size_t kstep = (size_t)(BK * 2);
    const size_t hstep = (size_t)HALF * K * 2;
    const size_t tstep = 2 * hstep;
    const unsigned ldsw = (unsigned)wid * 1024u;
    const int aoff = lds_byte(wr * 64 + fr, fq * 8), boff = lds_byte(wc * 32 + fr, fq * 8);
#define PG8_SA(b, h) (((b) * 2 + (h)) * HTB)
#define PG8_SB(b, h) ((4 + (b) * 2 + (h)) * HTB)
#define PG8_STAGE(bufoff, gbase, voff) do { _Pragma("unroll") for (int _i = 0; _i < 2; ++_i) \
        __builtin_amdgcn_global_load_lds((const unsigned*)((const char*)(gbase) + (voff)[_i]), (PG8_LAS unsigned*)(lds + (bufoff) + ldsw + _i * 8192), 16, 0, 0); } while (0)
#define PG8_LDA(dst, b, h) do { _Pragma("unroll") for (int m = 0; m < 4; ++m) _Pragma("unroll") for (int k = 0; k < 2; ++k) dst[m][k] = *(const PG8_LAS bf16x8*)(lds + PG8_SA(b, h) + aoff + m * 2048 + k * 1024); } while (0)
#define PG8_LDB(dst, b, h) do { _Pragma("unroll") for (int n = 0; n < 2; ++n) _Pragma("unroll") for (int k = 0; k < 2; ++k) dst[n][k] = *(const PG8_LAS bf16x8*)(lds + PG8_SB(b, h) + boff + n * 2048 + k * 1024); } while (0)
#define PG8_MMA(ai, bj, At, Bt) do { __builtin_amdgcn_s_setprio(1); _Pragma("unroll") for (int m = 0; m < 4; ++m) _Pragma("unroll") for (int n = 0; n < 2; ++n) _Pragma("unroll") for (int k = 0; k < 2; ++k) \
        acc[ai][bj][m][n] = __builtin_amdgcn_mfma_f32_16x16x32_bf16(Bt[n][k], At[m][k], acc[ai][bj][m][n], 0, 0, 0); __builtin_amdgcn_s_setprio(0); } while (0)
#define PG8_WAIT_V(n) asm volatile("s_waitcnt vmcnt(" #n ")" ::: "memory")
#define PG8_WAIT_L(n) asm volatile("s_waitcnt lgkmcnt(" #n ")" ::: "memory")
#define PG8_BAR __builtin_amdgcn_s_barrier()
#define PG8_SCHED __builtin_amdgcn_sched_barrier(0)
    Unit cur, nxt; int ui = 0;
    if (!S.next(0, cur)) return;
    f32x4 acc[2][2][4][2];
#pragma unroll
    for (int a = 0; a < 2; ++a)
#pragma unroll
        for (int b = 0; b < 2; ++b)
#pragma unroll
            for (int m = 0; m < 4; ++m)
#pragma unroll
                for (int n = 0; n < 2; ++n) acc[a][b][m][n] = (f32x4){0.f, 0.f, 0.f, 0.f};
    bf16x8 At[4][2], B0[2][2], B1[2][2];
    const char* cA = (const char*)g.A + (size_t)cur.pm * tstep; const char* cB = (const char*)g.Bt + (size_t)cur.pn * tstep;
    S.a_ready(cur);
    if constexpr (SP2) {
        PG8_STAGE(PG8_SB(0, 0), cB, voffB); PG8_STAGE(PG8_SB(0, 1), cB + hstep, voffB); PG8_STAGE(PG8_SA(0, 0), cA, voffA); PG8_STAGE(PG8_SA(0, 1), cA + hstep, voffA);
        if (wr == 1) PG8_BAR;
        PG8_WAIT_V(2); PG8_BAR;
        PG8_STAGE(PG8_SB(1, 0), cB + kstep, voffB); PG8_STAGE(PG8_SA(1, 0), cA + kstep, voffA); PG8_STAGE(PG8_SB(1, 1), cB + hstep + kstep, voffB);
        PG8_WAIT_V(6); PG8_BAR;
    } else {
        PG8_STAGE(PG8_SB(0, 0), cB, voffB); PG8_STAGE(PG8_SA(0, 0), cA, voffA); PG8_STAGE(PG8_SB(0, 1), cB + hstep, voffB); PG8_STAGE(PG8_SA(0, 1), cA + hstep, voffA);
        if (wr == 1) PG8_BAR;
        PG8_WAIT_V(4); PG8_BAR;
        PG8_STAGE(PG8_SB(1, 0), cB + kstep, voffB); PG8_STAGE(PG8_SA(1, 0), cA + kstep, voffA); PG8_STAGE(PG8_SB(1, 1), cB + hstep + kstep, voffB);
        PG8_WAIT_V(6); PG8_BAR;
    }
    for (;;) {
        const bool has_next = S.next(ui + 1, nxt);
        const char* nA = has_next ? (const char*)g.A + (size_t)nxt.pm * tstep : cA; const char* nB = has_next ? (const char*)g.Bt + (size_t)nxt.pn * tstep : cB;
        for (int t = 0; t < nt; t += 2) {
            const bool last = (t == nt - 2);
            const char* a1 = cA + (size_t)(t + 1) * kstep;
            const char* a2 = last ? nA : cA + (size_t)(t + 2) * kstep; const char* b2 = last ? nB : cB + (size_t)(t + 2) * kstep;
            const char* a3 = a2 + kstep; const char* b3 = b2 + kstep;
            if (last && has_next) S.a_ready(nxt);
            if constexpr (SP2) {
            PG8_LDB(B0, 0, 0); PG8_LDB(B1, 0, 1); PG8_SCHED; PG8_LDA(At, 0, 0); PG8_STAGE(PG8_SA(1, 1), a1 + hstep, voffA);
            PG8_WAIT_V(8); PG8_WAIT_L(0); PG8_BAR; PG8_MMA(0, 0, At, B0); PG8_MMA(0, 1, At, B1); PG8_BAR; PG8_SCHED;
            PG8_LDA(At, 0, 1); PG8_STAGE(PG8_SB(0, 0), b2, voffB); PG8_STAGE(PG8_SB(0, 1), b2 + hstep, voffB); PG8_STAGE(PG8_SA(0, 0), a2, voffA);
            PG8_WAIT_V(8); PG8_WAIT_L(0); PG8_BAR; PG8_MMA(1, 0, At, B0); PG8_MMA(1, 1, At, B1); PG8_BAR; PG8_SCHED;
            PG8_LDB(B0, 1, 0); PG8_LDB(B1, 1, 1); PG8_SCHED; PG8_LDA(At, 1, 0); PG8_STAGE(PG8_SA(0, 1), a2 + hstep, voffA);
            PG8_WAIT_V(8); PG8_WAIT_L(0); PG8_BAR; PG8_MMA(0, 0, At, B0); PG8_MMA(0, 1, At, B1); PG8_BAR; PG8_SCHED;
            PG8_LDA(At, 1, 1); PG8_STAGE(PG8_SB(1, 0), b3, voffB); PG8_STAGE(PG8_SB(1, 1), b3 + hstep, voffB); PG8_STAGE(PG8_SA(1, 0), a3, voffA);
            PG8_WAIT_V(8); PG8_WAIT_L(0); PG8_BAR; PG8_MMA(1, 0, At, B0); PG8_MMA(1, 1, At, B1); PG8_BAR; PG8_SCHED;
            } else {
            PG8_LDB(B0, 0, 0); PG8_SCHED; PG8_LDA(At, 0, 0); PG8_STAGE(PG8_SA(1, 1), a1 + hstep, voffA);
            PG8_WAIT_L(8); PG8_BAR; PG8_WAIT_L(0); PG8_MMA(0, 0, At, B0); PG8_BAR; PG8_SCHED;
            PG8_LDB(B1, 0, 1); PG8_STAGE(PG8_SB(0, 0), b2, voffB);
            PG8_BAR; PG8_WAIT_L(0); PG8_MMA(0, 1, At, B1); PG8_BAR;
            PG8_LDA(At, 0, 1); PG8_STAGE(PG8_SA(0, 0), a2, voffA);
            PG8_BAR; PG8_WAIT_L(0); PG8_MMA(1, 0, At, B0); PG8_BAR; PG8_SCHED;
            PG8_STAGE(PG8_SB(0, 1), b2 + hstep, voffB);
            PG8_WAIT_V(6); PG8_BAR; PG8_MMA(1, 1, At, B1); PG8_BAR;
            PG8_LDB(B0, 1, 0); PG8_SCHED; PG8_LDA(At, 1, 0); PG8_STAGE(PG8_SA(0, 1), a2 + hstep, voffA);
            PG8_WAIT_L(8); PG8_BAR; PG8_WAIT_L(0); PG8_MMA(0, 0, At, B0); PG8_BAR; PG8_SCHED;
            PG8_LDB(B1, 1, 1); PG8_STAGE(PG8_SB(1, 0), b3, voffB);
            PG8_BAR; PG8_WAIT_L(0); PG8_MMA(0, 1, At, B1); PG8_BAR;
            PG8_LDA(At, 1, 1); PG8_STAGE(PG8_SA(1, 0), a3, voffA);
            PG8_BAR; PG8_WAIT_L(0); PG8_MMA(1, 0, At, B0); PG8_BAR; PG8_SCHED;
            PG8_STAGE(PG8_SB(1, 1), b3 + hstep, voffB);
            PG8_WAIT_V(6); PG8_BAR; PG8_MMA(1, 1, At, B1); PG8_BAR;
            }
        }
        if constexpr (ALIGN_EPI) { if (wr == 0) PG8_BAR; }
        if constexpr (!Epi::AFTER_DRAIN) { E(acc, cur, wr, wc, fr, fq); S.done(cur); }
        if (!has_next) break;
#pragma unroll
        for (int a = 0; a < 2; ++a)
#pragma unroll
            for (int b = 0; b < 2; ++b)
#pragma unroll
                for (int m = 0; m < 4; ++m)
#pragma unroll
                    for (int n = 0; n < 2; ++n) acc[a][b][m][n] = (f32x4){0.f, 0.f, 0.f, 0.f};
        cur = nxt; cA = nA; cB = nB; ++ui;
        if constexpr (ALIGN_EPI) { if (wr == 1) PG8_BAR; }
    }
    PG8_WAIT_V(0);
    if constexpr (!ALIGN_EPI) { if (wr == 0) PG8_BAR; }
    PG8_BAR;
    if constexpr (Epi::AFTER_DRAIN) { E.fused(acc, cur, wr, wc, fr, fq, lds, wid, lane); S.done(cur); }
#undef PG8_SA
#undef PG8_SB
#undef PG8_STAGE
#undef PG8_LDA
#undef PG8_LDB
#undef PG8_MMA
#undef PG8_WAIT_V
#undef PG8_WAIT_L
#undef PG8_BAR
#undef PG8_SCHED
}
}
#define LAS __attribute__((address_space(3)))
typedef unsigned short bf16;
typedef float f32x4 __attribute__((ext_vector_type(4)));
typedef float f32x16 __attribute__((ext_vector_type(16)));
typedef short bf16x8 __attribute__((ext_vector_type(8)));
typedef short s16x4 __attribute__((ext_vector_type(4)));
typedef unsigned u32x4 __attribute__((ext_vector_type(4)));
typedef unsigned u32x2 __attribute__((ext_vector_type(2)));
using pg8::cvt_pk_bf16;

constexpr int NTHREADS = 512, NWAVES = 8;
constexpr int M = 65536, D = 1024, FF = 4096, DIN = 3104, DIN_PAD = 3328, LDH = 3104;
constexpr int NSEQ = 10, S_P = 16384, S_S = 4096, NPR = 32768;
constexpr int O_DQ = 0, O_DK = 512, O_DV = 1024, O_GQ = 1536, O_GK = 1792, O_GV = 2048, O_GR = 2560, O_LRF = 3072, O_LRB = 3088;
constexpr float LN_EPS = 1e-5f;
constexpr float ALPHA = 1.189207115002721f;
constexpr float LAM_INIT = 0.2f;
constexpr float C1 = 0.125f * 1.4426950408889634f;

constexpr size_t MiB = 1u << 20;
constexpr size_t WS_CTL = 0;
constexpr size_t WS_WIN = 2 * MiB, WS_WO = 9 * MiB, WS_W1 = 11 * MiB, WS_W2 = 19 * MiB, WS_GG = 27 * MiB;
constexpr size_t WS_H = 32 * MiB;
constexpr size_t WS_XB = 420 * MiB;
constexpr size_t WS_MIX = 548 * MiB;
constexpr size_t WS_ST = 676 * MiB;
constexpr size_t WS_X1B = 676 * MiB;
constexpr size_t WS_HID = 32 * MiB;
constexpr size_t WS_KD = 832 * MiB, WS_VD = 896 * MiB;
constexpr size_t WS_END = 960 * MiB;
static_assert(WS_H + (size_t)M * LDH * 2 <= WS_XB && WS_HID + (size_t)M * FF * 2 <= WS_MIX && WS_X1B + (size_t)M * D * 2 <= WS_END, "ws map");

constexpr int RING_BYTES = 131072;
constexpr int LDS_BYTES = 160 * 1024;

struct Params {
    const float* in[20];
    float* out;
    unsigned char* ws;
    int ph_lo, ph_hi;
};

__device__ __forceinline__ float wave_sum(float v) {
#pragma unroll
    for (int o = 1; o < 64; o <<= 1) v += __shfl_xor(v, o);
    return v;
}
__device__ __forceinline__ const float* xrow_ptr(const Params& p, int m) { return (m < NPR) ? p.in[0] + (size_t)m * D : p.in[1] + (size_t)(m - NPR) * D; }

__device__ __forceinline__ void p0_transpose_item(const float* W, int K, int N, bf16* WT, LAS float* scr, int item, int lane) {
    const int nblk = N / 32, kb = item / nblk, nb = item % nblk, k0 = 64 * kb, n0 = 32 * nb;
#pragma unroll 8
    for (int i = 0; i < 32; ++i) { const int kk = 2 * i + (lane >> 5); scr[kk * 33 + (lane & 31)] = W[(size_t)(k0 + kk) * N + n0 + (lane & 31)]; }
    asm volatile("s_waitcnt vmcnt(0) lgkmcnt(0)" ::: "memory");
    const int c = lane & 7;
#pragma unroll
    for (int j = 0; j < 4; ++j) { const int n = (lane >> 3) + 8 * j; const LAS float* s = scr + (8 * c) * 33 + n;
        u32x4 o; o.x = cvt_pk_bf16(s[0 * 33], s[1 * 33]); o.y = cvt_pk_bf16(s[2 * 33], s[3 * 33]); o.z = cvt_pk_bf16(s[4 * 33], s[5 * 33]); o.w = cvt_pk_bf16(s[6 * 33], s[7 * 33]);
        *(u32x4*)(WT + (size_t)(n0 + n) * K + k0 + 8 * c) = o; }
    asm volatile("s_waitcnt lgkmcnt(0)" ::: "memory");
}

__device__ __forceinline__ void ln_row(const float* in, float* outf, bf16* outb, const float* g, const float* b, int lane) {
    const f32x4* xr = (const f32x4*)in + lane;
    f32x4 v[4]; float s = 0.f;
#pragma unroll
    for (int j = 0; j < 4; ++j) { v[j] = xr[64 * j]; s += (v[j].x + v[j].y) + (v[j].z + v[j].w); }
    const float mean = wave_sum(s) * (1.f / D); float s2 = 0.f;
#pragma unroll
    for (int j = 0; j < 4; ++j) { v[j] = v[j] - mean; s2 += (v[j].x * v[j].x + v[j].y * v[j].y) + (v[j].z * v[j].z + v[j].w * v[j].w); }
    const float rstd = 1.f / sqrtf(wave_sum(s2) * (1.f / D) + LN_EPS);
#pragma unroll
    for (int j = 0; j < 4; ++j) {
        const f32x4 g4 = ((const f32x4*)g)[lane + 64 * j], b4 = ((const f32x4*)b)[lane + 64 * j];
        const f32x4 o = v[j] * rstd * g4 + b4;
        ((f32x4*)outf)[lane + 64 * j] = o;
        if (outb) { u32x2 w; w.x = cvt_pk_bf16(o.x, o.y); w.y = cvt_pk_bf16(o.z, o.w); ((u32x2*)outb)[lane + 64 * j] = w; }
    }
}

__device__ __forceinline__ void ln_row_b(const bf16* in, float* outf, bf16* outb, const float* g, const float* b, int lane) {
    const u32x4 wa = ((const u32x4*)in)[lane], wb = ((const u32x4*)in)[64 + lane];
    float v[16];
#pragma unroll
    for (int i = 0; i < 4; ++i) { v[2 * i] = __uint_as_float(wa[i] << 16); v[2 * i + 1] = __uint_as_float(wa[i] & 0xffff0000u); v[8 + 2 * i] = __uint_as_float(wb[i] << 16); v[8 + 2 * i + 1] = __uint_as_float(wb[i] & 0xffff0000u); }
    float s = 0.f;
#pragma unroll
    for (int i = 0; i < 16; ++i) s += v[i];
    const float mean = wave_sum(s) * (1.f / D); float s2 = 0.f;
#pragma unroll
    for (int i = 0; i < 16; ++i) { v[i] -= mean; s2 += v[i] * v[i]; }
    const float rstd = 1.f / sqrtf(wave_sum(s2) * (1.f / D) + LN_EPS);
#pragma unroll
    for (int h = 0; h < 2; ++h) {
        const int e0 = h * 512 + 8 * lane;
        const f32x4 g0 = *(const f32x4*)(g + e0), g1 = *(const f32x4*)(g + e0 + 4), b0 = *(const f32x4*)(b + e0), b1 = *(const f32x4*)(b + e0 + 4);
        const f32x4 o0 = (f32x4){v[8 * h + 0], v[8 * h + 1], v[8 * h + 2], v[8 * h + 3]} * rstd * g0 + b0;
        const f32x4 o1 = (f32x4){v[8 * h + 4], v[8 * h + 5], v[8 * h + 6], v[8 * h + 7]} * rstd * g1 + b1;
        if (outf) { *(f32x4*)(outf + e0) = o0; *(f32x4*)(outf + e0 + 4) = o1; }
        if (outb) { u32x4 w; w.x = cvt_pk_bf16(o0.x, o0.y); w.y = cvt_pk_bf16(o0.z, o0.w); w.z = cvt_pk_bf16(o1.x, o1.y); w.w = cvt_pk_bf16(o1.z, o1.w); *(u32x4*)(outb + e0) = w; }
    }
}

__device__ __forceinline__ void ln_rows4_b(const bf16* in, float* outf, bf16* outb, const float* g, const float* b, int lane) {
    u32x4 wa[4], wb[4];
#pragma unroll
    for (int r = 0; r < 4; ++r) { wa[r] = ((const u32x4*)(in + (size_t)r * D))[lane]; wb[r] = ((const u32x4*)(in + (size_t)r * D))[64 + lane]; }
    float v[4][16], s[4], s2[4];
#pragma unroll
    for (int r = 0; r < 4; ++r) { s[r] = 0.f;
#pragma unroll
        for (int i = 0; i < 4; ++i) { v[r][2 * i] = __uint_as_float(wa[r][i] << 16); v[r][2 * i + 1] = __uint_as_float(wa[r][i] & 0xffff0000u); v[r][8 + 2 * i] = __uint_as_float(wb[r][i] << 16); v[r][8 + 2 * i + 1] = __uint_as_float(wb[r][i] & 0xffff0000u); }
#pragma unroll
        for (int i = 0; i < 16; ++i) s[r] += v[r][i]; }
#pragma unroll
    for (int o = 1; o < 64; o <<= 1) {
#pragma unroll
        for (int r = 0; r < 4; ++r) s[r] += __shfl_xor(s[r], o); }
#pragma unroll
    for (int r = 0; r < 4; ++r) { const float mean = s[r] * (1.f / D); s2[r] = 0.f;
#pragma unroll
        for (int i = 0; i < 16; ++i) { v[r][i] -= mean; s2[r] += v[r][i] * v[r][i]; } }
#pragma unroll
    for (int o = 1; o < 64; o <<= 1) {
#pragma unroll
        for (int r = 0; r < 4; ++r) s2[r] += __shfl_xor(s2[r], o); }
#pragma unroll
    for (int h = 0; h < 2; ++h) {
        const int e0 = h * 512 + 8 * lane;
        const f32x4 g0 = *(const f32x4*)(g + e0), g1 = *(const f32x4*)(g + e0 + 4), b0 = *(const f32x4*)(b + e0), b1 = *(const f32x4*)(b + e0 + 4);
#pragma unroll
        for (int r = 0; r < 4; ++r) {
            const float rstd = 1.f / sqrtf(s2[r] * (1.f / D) + LN_EPS);
            const f32x4 o0 = (f32x4){v[r][8 * h + 0], v[r][8 * h + 1], v[r][8 * h + 2], v[r][8 * h + 3]} * rstd * g0 + b0;
            const f32x4 o1 = (f32x4){v[r][8 * h + 4], v[r][8 * h + 5], v[r][8 * h + 6], v[r][8 * h + 7]} * rstd * g1 + b1;
            if (outf) { *(f32x4*)(outf + (size_t)r * D + e0) = o0; *(f32x4*)(outf + (size_t)r * D + e0 + 4) = o1; }
            if (outb) { u32x4 w; w.x = cvt_pk_bf16(o0.x, o0.y); w.y = cvt_pk_bf16(o0.z, o0.w); w.z = cvt_pk_bf16(o1.x, o1.y); w.w = cvt_pk_bf16(o1.z, o1.w); *(u32x4*)(outb + (size_t)r * D + e0) = w; }
        }
    }
}
#define RLX_AGENT __ATOMIC_RELAXED, __HIP_MEMORY_SCOPE_AGENT
#define XB_TMO      128
#define XB_XCNT(j)  (256  + 64 * (j))
#define XB_XSUB(j)  (1280 + 64 * (j))
#define XB_XGEN(j)  (2304 + 64 * (j))
#define XB_TOP      3328
#define XB_TOPGEN   3392
#define XCD_BAR_WORDS 3456
#define XB_SPIN_CAP (1u << 18)

__device__ __forceinline__ unsigned xb_ld(unsigned* p)              { return __hip_atomic_load(p, __ATOMIC_RELAXED, __HIP_MEMORY_SCOPE_AGENT); }
__device__ __forceinline__ unsigned xb_add(unsigned* p, unsigned v) { return __hip_atomic_fetch_add(p, v, __ATOMIC_RELAXED, __HIP_MEMORY_SCOPE_AGENT); }
__device__ __forceinline__ unsigned xb_xcc_id() { return (unsigned)__builtin_amdgcn_s_getreg((3 << 11) | 20) & 0xFu; }
#define XB_SPIN(cond, bar) do { unsigned _sp = 0; while (cond) { __builtin_amdgcn_s_sleep(1); \
    if ((++_sp & 255u) == 0u) { if (xb_ld(&(bar)[XB_TMO])) break; if (_sp > XB_SPIN_CAP) { atomicAdd(&(bar)[XB_TMO], 1u); break; } } } } while (0)

struct XcdBarrier {
    unsigned* bar; unsigned x; int wv;
    volatile LAS unsigned* st;
};

__device__ __forceinline__ XcdBarrier xcd_barrier_post(unsigned* bar, volatile LAS unsigned* st, int wave_u) {
    XcdBarrier b; b.bar = bar; b.x = xb_xcc_id(); b.st = st; b.wv = wave_u;
    if (tid_of(wave_u) == 0) (void)xb_add(&bar[XB_XCNT(b.x)], 1u);
    return b;
}
__device__ __forceinline__ void xcd_barrier_complete(unsigned* bar, unsigned x, unsigned& nloc, unsigned& nx) {
    const unsigned G = gridDim.x * gridDim.y * gridDim.z;
    unsigned sum, cnt, mine, sp = 0u;
    for (;;) {
        sum = 0u; cnt = 0u; mine = 0u;
#pragma unroll
        for (unsigned j = 0; j < 16; ++j) { const unsigned c = xb_ld(&bar[XB_XCNT(j)]); sum += c; cnt += (c > 0u) ? 1u : 0u; mine = (j == x) ? c : mine; }
        if (sum == G) break;
        __builtin_amdgcn_s_sleep(1);
        if ((++sp & 255u) == 0u) { if (xb_ld(&bar[XB_TMO])) break; if (sp > XB_SPIN_CAP) { atomicAdd(&bar[XB_TMO], 1u); break; } }
    }
    nloc = mine > 0u ? mine : 1u; nx = cnt > 0u ? cnt : 1u;
}

__device__ __forceinline__ void xcd_barrier(const XcdBarrier& b) {
    asm volatile("s_waitcnt vmcnt(0)" ::: "memory");
    __syncthreads();
    if (tid_of(b.wv) == 0) {
        unsigned* bar = b.bar;
        __builtin_amdgcn_s_waitcnt(0);
        unsigned nloc = b.st[0], nx = b.st[1];
        if (nloc == 0u) { xcd_barrier_complete(bar, b.x, nloc, nx); b.st[0] = nloc; b.st[1] = nx; }
        const unsigned old = xb_add(&bar[XB_XSUB(b.x)], 1u);
        const unsigned gen = old / nloc;
        if (old + 1u == (gen + 1u) * nloc) {
            __builtin_amdgcn_fence(__ATOMIC_RELEASE, "agent");
            asm volatile("s_waitcnt vmcnt(0)" ::: "memory");
            const unsigned og = xb_add(&bar[XB_TOP], 1u);
            const unsigned tg = og / nx;
            if (og + 1u == (tg + 1u) * nx) xb_add(&bar[XB_TOPGEN], 1u);
            else XB_SPIN(xb_ld(&bar[XB_TOPGEN]) == tg, bar);
            __builtin_amdgcn_fence(__ATOMIC_ACQUIRE, "agent");
            xb_add(&bar[XB_XGEN(b.x)], 1u);
            asm volatile("s_waitcnt vmcnt(0)" ::: "memory");
        } else {
            XB_SPIN(xb_ld(&bar[XB_XGEN(b.x)]) == gen, bar);
            __builtin_amdgcn_fence(__ATOMIC_ACQUIRE, "agent");
            asm volatile("s_waitcnt vmcnt(0)" ::: "memory");
        }
    }
    __syncthreads();
}
#ifndef ATT_REPS
#define ATT_REPS 1
#endif
namespace att {
typedef short v4i16_t __attribute__((ext_vector_type(4)));
typedef float f32x2 __attribute__((ext_vector_type(2)));
typedef __bf16 bf16x2_t __attribute__((ext_vector_type(2)));
__device__ __forceinline__ unsigned cvtpk_n(float lo, float hi) { const f32x2 v = {lo, hi}; return __builtin_bit_cast(unsigned, __builtin_convertvector(v, bf16x2_t)); }
constexpr int KSTR = 272, VSTR = 320;
constexpr int KBUF = 64 * KSTR, VBUF = 64 * VSTR, BUFB = KBUF + VBUF;
constexpr int XS = 132;
constexpr int TILEB = 32768;
constexpr int L_RED = 4 * TILEB;
constexpr int L_CTL = 160 * 1024 - 256;
constexpr float SKIP_T = 38.f;
constexpr int CW_UNIT = 160, CW_KN = 64;
__device__ __forceinline__ int crow(int r, int hi) { return (r & 3) + 8 * (r >> 2) + 4 * hi; }
__device__ __forceinline__ s16x4 vtr(LAS unsigned char* p) { return __builtin_bit_cast(s16x4, __builtin_amdgcn_ds_read_tr16_b64_v4i16((LAS v4i16_t*)p)); }
__device__ __forceinline__ float bf_lo(unsigned w) { return __uint_as_float(w << 16); }
__device__ __forceinline__ float bf_hi(unsigned w) { return __uint_as_float(w & 0xffff0000u); }

__device__ __forceinline__ void knorm_phase(const bf16* KD, unsigned* ctl, int bid, int G, int wave_u) {
    const int tid_l = tid_of(wave_u);
    const int gt = bid * NTHREADS + tid_l, NTH = G * NTHREADS;
    for (int idx = gt; idx < M * 8; idx += NTH) {
        const int row = idx >> 3, hc = idx & 7;
        const u32x4* kp = (const u32x4*)(KD + ((size_t)(hc >> 1) * M + row) * 128 + (hc & 1) * 64);
        float ss = 0.f;
#pragma unroll
        for (int i = 0; i < 8; ++i) { const u32x4 w = kp[i];
#pragma unroll
            for (int e = 0; e < 4; ++e) { const float a = bf_lo(w[e]), b = bf_hi(w[e]); ss = fmaf(a, a, ss); ss = fmaf(b, b, ss); } }
        float nr = sqrtf(ss);
        nr = fmaxf(nr, __shfl_xor(nr, 8)); nr = fmaxf(nr, __shfl_xor(nr, 16)); nr = fmaxf(nr, __shfl_xor(nr, 32));
        const int seq = (row < NPR) ? (row >> 14) : 2 + ((row - NPR) >> 12);
        if ((tid_l & 63) < 8) atomicMax(ctl + CW_KN + seq * 8 + hc, __float_as_uint(nr));
    }
}

__device__ __forceinline__ void attn_unit(const bf16* Hb, const bf16* KD, const bf16* VD, bf16* MIX, int row0, int S, int head, int qb, float lam, const float* dng, float kn0, float kn1, LAS unsigned char* lds, int wave_u) {
    const int tid_l = tid_of(wave_u);
    const int tid = tid_l, lane = tid & 63, wid = __builtin_amdgcn_readfirstlane(tid >> 6), r32 = lane & 31, hh = lane >> 5;
    const int c = wid >> 2, qs = wid & 3;
    const int q0 = qb * 128 + qs * 32;
    const float slope2 = __uint_as_float(__builtin_amdgcn_readfirstlane(__float_as_uint(exp2f(-2.f * (float)(head + 1)) * 1.4426950408889634f)));
    lam = __uint_as_float(__builtin_amdgcn_readfirstlane(__float_as_uint(lam)));
    bf16x8 qr[4];
    float mub;
    float m;
    {   const bf16* Qp = Hb + (size_t)(row0 + q0 + r32) * LDH + O_DQ + head * 128 + c * 64 + hh * 8;
        const bf16* Kp = KD + ((size_t)head * M + row0 + q0 + r32) * 128 + c * 64 + hh * 8;
        float qq = 0.f, dot = 0.f;
#pragma unroll
        for (int d0 = 0; d0 < 4; ++d0) { qr[d0] = *(const bf16x8*)(Qp + d0 * 16); const u32x4 qw = __builtin_bit_cast(u32x4, qr[d0]); const u32x4 kw = *(const u32x4*)(Kp + d0 * 16);
#pragma unroll
            for (int e = 0; e < 4; ++e) { const float qa = bf_lo(qw[e]), qb_ = bf_hi(qw[e]), ka = bf_lo(kw[e]), kb = bf_hi(kw[e]);
                qq = fmaf(qa, qa, qq); qq = fmaf(qb_, qb_, qq); dot = fmaf(qa, ka, dot); dot = fmaf(qb_, kb, dot); } }
        qq += __shfl_xor(qq, 32); dot += __shfl_xor(dot, 32);
        m = dot;
        float am = sqrtf(qq) * (c ? kn1 : kn0) * 1.001f + 0.01f, bm = dot;
        mub = am;
        float sp = am - dot;
#pragma unroll
        for (int o = 1; o < 32; o <<= 1) { am = fmaxf(am, __shfl_xor(am, o)); bm = fminf(bm, __shfl_xor(bm, o)); sp = fmaxf(sp, __shfl_xor(sp, o)); }
        LAS float* red = (LAS float*)(lds + L_RED);
        if (lane == 0) { red[wid * 4] = am; red[wid * 4 + 1] = bm; red[wid * 4 + 2] = sp; }
    }
    __syncthreads();
    int tlo, thi; bool fast;
    {   LAS float* red = (LAS float*)(lds + L_RED); float am = red[0], bm = red[1], sp = red[2];
#pragma unroll
        for (int w = 1; w < 8; ++w) { am = fmaxf(am, red[4 * w]); bm = fminf(bm, red[4 * w + 1]); sp = fmaxf(sp, red[4 * w + 2]); }
        fast = sp < 100.f;
        const float Wf = (sp + SKIP_T) / slope2 + 1.f; (void)am; (void)bm;
        const int W = (Wf < 1.0e6f) ? (int)Wf : 1000000;
        const int Q0 = qb * 128, NTall = S / 64;
        int lo = Q0 - 63 - W; lo = lo > 0 ? (lo + 63) / 64 : 0;
        int hi_ = (Q0 + 127 + W) / 64; hi_ = hi_ < NTall - 1 ? hi_ : NTall - 1;
        tlo = __builtin_amdgcn_readfirstlane(lo); thi = __builtin_amdgcn_readfirstlane(hi_);
    }
    if (((thi - tlo + 1) & 1) != 0) { if (tlo > 0) --tlo; else ++thi; }
    const int drow = 8 * wid + (lane >> 4);
    const int f0 = ((drow & 3) << 2) | ((drow >> 2) & 3), f1 = (((drow + 4) & 3) << 2) | (((drow + 4) >> 2) & 3);
    const unsigned kg0 = (unsigned)((((size_t)head * M + row0 + drow) * 128 + ((lane & 15) ^ f0) * 8) * 2);
    const unsigned kg1 = (unsigned)((((size_t)head * M + row0 + drow + 4) * 128 + ((lane & 15) ^ f1) * 8) * 2);
    const char* Kc = (const char*)KD; const char* Vc = (const char*)VD;
    const int dmaw = wid * 2048;
#define ATT_DMA(t, st) do { const unsigned off_ = (unsigned)(t) * 16384u; LAS unsigned char* S_ = lds + (st) * TILEB + dmaw; \
        __builtin_amdgcn_global_load_lds((const unsigned*)(Kc + (size_t)(kg0 + off_)), (LAS unsigned*)(S_), 16, 0, 0); \
        __builtin_amdgcn_global_load_lds((const unsigned*)(Kc + (size_t)(kg1 + off_)), (LAS unsigned*)(S_ + 1024), 16, 0, 0); \
        __builtin_amdgcn_global_load_lds((const unsigned*)(Vc + (size_t)(kg0 + off_)), (LAS unsigned*)(S_ + 16384), 16, 0, 0); \
        __builtin_amdgcn_global_load_lds((const unsigned*)(Vc + (size_t)(kg1 + off_)), (LAS unsigned*)(S_ + 16384 + 1024), 16, 0, 0); } while (0)
    ATT_DMA(tlo, 0); ATT_DMA(tlo + 1, 1);
    asm volatile("s_waitcnt vmcnt(0)" ::: "memory");
    __syncthreads();
    float l = 0.f;
    f32x16 o[4];
#pragma unroll
    for (int b = 0; b < 4; ++b)
#pragma unroll
        for (int r = 0; r < 16; ++r) o[b][r] = 0.f;
    const int fk = ((r32 & 3) << 2) | ((r32 >> 2) & 3);
    const int kbase = 256 * r32 + 16 * ((c * 8 + hh) ^ fk);
    const int q4 = (lane & 15) >> 2, pp4 = lane & 3, g1 = (lane >> 4) & 1;
    const int vlow0 = (2 * g1 + (pp4 >> 1)) ^ hh;
    const int vbase0 = 16384 + 256 * (4 * hh + q4) + 64 * q4 + 16 * vlow0 + 8 * (pp4 & 1);
    const int vbase1 = 16384 + 256 * (4 * hh + q4 + 8) + 64 * q4 + 16 * (vlow0 ^ 2) + 8 * (pp4 & 1);
    f32x2 l2 = (f32x2){0.f, 0.f};
#define ATT_CINIT(P0, P1, T) do { const int krel_ = (T) * 64 - q0; const float dbase_ = (float)(krel_ + 4 * hh - r32); \
        if (krel_ + 63 <= 0 || krel_ >= 31) { const float sg_ = (krel_ + 63 <= 0) ? slope2 : -slope2; const float base_ = fmaf(sg_, dbase_, -m); \
            _Pragma("unroll") for (int r = 0; r < 16; ++r) { const float cr = (float)((r & 3) + 8 * (r >> 2)); P0[r] = fmaf(sg_, cr, base_); P1[r] = fmaf(sg_, cr + 32.f, base_); } } \
        else { _Pragma("unroll") for (int r = 0; r < 16; ++r) { const float cr = (float)((r & 3) + 8 * (r >> 2)); P0[r] = fmaf(fabsf(dbase_ + cr), -slope2, -m); P1[r] = fmaf(fabsf(dbase_ + cr + 32.f), -slope2, -m); } } } while (0)
#define ATT_SB() __builtin_amdgcn_sched_barrier(0)
#define ATT_EXPPACK(P, S8, W) do { float e0 = __builtin_amdgcn_exp2f(P[S8 + 0]), e1 = __builtin_amdgcn_exp2f(P[S8 + 1]), e2 = __builtin_amdgcn_exp2f(P[S8 + 2]), e3 = __builtin_amdgcn_exp2f(P[S8 + 3]), \
        e4 = __builtin_amdgcn_exp2f(P[S8 + 4]), e5 = __builtin_amdgcn_exp2f(P[S8 + 5]), e6 = __builtin_amdgcn_exp2f(P[S8 + 6]), e7 = __builtin_amdgcn_exp2f(P[S8 + 7]); \
        l += ((e0 + e1) + (e2 + e3)) + ((e4 + e5) + (e6 + e7)); \
        u32x4 w_; w_.x = cvt_pk_bf16(e0, e1); w_.y = cvt_pk_bf16(e2, e3); w_.z = cvt_pk_bf16(e4, e5); w_.w = cvt_pk_bf16(e6, e7); W = __builtin_bit_cast(bf16x8, w_); } while (0)
#define ATT_VRD(S, L, H) do { _Pragma("unroll") for (int db = 0; db < 4; ++db) { \
        asm volatile("ds_read_b64_tr_b16 %0, %1 offset:%c2" : "=&v"(L[db]) : "v"(va0[db]), "i"(4096 * (S)) : "memory"); \
        asm volatile("ds_read_b64_tr_b16 %0, %1 offset:%c2" : "=&v"(H[db]) : "v"(va1[db]), "i"(4096 * (S)) : "memory"); } } while (0)
#define ATT_WAITV(L, H) asm volatile("s_waitcnt lgkmcnt(0)" : "+v"(L[0]), "+v"(L[1]), "+v"(L[2]), "+v"(L[3]), "+v"(H[0]), "+v"(H[1]), "+v"(H[2]), "+v"(H[3]) : : "memory")
#define ATT_PVM(L, H, PF) do { _Pragma("unroll") for (int db = 0; db < 4; ++db) \
        o[db] = __builtin_amdgcn_mfma_f32_32x32x16_bf16(__builtin_bit_cast(bf16x8, (u32x4){L[db].x, L[db].y, H[db].x, H[db].y}), PF, o[db], 0, 0, 0); } while (0)
#define ATT_TILE(Bt, T) do { \
        f32x16 p0, p1; ATT_CINIT(p0, p1, T); \
        unsigned va0[4], va1[4]; { const unsigned tb_ = (unsigned)(uintptr_t)(Bt); \
            _Pragma("unroll") for (int db = 0; db < 4; ++db) { va0[db] = tb_ + (unsigned)(vbase0 ^ (64 * db)); va1[db] = tb_ + (unsigned)(vbase1 ^ (64 * db)); } } \
        bf16x8 kf[8]; \
        _Pragma("unroll") for (int d0 = 0; d0 < 4; ++d0) { kf[2 * d0] = *(LAS bf16x8*)(Bt + (kbase ^ (32 * d0))); kf[2 * d0 + 1] = *(LAS bf16x8*)(Bt + 8192 + (kbase ^ (32 * d0))); } \
        ATT_SB(); \
        _Pragma("unroll") for (int d0 = 0; d0 < 4; ++d0) { p0 = __builtin_amdgcn_mfma_f32_32x32x16_bf16(kf[2 * d0], qr[d0], p0, 0, 0, 0); p1 = __builtin_amdgcn_mfma_f32_32x32x16_bf16(kf[2 * d0 + 1], qr[d0], p1, 0, 0, 0); } \
        u32x2 vl[4], vh[4], wl[4], wh[4]; \
        ATT_VRD(0, vl, vh); \
        ATT_SB(); \
        float mt = fmaxf(p0[0], p1[0]); \
        _Pragma("unroll") for (int r = 1; r < 16; ++r) mt = fmaxf(mt, fmaxf(p0[r], p1[r])); \
        mt = fmaxf(mt, __shfl_xor(mt, 32)); \
        if (__any(mt > 0.f)) { \
            const float dl = fmaxf(mt, 0.f), alpha = __builtin_amdgcn_exp2f(-dl); \
            m += dl; l *= alpha; \
            _Pragma("unroll") for (int r = 0; r < 16; ++r) { p0[r] -= dl; p1[r] -= dl; } \
            _Pragma("unroll") for (int b = 0; b < 4; ++b) _Pragma("unroll") for (int r = 0; r < 16; ++r) o[b][r] *= alpha; \
        } \
        bf16x8 f0, f1, f2, f3; \
        ATT_EXPPACK(p0, 0, f0); ATT_EXPPACK(p0, 8, f1); ATT_EXPPACK(p1, 0, f2); ATT_EXPPACK(p1, 8, f3); \
        ATT_SB(); \
        ATT_WAITV(vl, vh); ATT_VRD(1, wl, wh); ATT_SB(); ATT_PVM(vl, vh, f0); ATT_SB(); \
        ATT_WAITV(wl, wh); ATT_VRD(2, vl, vh); ATT_SB(); ATT_PVM(wl, wh, f1); ATT_SB(); \
        ATT_WAITV(vl, vh); ATT_VRD(3, wl, wh); ATT_SB(); ATT_PVM(vl, vh, f2); ATT_SB(); \
        ATT_WAITV(wl, wh); ATT_SB(); ATT_PVM(wl, wh, f3); ATT_SB(); \
    } while (0)
#define ATT_TILE_FAST(Bt, T) do { \
        f32x16 p0, p1; \
        { const int krel_ = (T) * 64 - q0; const float dbase_ = (float)(krel_ + 4 * hh - r32); \
          if (krel_ + 63 <= 0 || krel_ >= 31) { const float sg_ = (krel_ + 63 <= 0) ? slope2 : -slope2; const float b0_ = fmaf(sg_, dbase_, -mub), b1_ = fmaf(sg_, 32.f, b0_); \
              _Pragma("unroll") for (int r = 0; r < 16; ++r) { const float cr = (float)((r & 3) + 8 * (r >> 2)); p0[r] = fmaf(sg_, cr, b0_); p1[r] = fmaf(sg_, cr, b1_); } } \
          else { _Pragma("unroll") for (int r = 0; r < 16; ++r) { const float cr = (float)((r & 3) + 8 * (r >> 2)); p0[r] = fmaf(fabsf(dbase_ + cr), -slope2, -mub); p1[r] = fmaf(fabsf(dbase_ + cr + 32.f), -slope2, -mub); } } } \
        unsigned va0[4], va1[4]; { const unsigned tb_ = (unsigned)(uintptr_t)(Bt); \
            _Pragma("unroll") for (int db = 0; db < 4; ++db) { va0[db] = tb_ + (unsigned)(vbase0 ^ (64 * db)); va1[db] = tb_ + (unsigned)(vbase1 ^ (64 * db)); } } \
        bf16x8 kf[8]; \
        _Pragma("unroll") for (int d0 = 0; d0 < 4; ++d0) { kf[2 * d0] = *(LAS bf16x8*)(Bt + (kbase ^ (32 * d0))); kf[2 * d0 + 1] = *(LAS bf16x8*)(Bt + 8192 + (kbase ^ (32 * d0))); } \
        ATT_SB(); \
        _Pragma("unroll") for (int d0 = 0; d0 < 4; ++d0) { p0 = __builtin_amdgcn_mfma_f32_32x32x16_bf16(kf[2 * d0], qr[d0], p0, 0, 0, 0); p1 = __builtin_amdgcn_mfma_f32_32x32x16_bf16(kf[2 * d0 + 1], qr[d0], p1, 0, 0, 0); } \
        u32x2 vl[4], vh[4], wl[4], wh[4]; \
        ATT_VRD(0, vl, vh); \
        ATT_SB(); \
        bf16x8 f0, f1, f2, f3; \
        ATT_EXPPACK2(p0, 0, f0); ATT_EXPPACK2(p0, 8, f1); ATT_EXPPACK2(p1, 0, f2); ATT_EXPPACK2(p1, 8, f3); \
        ATT_SB(); \
        ATT_WAITV(vl, vh); ATT_VRD(1, wl, wh); ATT_SB(); ATT_PVM(vl, vh, f0); ATT_SB(); \
        ATT_WAITV(wl, wh); ATT_VRD(2, vl, vh); ATT_SB(); ATT_PVM(wl, wh, f1); ATT_SB(); \
        ATT_WAITV(vl, vh); ATT_VRD(3, wl, wh); ATT_SB(); ATT_PVM(vl, vh, f2); ATT_SB(); \
        ATT_WAITV(wl, wh); ATT_SB(); ATT_PVM(wl, wh, f3); ATT_SB(); \
    } while (0)
#define ATT_EXPPACK2(P, S8, W) do { f32x2 ea_ = (f32x2){__builtin_amdgcn_exp2f(P[S8 + 0]), __builtin_amdgcn_exp2f(P[S8 + 1])}, eb_ = (f32x2){__builtin_amdgcn_exp2f(P[S8 + 2]), __builtin_amdgcn_exp2f(P[S8 + 3])}, \
        ec_ = (f32x2){__builtin_amdgcn_exp2f(P[S8 + 4]), __builtin_amdgcn_exp2f(P[S8 + 5])}, ed_ = (f32x2){__builtin_amdgcn_exp2f(P[S8 + 6]), __builtin_amdgcn_exp2f(P[S8 + 7])}; \
        l2 += (ea_ + eb_) + (ec_ + ed_); \
        u32x4 w_; w_.x = cvt_pk_bf16(ea_.x, ea_.y); w_.y = cvt_pk_bf16(eb_.x, eb_.y); w_.z = cvt_pk_bf16(ec_.x, ec_.y); w_.w = cvt_pk_bf16(ed_.x, ed_.y); W = __builtin_bit_cast(bf16x8, w_); } while (0)
#define ATT_CINITH(P, T, H) do { const int krel_ = (T) * 64 - q0; const float dbase_ = (float)(krel_ + 4 * hh - r32 + 32 * (H)); \
          if (krel_ + 63 <= 0 || krel_ >= 31) { const float sg_ = (krel_ + 63 <= 0) ? slope2 : -slope2; const float b0_ = fmaf(sg_, dbase_, -mref); \
              _Pragma("unroll") for (int r = 0; r < 16; ++r) { const float cr = (float)((r & 3) + 8 * (r >> 2)); P[r] = fmaf(sg_, cr, b0_); } } \
          else { _Pragma("unroll") for (int r = 0; r < 16; ++r) { const float cr = (float)((r & 3) + 8 * (r >> 2)); P[r] = fmaf(fabsf(dbase_ + cr), -slope2, -mref); } } } while (0)
#define ATT_SGB(mask, n) __builtin_amdgcn_sched_group_barrier(mask, n, 0)
#define ATT_KLD(Bt, H) do { _Pragma("unroll") for (int d0 = 0; d0 < 4; ++d0) kf[d0] = *(LAS bf16x8*)(Bt + 8192 * (H) + (kbase ^ (32 * d0))); } while (0)
#define ATT_QK(P) do { _Pragma("unroll") for (int d0 = 0; d0 < 4; ++d0) P = __builtin_amdgcn_mfma_f32_32x32x16_bf16(kf[d0], qr[d0], P, 0, 0, 0); } while (0)
#define ATT_VADDR(Bt) do { const unsigned tb_ = (unsigned)(uintptr_t)(Bt); \
            _Pragma("unroll") for (int db = 0; db < 4; ++db) { va0[db] = tb_ + (unsigned)(vbase0 ^ (64 * db)); va1[db] = tb_ + (unsigned)(vbase1 ^ (64 * db)); } } while (0)
#define ATT_PAIR_FAST(BtA, BtB, T) do { \
        f32x16 a0, a1, b0, b1; bf16x8 kf[4]; unsigned va0[4], va1[4]; u32x2 vl[4], vh[4], wl[4], wh[4]; \
        bf16x8 fa0, fa1, fa2, fa3, fb0, fb1, fb2, fb3; \
        ATT_CINITH(a0, T, 0); ATT_CINITH(a1, T, 1); ATT_VADDR(BtA); \
        ATT_KLD(BtA, 0); ATT_SB(); ATT_QK(a0); ATT_VRD(0, vl, vh); ATT_KLD(BtA, 1); ATT_SB(); \
        ATT_QK(a1); ATT_EXPPACK2(a0, 0, fa0); ATT_EXPPACK2(a0, 8, fa1); \
        _Pragma("unroll") for (int i_ = 0; i_ < 4; ++i_) { ATT_SGB(0x8, 1); ATT_SGB(0x2, 7); } ATT_SB(); \
        ATT_CINITH(b0, (T) + 1, 0); ATT_WAITV(vl, vh); ATT_VRD(1, wl, wh); ATT_KLD(BtB, 0); ATT_SB(); \
        ATT_PVM(vl, vh, fa0); ATT_QK(b0); ATT_EXPPACK2(a1, 0, fa2); ATT_EXPPACK2(a1, 8, fa3); \
        _Pragma("unroll") for (int i_ = 0; i_ < 8; ++i_) { ATT_SGB(0x8, 1); ATT_SGB(0x2, 4); } ATT_SB(); \
        ATT_CINITH(b1, (T) + 1, 1); ATT_WAITV(wl, wh); ATT_VRD(2, vl, vh); ATT_KLD(BtB, 1); ATT_SB(); \
        ATT_PVM(wl, wh, fa1); ATT_QK(b1); ATT_EXPPACK2(b0, 0, fb0); ATT_EXPPACK2(b0, 8, fb1); \
        _Pragma("unroll") for (int i_ = 0; i_ < 8; ++i_) { ATT_SGB(0x8, 1); ATT_SGB(0x2, 4); } ATT_SB(); \
        ATT_WAITV(vl, vh); ATT_VRD(3, wl, wh); ATT_SB(); \
        ATT_PVM(vl, vh, fa2); ATT_EXPPACK2(b1, 0, fb2); \
        _Pragma("unroll") for (int i_ = 0; i_ < 4; ++i_) { ATT_SGB(0x8, 1); ATT_SGB(0x2, 4); } ATT_SB(); \
        ATT_WAITV(wl, wh); ATT_VRD(8, vl, vh); ATT_SB(); \
        ATT_PVM(wl, wh, fa3); ATT_EXPPACK2(b1, 8, fb3); \
        _Pragma("unroll") for (int i_ = 0; i_ < 4; ++i_) { ATT_SGB(0x8, 1); ATT_SGB(0x2, 4); } ATT_SB(); \
        ATT_WAITV(vl, vh); ATT_VRD(9, wl, wh); ATT_SB(); ATT_PVM(vl, vh, fb0); ATT_SB(); \
        ATT_WAITV(wl, wh); ATT_VRD(10, vl, vh); ATT_SB(); ATT_PVM(wl, wh, fb1); ATT_SB(); \
        ATT_WAITV(vl, vh); ATT_VRD(11, wl, wh); ATT_SB(); ATT_PVM(vl, vh, fb2); ATT_SB(); \
        ATT_WAITV(wl, wh); ATT_SB(); ATT_PVM(wl, wh, fb3); ATT_SB(); \
    } while (0)
    if (fast) {
    for (int t = tlo; t <= thi; t += 2) {
        const int pbuf = ((t - tlo) >> 1) & 1;
        if (t + 2 <= thi) { ATT_DMA(t + 2, 2 * (pbuf ^ 1)); ATT_DMA(t + 3, 2 * (pbuf ^ 1) + 1); }
        LAS unsigned char* BA = lds + (2 * pbuf) * TILEB;
        LAS unsigned char* BB = BA + TILEB;
#ifndef ATT_DUP
#define ATT_DUP 1
#endif
        _Pragma("nounroll") for (int dup_ = ATT_DUP - 1; dup_ >= 0; --dup_) { const float mref = mub + (dup_ ? 1000.f : 0.f); ATT_PAIR_FAST(BA, BB, t); }
        asm volatile("s_waitcnt vmcnt(0)" ::: "memory");
        __syncthreads();
    }
    } else {
    for (int t = tlo; t <= thi; t += 2) {
        const int pbuf = ((t - tlo) >> 1) & 1;
        if (t + 2 <= thi) { ATT_DMA(t + 2, 2 * (pbuf ^ 1)); ATT_DMA(t + 3, 2 * (pbuf ^ 1) + 1); }
        LAS unsigned char* BA = lds + (2 * pbuf) * TILEB;
        LAS unsigned char* BB = BA + TILEB;
        ATT_TILE(BA, t); ATT_TILE(BB, t + 1);
        asm volatile("s_waitcnt vmcnt(0)" ::: "memory");
        __syncthreads();
    }
    }
#undef ATT_DMA
#undef ATT_CINIT
#undef ATT_EXPPACK
#undef ATT_VRD
#undef ATT_WAITV
#undef ATT_PVM
#undef ATT_TILE
#undef ATT_TILE_FAST
#undef ATT_PAIR_FAST
#undef ATT_CINITH
#undef ATT_KLD
#undef ATT_QK
#undef ATT_VADDR
#undef ATT_SGB
#undef ATT_EXPPACK2
#undef ATT_SB
    int ln2 = tid_of(wave_u) & 63;
    const int r32e = ln2 & 31, hhe = ln2 >> 5;
    if (fast) l = l2.x + l2.y;
    l += __shfl_xor(l, 32);
    const float rl = 1.f / l;
    LAS float* X = (LAS float*)lds;
    if (c == 1) {
        const float f = rl * lam;
#pragma unroll
        for (int b = 0; b < 4; ++b)
#pragma unroll
            for (int r = 0; r < 16; ++r) X[(qs * 32 + r32e) * XS + 32 * b + crow(r, hhe)] = o[b][r] * f;
    }
    __syncthreads();
    if (c == 0) {
        float ss = 0.f;
#pragma unroll
        for (int b = 0; b < 4; ++b)
#pragma unroll
            for (int r = 0; r < 16; ++r) { const float v = o[b][r] * rl - X[(qs * 32 + r32e) * XS + 32 * b + crow(r, hhe)]; o[b][r] = v; ss += v * v; }
        ss += __shfl_xor(ss, 32);
        const float rn = (1.f - LAM_INIT) / sqrtf(ss * (1.f / 128.f) + 1e-5f);
        bf16* orow = MIX + (size_t)(row0 + q0 + r32e) * D + head * 128;
#pragma unroll
        for (int b = 0; b < 4; ++b)
#pragma unroll
            for (int rg = 0; rg < 4; ++rg) { const int d = 32 * b + 8 * rg + 4 * hhe; const f32x4 g4 = *(const f32x4*)(dng + d);
                u32x2 w; w.x = cvt_pk_bf16(o[b][4 * rg + 0] * rn * g4.x, o[b][4 * rg + 1] * rn * g4.y); w.y = cvt_pk_bf16(o[b][4 * rg + 2] * rn * g4.z, o[b][4 * rg + 3] * rn * g4.w);
                *(u32x2*)(orow + d) = w; }
    }
    __syncthreads();
}

__device__ __forceinline__ void attn_phase(const Params& p, const bf16* Hb, const bf16* KD, const bf16* VD, bf16* MIX, unsigned* ctl, LAS unsigned char* lds, int bid, int G, int wave_u) {
    float s1 = 0.f, s2 = 0.f;
    for (int i = 0; i < 64; ++i) { s1 += p.in[4][i] * p.in[5][i]; s2 += p.in[6][i] * p.in[7][i]; }
    const float lam = expf(s1) - expf(s2) + LAM_INIT;
    LAS int* slot = (LAS int*)(lds + L_CTL);
    const int myx = (int)(__builtin_amdgcn_s_getreg((3 << 11) | 20) & 7u);
    for (int rep = 0; rep < ATT_REPS; ++rep)
    for (int qi = 0; qi < 8; ++qi) {
      const int x = (myx + qi) & 7;
      for (;;) {
        if (tid_of(wave_u) == 0) *slot = (int)atomicAdd(ctl + CW_UNIT + x + 8 * rep, 1u);
        __syncthreads();
        const int j = __builtin_amdgcn_readfirstlane(*slot);
        __syncthreads();
        if (j >= 256) break;
        const int grp = j >> 5, i = j & 31;
        const bool prompt = (grp == 0) | (grp == 1) | (grp == 4) | (grp == 6);
        const int head = (grp == 0 || grp == 2) ? 3 : (grp == 1 || grp == 3) ? 2 : (grp == 4 || grp == 5) ? 1 : 0;
        int seq, qb, row0, S;
        if (prompt) { seq = x & 1; qb = i * 4 + (x >> 1); row0 = seq * S_P; S = S_P; }
        else { seq = 2 + x; qb = i; row0 = NPR + x * S_S; S = S_S; }
        const float kn0 = __uint_as_float(__hip_atomic_load(ctl + CW_KN + seq * 8 + head * 2, __ATOMIC_RELAXED, __HIP_MEMORY_SCOPE_AGENT));
        const float kn1 = __uint_as_float(__hip_atomic_load(ctl + CW_KN + seq * 8 + head * 2 + 1, __ATOMIC_RELAXED, __HIP_MEMORY_SCOPE_AGENT));
        attn_unit(Hb, KD, VD, MIX, row0, S, head, qb, lam, p.in[8], kn0, kn1, lds, wave_u);
      }
    }
}
}
namespace gla {
using att::crow; using att::vtr; using att::VSTR;
constexpr int L_LR = 0, L_B = 4096, L_TOT = 20480, L_BT = 22528, L_QT = 23040, L_KT = 32256, L_V = 41472, L_Z = 82432;
constexpr int L_V2 = 116224, L_LR2 = 136704;
constexpr int QSTR = 144, ZS = 132, SEGC = 16;
constexpr float LOG2E = 1.4426950408889634f, LN2 = 0.6931471805599453f;
__device__ __forceinline__ float bf2f(unsigned h) { return __uint_as_float(h << 16); }
__device__ __forceinline__ float fexp(float x) { return __builtin_amdgcn_exp2f(x * LOG2E); }

struct ChunkRegs { u32x4 v0, v1, q, k, lr; };
template <bool NEEDQ> __device__ __forceinline__ void chunk_load(ChunkRegs& R, const bf16* Hb, int rowbase, int head, int dir, int tid) {
    const int srow = tid >> 4, sch = tid & 15;
    const bf16* Vg = Hb + (size_t)(rowbase + srow) * LDH + O_GV + head * 128 + sch * 8;
    R.v0 = *(const u32x4*)Vg; R.v1 = *(const u32x4*)(Vg + (size_t)32 * LDH);
    const int pr = tid >> 3, dk0 = (tid & 7) * 8;
    R.k = *(const u32x4*)(Hb + (size_t)(rowbase + pr) * LDH + O_GK + head * 64 + dk0);
    if (NEEDQ) R.q = *(const u32x4*)(Hb + (size_t)(rowbase + pr) * LDH + O_GQ + head * 64 + dk0);
    if (tid < 128) R.lr = *(const u32x4*)(Hb + (size_t)(rowbase + (tid >> 1)) * LDH + O_LRF + dir * 16 + (tid & 1) * 8);
}
__device__ __forceinline__ void stage_vlr(const ChunkRegs& R, int buf, LAS unsigned char* lds, int tid) {
    LAS float* LR = (LAS float*)(lds + (buf ? L_LR2 : L_LR));
    { const int srow = tid >> 4, sch = tid & 15; LAS unsigned char* V = lds + (buf ? L_V2 : L_V);
      *(LAS u32x4*)(V + srow * VSTR + sch * 16) = R.v0; *(LAS u32x4*)(V + (srow + 32) * VSTR + sch * 16) = R.v1; }
    if (tid < 128) { const int tok = tid >> 1, hf = tid & 1;
#pragma unroll
        for (int i = 0; i < 4; ++i) { const unsigned ww = R.lr[i]; LR[tok * 16 + hf * 8 + 2 * i] = bf2f(ww & 0xffffu); LR[tok * 16 + hf * 8 + 2 * i + 1] = bf2f(ww >> 16); } }
}
template <bool NEEDQ> __device__ __forceinline__ float chunk_front(const ChunkRegs& C, const ChunkRegs& N, bool stage_next, int cur, int dir, const bf16x8& bhi, const bf16x8& blo, float biasd, LAS unsigned char* lds, int tid) {
    LAS float* LR = (LAS float*)(lds + (cur ? L_LR2 : L_LR)); LAS float* Bm = (LAS float*)(lds + L_B); LAS float* TOT = (LAS float*)(lds + L_TOT); LAS float* BT = (LAS float*)(lds + L_BT);
    const int d = tid & 63, grp = tid >> 6;
    if (grp < 4) { const int ln = tid & 63, r32_ = ln & 31, hh_ = ln >> 5, pblk = grp >> 1, dblk = grp & 1;
        const f32x4 a0 = *(const LAS f32x4*)(LR + (32 * pblk + r32_) * 16 + 8 * hh_), a1 = *(const LAS f32x4*)(LR + (32 * pblk + r32_) * 16 + 8 * hh_ + 4);
        u32x4 aw; aw.x = att::cvtpk_n(a0.x, a0.y); aw.y = att::cvtpk_n(a0.z, a0.w); aw.z = att::cvtpk_n(a1.x, a1.y); aw.w = att::cvtpk_n(a1.z, a1.w);
        f32x16 zc;
#pragma unroll
        for (int r = 0; r < 16; ++r) zc[r] = biasd;
        zc = __builtin_amdgcn_mfma_f32_32x32x16_bf16(__builtin_bit_cast(bf16x8, aw), bhi, zc, 0, 0, 0);
        zc = __builtin_amdgcn_mfma_f32_32x32x16_bf16(__builtin_bit_cast(bf16x8, aw), blo, zc, 0, 0, 0);
#pragma unroll
        for (int r = 0; r < 16; ++r) Bm[(32 * pblk + crow(r, hh_)) * 64 + 32 * dblk + r32_] = zc[r]; }
    __syncthreads();
    float la[8];
#pragma unroll
    for (int i = 0; i < 8; ++i) { const int p = grp * 8 + i; const float z = Bm[p * 64 + d];
        const float t = __builtin_amdgcn_exp2f(-fabsf(z) * LOG2E);
        la[i] = (fminf(z, 0.f) * LOG2E - __builtin_amdgcn_logf(1.f + t)) * (1.f / 16.f); }
    if (dir == 0) {
#pragma unroll
        for (int i = 1; i < 8; ++i) la[i] += la[i - 1];
        TOT[grp * 64 + d] = la[7];
    } else {
#pragma unroll
        for (int i = 6; i >= 0; --i) la[i] += la[i + 1];
        TOT[grp * 64 + d] = la[0];
    }
    __syncthreads();
    float pre = 0.f, tot = 0.f;
#pragma unroll
    for (int g = 0; g < 8; ++g) { const float tv = TOT[g * 64 + d]; tot += tv; if (dir == 0 ? (g < grp) : (g > grp)) pre += tv; }
#pragma unroll
    for (int i = 0; i < 8; ++i) Bm[(grp * 8 + i) * 64 + d] = la[i] + pre;
    if (grp == 0) BT[d] = __builtin_amdgcn_exp2f(tot);
    __syncthreads();
    { const int pr = tid >> 3, dk0 = (tid & 7) * 8;
      float qt[8], kt[8];
#pragma unroll
      for (int i = 0; i < 8; ++i) { const unsigned wk = C.k[i >> 1]; const float bb = Bm[pr * 64 + dk0 + i];
          kt[i] = bf2f((i & 1) ? (wk >> 16) : (wk & 0xffffu)) * __builtin_amdgcn_exp2f(-bb);
          if (NEEDQ) { const unsigned wq = C.q[i >> 1]; qt[i] = bf2f((i & 1) ? (wq >> 16) : (wq & 0xffffu)) * __builtin_amdgcn_exp2f(bb); } }
      u32x4 wk4; wk4.x = cvt_pk_bf16(kt[0], kt[1]); wk4.y = cvt_pk_bf16(kt[2], kt[3]); wk4.z = cvt_pk_bf16(kt[4], kt[5]); wk4.w = cvt_pk_bf16(kt[6], kt[7]);
      *(LAS u32x4*)(lds + L_KT + pr * QSTR + dk0 * 2) = wk4;
      if (NEEDQ) { u32x4 wq4; wq4.x = cvt_pk_bf16(qt[0], qt[1]); wq4.y = cvt_pk_bf16(qt[2], qt[3]); wq4.z = cvt_pk_bf16(qt[4], qt[5]); wq4.w = cvt_pk_bf16(qt[6], qt[7]);
          *(LAS u32x4*)(lds + L_QT + pr * QSTR + dk0 * 2) = wq4; } }
    if (stage_next) stage_vlr(N, cur ^ 1, lds, tid);
    __syncthreads();
    return tot;
}
__device__ __forceinline__ void state_update(f32x16& S, int mb, int nb, int LV, LAS unsigned char* lds, int hh, int q4, int pp4, int g1) {
#pragma unroll
    for (int s = 0; s < 4; ++s) {
        LAS unsigned char* kb = lds + L_KT + (16 * s + 8 * hh + q4) * QSTR + (32 * mb + 16 * g1 + 4 * pp4) * 2;
        LAS unsigned char* vb = lds + LV + (16 * s + 8 * hh + q4) * VSTR + (32 * nb + 16 * g1 + 4 * pp4) * 2;
        const s16x4 alo = vtr(kb), ahi = vtr(kb + 4 * QSTR), blo = vtr(vb), bhi = vtr(vb + 4 * VSTR);
        S = __builtin_amdgcn_mfma_f32_32x32x16_bf16((bf16x8){alo[0], alo[1], alo[2], alo[3], ahi[0], ahi[1], ahi[2], ahi[3]},
                                                    (bf16x8){blo[0], blo[1], blo[2], blo[3], bhi[0], bhi[1], bhi[2], bhi[3]}, S, 0, 0, 0);
    }
    LAS float* BT = (LAS float*)(lds + L_BT);
#pragma unroll
    for (int r = 0; r < 16; ++r) S[r] *= BT[32 * mb + crow(r, hh)];
}
__device__ __forceinline__ void load_gate_b(bf16x8& bhi, bf16x8& blo, float& biasd, const Params& p, int head, int dir, int tid) {
    const float* wa2 = dir ? p.in[11] : p.in[9]; const float* ba = dir ? p.in[12] : p.in[10];
    const int ln = tid & 63, r32_ = ln & 31, hh_ = ln >> 5, dblk = (tid >> 6) & 1, dcol = head * 64 + 32 * dblk + r32_;
    float wv[8], hf[8];
#pragma unroll
    for (int j = 0; j < 8; ++j) { wv[j] = wa2[(8 * hh_ + j) * 256 + dcol]; hf[j] = __uint_as_float(att::cvtpk_n(wv[j], 0.f) << 16); }
    u32x4 h4, l4;
    h4.x = att::cvtpk_n(hf[0], hf[1]); h4.y = att::cvtpk_n(hf[2], hf[3]); h4.z = att::cvtpk_n(hf[4], hf[5]); h4.w = att::cvtpk_n(hf[6], hf[7]);
    l4.x = att::cvtpk_n(wv[0] - hf[0], wv[1] - hf[1]); l4.y = att::cvtpk_n(wv[2] - hf[2], wv[3] - hf[3]); l4.z = att::cvtpk_n(wv[4] - hf[4], wv[5] - hf[5]); l4.w = att::cvtpk_n(wv[6] - hf[6], wv[7] - hf[7]);
    bhi = __builtin_bit_cast(bf16x8, h4); blo = __builtin_bit_cast(bf16x8, l4); biasd = ba[dcol];
}

__device__ __forceinline__ void passA(const Params& p, const bf16* Hb, float* SEG, float* LG, LAS unsigned char* lds, int bid, int G, int wave_u) {
    const int tid_l = tid_of(wave_u);
    const int tid = tid_l, lane = tid & 63, wid = __builtin_amdgcn_readfirstlane(tid >> 6), r32 = lane & 31, hh = lane >> 5;
    const int mb = wid >> 2, nb = wid & 3, q4 = (lane & 15) >> 2, pp4 = lane & 3, g1 = (lane >> 4) & 1;
    for (int si = bid; si < 512; si += G) {
        const int dir = si & 1, head = (si >> 1) & 3, sg = si >> 3;
        bf16x8 bhi, blo; float biasd; load_gate_b(bhi, blo, biasd, p, head, dir, tid);
        f32x16 S;
#pragma unroll
        for (int r = 0; r < 16; ++r) S[r] = 0.f;
        float lg = 0.f;
        ChunkRegs R;
        chunk_load<false>(R, Hb, (sg * SEGC + (dir ? SEGC - 1 : 0)) * 64, head, dir, tid);
        __syncthreads();
        stage_vlr(R, 0, lds, tid);
        __syncthreads();
        for (int n = 0; n < SEGC; ++n) {
            const ChunkRegs C = R; const int cur = n & 1;
            if (n + 1 < SEGC) chunk_load<false>(R, Hb, (sg * SEGC + (dir ? SEGC - 2 - n : n + 1)) * 64, head, dir, tid);
            lg += chunk_front<false>(C, R, n + 1 < SEGC, cur, dir, bhi, blo, biasd, lds, tid);
            state_update(S, mb, nb, cur ? L_V2 : L_V, lds, hh, q4, pp4, g1);
        }
        float* Up = SEG + (size_t)si * 8192;
#pragma unroll
        for (int r = 0; r < 16; ++r) Up[(32 * mb + crow(r, hh)) * 128 + 32 * nb + r32] = S[r];
        if (tid < 64) LG[si * 64 + tid] = lg;
    }
}
__device__ __forceinline__ void passB(float* SEG, const float* LG, int bid, int G, int wave_u) {
    const int tid_l = tid_of(wave_u);
    const int gt = bid * NTHREADS + tid_l, NTH = G * NTHREADS;
    for (int v = gt; v < 80 * 2048; v += NTH) {
        const int chain = v >> 11, e4 = v & 2047, dir = chain & 1, head = (chain >> 1) & 3, seq = chain >> 3;
        const int sg0 = seq < 2 ? seq * 16 : 32 + (seq - 2) * 4, ns = seq < 2 ? 16 : 4;
        f32x4 S = (f32x4){0.f, 0.f, 0.f, 0.f};
        for (int n = 0; n < ns; ++n) { const int si = ((sg0 + (dir ? ns - 1 - n : n)) * 4 + head) * 2 + dir;
            float* ptr = SEG + (size_t)si * 8192 + e4 * 4; const f32x4 u = *(const f32x4*)ptr; const float g = __builtin_amdgcn_exp2f(LG[si * 64 + (e4 >> 5)]);
            *(f32x4*)ptr = S; S = S * g + u; }
    }
}
__device__ __forceinline__ void passC(const Params& p, const bf16* Hb, const float* SEG, float* Z0, bf16* MIX, LAS unsigned char* lds, int bid, int G, int wave_u) {
    const int tid_l = tid_of(wave_u);
    const int tid = tid_l, lane = tid & 63, wid = __builtin_amdgcn_readfirstlane(tid >> 6), r32 = lane & 31, hh = lane >> 5;
    const int pb = wid >> 2, db = wid & 3, q4 = (lane & 15) >> 2, pp4 = lane & 3, g1 = (lane >> 4) & 1;
    for (int item = bid; item < 256; item += G) {
        const int head = item & 3, sg = item >> 2;
        for (int dir = 0; dir < 2; ++dir) {
            bf16x8 bhi, blo; float biasd; load_gate_b(bhi, blo, biasd, p, head, dir, tid);
            f32x16 S0, S1;
            { const float* Sp = SEG + (size_t)((sg * 4 + head) * 2 + dir) * 8192 + 32 * db + r32;
#pragma unroll
              for (int r = 0; r < 16; ++r) { S0[r] = Sp[crow(r, hh) * 128]; S1[r] = Sp[(32 + crow(r, hh)) * 128]; } }
            ChunkRegs R;
            chunk_load<true>(R, Hb, (sg * SEGC + (dir ? SEGC - 1 : 0)) * 64, head, dir, tid);
            __syncthreads();
            stage_vlr(R, 0, lds, tid);
            __syncthreads();
            for (int n = 0; n < SEGC; ++n) {
                const int rowbase = (sg * SEGC + (dir ? SEGC - 1 - n : n)) * 64;
                const ChunkRegs C = R; const int cur = n & 1; const int LV = cur ? L_V2 : L_V;
                if (n + 1 < SEGC) chunk_load<true>(R, Hb, (sg * SEGC + (dir ? SEGC - 2 - n : n + 1)) * 64, head, dir, tid);
                f32x16 Z;
                const unsigned zoff = (unsigned)(((rowbase + 32 * pb + 4 * hh) * 512 + head * 128 + 32 * db + r32) * 4);
                char* Zc = (char*)Z0;
                if (dir == 0) {
#pragma unroll
                    for (int r = 0; r < 16; ++r) Z[r] = 0.f;
                } else {
#pragma unroll
                    for (int r = 0; r < 16; ++r) Z[r] = *(const float*)(Zc + (size_t)(zoff + (unsigned)(((r & 3) + 8 * (r >> 2)) * 2048)));
                }
                (void)chunk_front<true>(C, R, n + 1 < SEGC, cur, dir, bhi, blo, biasd, lds, tid);
                for (int mbp = 0; mbp < 2; ++mbp) {
                    if (dir == 0 ? (mbp > pb) : (mbp < pb)) continue;
                    f32x16 X;
#pragma unroll
                    for (int r = 0; r < 16; ++r) X[r] = 0.f;
#pragma unroll
                    for (int s = 0; s < 4; ++s) {
                        const bf16x8 a = *(LAS bf16x8*)(lds + L_KT + (32 * mbp + r32) * QSTR + (16 * s + 8 * hh) * 2);
                        const bf16x8 b = *(LAS bf16x8*)(lds + L_QT + (32 * pb + r32) * QSTR + (16 * s + 8 * hh) * 2);
                        X = __builtin_amdgcn_mfma_f32_32x32x16_bf16(a, b, X, 0, 0, 0);
                    }
#pragma unroll
                    for (int r = 0; r < 16; ++r) { const int pk = 32 * mbp + crow(r, hh), pq = 32 * pb + r32; const bool keep = dir == 0 ? (pk <= pq) : (pk >= pq); X[r] = keep ? X[r] : 0.f; }
#pragma unroll
                    for (int s2 = 0; s2 < 2; ++s2) {
                        u32x4 ww; ww.x = cvt_pk_bf16(X[8 * s2 + 0], X[8 * s2 + 1]); ww.y = cvt_pk_bf16(X[8 * s2 + 2], X[8 * s2 + 3]); ww.z = cvt_pk_bf16(X[8 * s2 + 4], X[8 * s2 + 5]); ww.w = cvt_pk_bf16(X[8 * s2 + 6], X[8 * s2 + 7]);
                        LAS unsigned char* vb = lds + LV + (32 * mbp + 16 * s2 + 4 * hh + q4) * VSTR + (32 * db + 16 * g1 + 4 * pp4) * 2;
                        const s16x4 lo = vtr(vb), hi = vtr(vb + 8 * VSTR);
                        Z = __builtin_amdgcn_mfma_f32_32x32x16_bf16(__builtin_bit_cast(bf16x8, ww), (bf16x8){lo[0], lo[1], lo[2], lo[3], hi[0], hi[1], hi[2], hi[3]}, Z, 0, 0, 0);
                    }
                }
#pragma unroll
                for (int mbs = 0; mbs < 2; ++mbs)
#pragma unroll
                    for (int s2 = 0; s2 < 2; ++s2) {
                        u32x4 ww;
                        if (mbs == 0) { ww.x = cvt_pk_bf16(S0[8 * s2 + 0], S0[8 * s2 + 1]); ww.y = cvt_pk_bf16(S0[8 * s2 + 2], S0[8 * s2 + 3]); ww.z = cvt_pk_bf16(S0[8 * s2 + 4], S0[8 * s2 + 5]); ww.w = cvt_pk_bf16(S0[8 * s2 + 6], S0[8 * s2 + 7]); }
                        else { ww.x = cvt_pk_bf16(S1[8 * s2 + 0], S1[8 * s2 + 1]); ww.y = cvt_pk_bf16(S1[8 * s2 + 2], S1[8 * s2 + 3]); ww.z = cvt_pk_bf16(S1[8 * s2 + 4], S1[8 * s2 + 5]); ww.w = cvt_pk_bf16(S1[8 * s2 + 6], S1[8 * s2 + 7]); }
                        LAS unsigned char* qa = lds + L_QT + (32 * pb + r32) * QSTR + (32 * mbs + 16 * s2 + 4 * hh) * 2;
                        const u32x2 alo = *(LAS u32x2*)qa, ahi = *(LAS u32x2*)(qa + 16);
                        const u32x4 aw = (u32x4){alo.x, alo.y, ahi.x, ahi.y};
                        Z = __builtin_amdgcn_mfma_f32_32x32x16_bf16(__builtin_bit_cast(bf16x8, aw), __builtin_bit_cast(bf16x8, ww), Z, 0, 0, 0);
                    }
                state_update(S0, 0, db, LV, lds, hh, q4, pp4, g1);
                state_update(S1, 1, db, LV, lds, hh, q4, pp4, g1);
                if (dir == 0) {
#pragma unroll
                    for (int r = 0; r < 16; ++r) *(float*)(Zc + (size_t)(zoff + (unsigned)(((r & 3) + 8 * (r >> 2)) * 2048))) = Z[r];
                } else {
                    LAS float* Zl = (LAS float*)(lds + L_Z);
#pragma unroll
                    for (int r = 0; r < 16; ++r) Zl[(32 * pb + crow(r, hh)) * ZS + 32 * db + r32] = Z[r];
                    __syncthreads();
                    { const int pr = tid >> 3, dv0 = (tid & 7) * 16;
                      float v[16]; float ss = 0.f;
#pragma unroll
                      for (int i = 0; i < 16; ++i) { v[i] = Zl[pr * ZS + dv0 + i]; ss += v[i] * v[i]; }
                      ss += __shfl_xor(ss, 1); ss += __shfl_xor(ss, 2); ss += __shfl_xor(ss, 4);
                      const float rn = __builtin_amdgcn_rsqf(ss * (1.f / 128.f) + 1e-5f);
                      const bf16* grp_ = Hb + (size_t)(rowbase + pr) * LDH + O_GR + head * 128 + dv0;
                      const u32x4 g0 = *(const u32x4*)grp_, g1v = *(const u32x4*)(grp_ + 8);
                      const float* gn = p.in[13] + dv0;
                      float o[16];
#pragma unroll
                      for (int i = 0; i < 16; ++i) { const unsigned wv = (i < 8) ? g0[i >> 1] : g1v[(i - 8) >> 1]; const float gr = bf2f((i & 1) ? (wv >> 16) : (wv & 0xffffu));
                          const float sl = gr * __builtin_amdgcn_rcpf(1.f + fexp(-gr)); o[i] = v[i] * rn * gn[i] * sl; }
                      u32x4 a, b; a.x = cvt_pk_bf16(o[0], o[1]); a.y = cvt_pk_bf16(o[2], o[3]); a.z = cvt_pk_bf16(o[4], o[5]); a.w = cvt_pk_bf16(o[6], o[7]);
                      b.x = cvt_pk_bf16(o[8], o[9]); b.y = cvt_pk_bf16(o[10], o[11]); b.z = cvt_pk_bf16(o[12], o[13]); b.w = cvt_pk_bf16(o[14], o[15]);
                      bf16* orow = MIX + (size_t)(rowbase + pr) * D + 512 + head * 128 + dv0;
                      *(u32x4*)orow = a; *(u32x4*)(orow + 8) = b; }
                }
            }
        }
    }
}
}
__global__ void __launch_bounds__(NTHREADS) mega(Params p) {
    extern __shared__ __attribute__((aligned(16))) unsigned char lds_raw[];
    LAS unsigned char* lds = (LAS unsigned char*)lds_raw;
    cg::grid_group grid = cg::this_grid();
    const int tid = threadIdx.x, lane = tid & 63, wave = __builtin_amdgcn_readfirstlane(tid >> 6);
    const int G = gridDim.x, bid = blockIdx.x;
    unsigned char* ws = p.ws;
    bf16* WTin = (bf16*)(ws + WS_WIN); bf16* WTo = (bf16*)(ws + WS_WO); bf16* WT1 = (bf16*)(ws + WS_W1); bf16* WT2 = (bf16*)(ws + WS_W2);
    bf16* Hb = (bf16*)(ws + WS_H); bf16* XB = (bf16*)(ws + WS_XB); bf16* MIX = (bf16*)(ws + WS_MIX); bf16* X1B = (bf16*)(ws + WS_X1B); bf16* HID = (bf16*)(ws + WS_HID);
    float* ST = (float*)(ws + WS_ST); float* SEG = (float*)(ws + WS_ST + 128 * MiB); float* LG = (float*)(ws + WS_GG);
    unsigned* ctl = (unsigned*)(ws + WS_CTL);
    bf16* Y1B = (bf16*)p.out;
    bf16* Y2B = (bf16*)(ws + WS_MIX);
    bf16* KD = (bf16*)(ws + WS_KD); bf16* VD = (bf16*)(ws + WS_VD);
    const int lo = p.ph_lo, hi = p.ph_hi;
    volatile LAS unsigned* xst = (volatile LAS unsigned*)(lds + 160 * 1024 - 128);
    if (tid < 2) xst[tid] = 0u;
    __syncthreads();
    const XcdBarrier xbar = xcd_barrier_post(ctl + 1024, xst, wave);
    if (hi > 1000) grid.sync();
#ifndef R_P0
#define R_P0 1
#endif
#ifndef R_G1
#define R_G1 1
#endif
#ifndef R_G2
#define R_G2 1
#endif
#define IN(k) (lo <= (k) && (k) < hi)
#define SEAM(k) do { if (IN(k) && IN((k) + 1)) { xcd_barrier(xbar); } } while (0)
    const int gw = bid * NWAVES + wave, NGW = G * NWAVES;

for (int rp_ = 0; rp_ < R_P0; ++rp_) {     if (IN(0)) {
        if (bid == 0 && tid < 256) ctl[tid] = 0u;
        LAS float* scr = (LAS float*)(lds + wave * 16384);
        constexpr int I_IN = (D / 64) * (DIN / 32), I_O = (D / 64) * (D / 32), I_1 = (D / 64) * (FF / 32), I_2 = (FF / 64) * (D / 32);
        constexpr int NITEMS = I_IN + I_O + I_1 + I_2;
        for (int it = gw; it < NITEMS; it += NGW) {
            int r = it;
            if (r < I_IN) { p0_transpose_item(p.in[2], D, DIN, WTin, scr, r, lane); continue; } r -= I_IN;
            if (r < I_O) { p0_transpose_item(p.in[3], D, D, WTo, scr, r, lane); continue; } r -= I_O;
            if (r < I_1) { p0_transpose_item(p.in[16], D, FF, WT1, scr, r, lane); continue; } r -= I_1;
            p0_transpose_item(p.in[17], FF, D, WT2, scr, r, lane);
        }
        { u32x4* z = (u32x4*)(WTin + (size_t)DIN * D); const int nz = (DIN_PAD - DIN) * D * 2 / 16;
          for (int i = bid * NTHREADS + tid; i < nz; i += G * NTHREADS) z[i] = (u32x4){0u, 0u, 0u, 0u}; }
        { const int ln0 = tid_of(wave) & 63;
        for (int m = gw * 2; m < M; m += NGW * 2) {
            f32x4 v[2][4];
#pragma unroll
            for (int r = 0; r < 2; ++r) { const f32x4* xr = (const f32x4*)xrow_ptr(p, m + r) + ln0;
#pragma unroll
                for (int j = 0; j < 4; ++j) v[r][j] = xr[64 * j]; }
#pragma unroll
            for (int r = 0; r < 2; ++r) { u32x2* o = (u32x2*)(XB + (size_t)(m + r) * D) + ln0;
#pragma unroll
                for (int j = 0; j < 4; ++j) { u32x2 w; w.x = cvt_pk_bf16(v[r][j].x, v[r][j].y); w.y = cvt_pk_bf16(v[r][j].z, v[r][j].w); o[64 * j] = w; } }
        } }
#if MIXER_STAGE < 1
        { u32x4* z = (u32x4*)MIX; const size_t nz = (size_t)M * D * 2 / 16;
          for (size_t i = (size_t)bid * NTHREADS + tid; i < nz; i += (size_t)G * NTHREADS) z[i] = (u32x4){0u, 0u, 0u, 0u}; }
#endif
    } }
    SEAM(0);
for (int rp_ = 0; rp_ < R_G1; ++rp_) {     if (IN(1)) {
#if MIXER_STAGE >= 1
        pg8::Gemm g{XB, WTin, M, DIN_PAD, D}; pg8::StaticOrder S; S.init(M, DIN_PAD, G, bid);
        pg8::EpiH E{Hb, LDH, DIN, C1, KD, VD};
        pg8::gemm_phase<pg8::EpiH, pg8::StaticOrder, true, true>(lds, g, S, E, wave);
#endif
    } }
    SEAM(1);
#ifndef GLA_REPS
#define GLA_REPS 1
#endif
#ifndef ATT_REPS
#define ATT_REPS 1
#endif
    for (int rep = 0; rep < GLA_REPS; ++rep) {
    if (IN(2)) {
#if MIXER_STAGE >= 1
        if (rep == 0) att::knorm_phase(KD, ctl, bid, G, wave);
#endif
#if MIXER_STAGE >= 2
        gla::passA(p, Hb, SEG, LG, lds, bid, G, wave);
#endif
    }
    SEAM(2);
    if (IN(3)) {
#if MIXER_STAGE >= 2
        gla::passB(SEG, LG, bid, G, wave);
#endif
    }
    SEAM(3);
    }
    if (IN(4)) {
#if MIXER_STAGE >= 2
        for (int rep = 0; rep < GLA_REPS; ++rep) gla::passC(p, Hb, SEG, ST, MIX, lds, bid, G, wave);
#endif
#if MIXER_STAGE >= 1
        att::attn_phase(p, Hb, KD, VD, MIX, ctl, lds, bid, G, wave);
#endif
    }
    SEAM(4);
for (int rp_ = 0; rp_ < R_G1; ++rp_) {     if (IN(5)) {
        pg8::Gemm g{MIX, WTo, M, D, D}; pg8::StaticOrder S; S.init(M, D, G, bid);
        pg8::EpiResB E{nullptr, nullptr, XB, Y1B, ALPHA};
        pg8::gemm_phase<pg8::EpiResB, pg8::StaticOrder, true, true>(lds, g, S, E, wave);
    } }
    SEAM(5);
for (int rp_ = 0; rp_ < R_P0; ++rp_) {     if (IN(6)) { const int ln_ = tid_of(wave) & 63; for (int m = gw * 4; m < M; m += NGW * 4) ln_rows4_b(Y1B + (size_t)m * D, nullptr, X1B + (size_t)m * D, p.in[14], p.in[15], ln_); } }
    SEAM(6);
for (int rp_ = 0; rp_ < R_G2; ++rp_) {     if (IN(7)) {
        pg8::Gemm g{X1B, WT1, M, FF, D}; pg8::StaticOrder S; S.init(M, FF, G, bid);
        pg8::EpiHid E{HID, FF};
        pg8::gemm_phase<pg8::EpiHid, pg8::StaticOrder, true, true>(lds, g, S, E, wave);
    } }
    SEAM(7);
for (int rp_ = 0; rp_ < R_G2; ++rp_) {     if (IN(8)) {
        pg8::Gemm g{HID, WT2, M, D, FF}; pg8::StaticOrder S; S.init(M, D, G, bid);
        pg8::EpiResB E{nullptr, nullptr, X1B, Y2B, ALPHA};
        pg8::gemm_phase<pg8::EpiResB, pg8::StaticOrder, true, true>(lds, g, S, E, wave);
    } }
    SEAM(8);
for (int rp_ = 0; rp_ < R_P0; ++rp_) {     if (IN(9)) { const int ln_ = tid_of(wave) & 63; for (int m = gw * 4; m < M; m += NGW * 4) ln_rows4_b(Y2B + (size_t)m * D, p.out + (size_t)m * D, nullptr, p.in[18], p.in[19], ln_); } }
#undef IN
#undef SEAM
}

extern "C" void kernel_launch(void* const* d_in, const int* in_sizes, int n_in, void* d_out, int out_size,
                              void* d_ws, size_t ws_size, hipStream_t stream) {
    static int grid = 0;
    if (grid == 0) {
        if (n_in != 20 || out_size != M * D || ws_size < WS_END) { fprintf(stderr, "kernel_launch: unexpected shapes (n_in %d out %d ws %zu)\n", n_in, out_size, ws_size); grid = -1; return; }
        int dev = 0, cus = 0, per_cu = 0;
        (void)hipGetDevice(&dev);
        (void)hipDeviceGetAttribute(&cus, hipDeviceAttributeMultiprocessorCount, dev);
        (void)hipFuncSetAttribute((const void*)mega, hipFuncAttributeMaxDynamicSharedMemorySize, LDS_BYTES);
        (void)hipOccupancyMaxActiveBlocksPerMultiprocessor(&per_cu, (const void*)mega, NTHREADS, LDS_BYTES);
        (void)hipGetLastError();
        grid = cus;
        fprintf(stderr, "kernel_launch: grid %d (cus %d, occupancy query %d/CU), ws %zu\n", grid, cus, per_cu, ws_size);
    }
    if (grid < 0) return;
    (void)hipMemsetAsync(d_ws, 0, 65536, stream);
    Params p{};
    for (int i = 0; i < 20; ++i) p.in[i] = (const float*)d_in[i];
    p.out = (float*)d_out; p.ws = (unsigned char*)d_ws; p.ph_lo = 0; p.ph_hi = 10;
    void* args[] = {&p};
    hipError_t e = hipLaunchCooperativeKernel((const void*)mega, dim3(grid), dim3(NTHREADS), args, LDS_BYTES, stream);
    if (e != hipSuccess) fprintf(stderr, "cooperative launch failed: %s\n", hipGetErrorString(e));
}
```

```cpp
#include <hip/hip_runtime.h>
#include <hip/hip_cooperative_groups.h>
#include <cstdio>
#include <cstdint>
namespace cg = cooperative_groups;
__device__ __forceinline__ int tid_of(int wave_u) { int t; asm volatile("v_mbcnt_lo_u32_b32 %0, -1, 0\n\tv_mbcnt_hi_u32_b32 %0, -1, %0" : "=v"(t)); return t | (wave_u << 6); }
#define MIXER_STAGE 2
namespace pg8 {
#define PG8_LAS __attribute__((address_space(3)))
typedef unsigned short bf16_t;
typedef short bf16x8 __attribute__((ext_vector_type(8)));
typedef float f32x4 __attribute__((ext_vector_type(4)));
typedef unsigned u32x4 __attribute__((ext_vector_type(4)));
constexpr int BM = 256, BK = 64, HALF = 128, HTB = HALF * BK * 2  , STAGE_BYTES = 8 * HTB, NXCD = 8, WGM = 8;

__host__ __device__ __forceinline__ int lds_byte(int r, int c) { const int st = (r >> 4) * 2 + (c >> 5), rr = r & 15, cc = c & 31, ob = rr * 64 + cc * 2; return st * 1024 + (ob ^ (((ob >> 9) & 1) << 5)); }
__host__ __device__ __forceinline__ void stage_rc(int b, int& R, int& C) { const int st = b / 1024, sb = b % 1024, swz = sb ^ (((sb >> 9) & 1) << 5); R = (st >> 1) * 16 + swz / 64; C = (st & 1) * 32 + (swz % 64) / 2; }
__host__ __device__ __forceinline__ int perm32(int rho) { const int n = rho >> 4, i = rho & 15; return 8 * (i >> 2) + 4 * n + (i & 3); }

struct Unit { int pm, pn; };
struct Gemm { const bf16_t* A; const bf16_t* Bt; int M, N, K; };

struct StaticOrder {
    int nM, nN, nwg, G, c;
    __host__ __device__ void init(int M, int N, int G_, int c_) { nM = M / BM; nN = N / BM; nwg = nM * nN; G = G_; c = c_; }
    __host__ __device__ bool next(int i, Unit& u) const {
        const long L = (long)i * G + c; if (L >= nwg) return false;
        int wgid = (int)L; { const int q = nwg / NXCD, r = nwg % NXCD, xcd = wgid % NXCD, off = wgid / NXCD; wgid = (xcd < r ? xcd * (q + 1) : r * (q + 1) + (xcd - r) * q) + off; }
        const int nig = WGM * nN, gid = wgid / nig, fm = gid * WGM, gsz = (nM - fm) < WGM ? (nM - fm) : WGM;
        u.pm = fm + ((wgid % nig) % gsz); u.pn = (wgid % nig) / gsz; return true;
    }
    __device__ __forceinline__ void a_ready(const Unit&) const {}
    __device__ __forceinline__ void done(const Unit&) const {}
};

__device__ __forceinline__ unsigned cvt_pk_bf16(float lo, float hi) { unsigned r; asm volatile("v_cvt_pk_bf16_f32 %0, %1, %2" : "=v"(r) : "v"(lo), "v"(hi)); return r; }
constexpr int M_TOK = 65536, NPROMPT = 32768, DMODEL = 1024;
struct EpiH {
    static constexpr bool PERM = true, AFTER_DRAIN = false;
    bf16_t* O; int ldc; int nvalid; float c1; bf16_t* KD; bf16_t* VD;
    __device__ __forceinline__ void operator()(const f32x4 (&acc)[2][2][4][2], const Unit& u, int wr, int wc, int fr, int fq) const {
        const int row0 = u.pm * BM + wr * 64 + fr;
        const int col0 = u.pn * BM + wc * 32 + 8 * fq;
        const float sc = (u.pn < 2) ? c1 : (u.pn == 6 ? 0.125f : 1.0f);
        const bool dense = (u.pn >= 2) && (u.pn < 6);
        bf16_t* db = (u.pn < 4) ? KD : VD;
        const int crel = col0 - ((u.pn < 4) ? 512 : 1024);
#pragma unroll
        for (int ai = 0; ai < 2; ++ai)
#pragma unroll
            for (int m = 0; m < 4; ++m) { const int row = row0 + ai * HALF + m * 16; bf16_t* rowp = O + (size_t)row * ldc + col0;
#pragma unroll
                for (int bj = 0; bj < 2; ++bj) { if (col0 + bj * HALF < nvalid) { const f32x4 v0 = acc[ai][bj][m][0] * sc, v1 = acc[ai][bj][m][1] * sc;
                    u32x4 w; w.x = cvt_pk_bf16(v0[0], v0[1]); w.y = cvt_pk_bf16(v0[2], v0[3]); w.z = cvt_pk_bf16(v1[0], v1[1]); w.w = cvt_pk_bf16(v1[2], v1[3]);
                    if (dense) { const int cr = crel + bj * HALF; *(u32x4*)(db + ((size_t)(cr >> 7) * M_TOK + row) * 128 + (cr & 127)) = w; }
                    else *(u32x4*)(rowp + bj * HALF) = w; } } }
    }
};
struct EpiHid {
    static constexpr bool PERM = true, AFTER_DRAIN = false;
    bf16_t* O; int ldc;
    __device__ __forceinline__ void operator()(const f32x4 (&acc)[2][2][4][2], const Unit& u, int wr, int wc, int fr, int fq) const {
        const int row0 = u.pm * BM + wr * 64 + fr;
        const int col0 = u.pn * BM + wc * 32 + 8 * fq;
#pragma unroll
        for (int ai = 0; ai < 2; ++ai)
#pragma unroll
            for (int m = 0; m < 4; ++m) { bf16_t* rowp = O + (size_t)(row0 + ai * HALF + m * 16) * ldc + col0;
#pragma unroll
                for (int bj = 0; bj < 2; ++bj) { f32x4 v0 = acc[ai][bj][m][0], v1 = acc[ai][bj][m][1];
#pragma unroll
                    for (int e = 0; e < 4; ++e) { const float a = fmaxf(v0[e], 0.f), b = fmaxf(v1[e], 0.f); v0[e] = a * a; v1[e] = b * b; }
                    u32x4 w; w.x = cvt_pk_bf16(v0[0], v0[1]); w.y = cvt_pk_bf16(v0[2], v0[3]); w.z = cvt_pk_bf16(v1[0], v1[1]); w.w = cvt_pk_bf16(v1[2], v1[3]);
                    *(u32x4*)(rowp + bj * HALF) = w; } }
    }
};
struct EpiRes {
    static constexpr bool PERM = false, AFTER_DRAIN = false;
    const float* xp; const float* xs; float* out; float alpha;
    __device__ __forceinline__ void operator()(const f32x4 (&acc)[2][2][4][2], const Unit& u, int wr, int wc, int fr, int fq) const {
        const int col0 = u.pn * BM + wc * 32 + 4 * fq;
#pragma unroll
        for (int ai = 0; ai < 2; ++ai)
#pragma unroll
            for (int m = 0; m < 4; ++m) { const int row = u.pm * BM + ai * HALF + wr * 64 + m * 16 + fr;
                float* orow = out + (size_t)row * DMODEL;
                const float* xr = xp ? ((row < NPROMPT) ? xp + (size_t)row * DMODEL : xs + (size_t)(row - NPROMPT) * DMODEL) : orow;
#pragma unroll
                for (int bj = 0; bj < 2; ++bj)
#pragma unroll
                    for (int n = 0; n < 2; ++n) { const int c = col0 + bj * HALF + n * 16; const f32x4 xv = *(const f32x4*)(xr + c); *(f32x4*)(orow + c) = xv * alpha + acc[ai][bj][m][n]; } }
    }
};


struct EpiResB {
    static constexpr bool PERM = true, AFTER_DRAIN = false;
    const float* xp; const float* xs; const bf16_t* RB; bf16_t* Y; float alpha;
    __device__ __forceinline__ void operator()(const f32x4 (&acc)[2][2][4][2], const Unit& u, int wr, int wc, int fr, int fq) const {
        const int col0 = u.pn * BM + wc * 32 + 8 * fq;
#pragma unroll
        for (int ai = 0; ai < 2; ++ai)
#pragma unroll
            for (int m = 0; m < 4; ++m) { const int row = u.pm * BM + ai * HALF + wr * 64 + m * 16 + fr;
#pragma unroll
                for (int bj = 0; bj < 2; ++bj) { const int c = col0 + bj * HALF;
                    f32x4 r0, r1;
                    if (xp) { const float* xr = ((row < NPROMPT) ? xp + (size_t)row * DMODEL : xs + (size_t)(row - NPROMPT) * DMODEL) + c; r0 = *(const f32x4*)xr; r1 = *(const f32x4*)(xr + 4); }
                    else { const u32x4 w = *(const u32x4*)(RB + (size_t)row * DMODEL + c);
                        r0 = (f32x4){__uint_as_float(w.x << 16), __uint_as_float(w.x & 0xffff0000u), __uint_as_float(w.y << 16), __uint_as_float(w.y & 0xffff0000u)};
                        r1 = (f32x4){__uint_as_float(w.z << 16), __uint_as_float(w.z & 0xffff0000u), __uint_as_float(w.w << 16), __uint_as_float(w.w & 0xffff0000u)}; }
                    const f32x4 v0 = r0 * alpha + acc[ai][bj][m][0], v1 = r1 * alpha + acc[ai][bj][m][1];
                    u32x4 o; o.x = cvt_pk_bf16(v0[0], v0[1]); o.y = cvt_pk_bf16(v0[2], v0[3]); o.z = cvt_pk_bf16(v1[0], v1[1]); o.w = cvt_pk_bf16(v1[2], v1[3]);
                    *(u32x4*)(Y + (size_t)row * DMODEL + c) = o; } }
    }
};

template <class Epi, class Sched, bool ALIGN_EPI = false, bool SP2 = false>
__device__ __forceinline__ void gemm_phase(PG8_LAS unsigned char* lds, const Gemm g, const Sched& S, const Epi& E, int wave_u) {
    const int tid_l = tid_of(wave_u);
    const int tid = tid_l, wid = __builtin_amdgcn_readfirstlane(tid >> 6), lane = tid & 63, wr = wid >> 2, wc = wid & 3, fr = lane & 15, fq = lane >> 4;
    const int K = g.K, nt = K / BK;
    unsigned voffA[2], voffB[2];
#pragma unroll
    for (int i = 0; i < 2; ++i) { int R, C; stage_rc(tid * 16 + i * 8192, R, C); const int Rb = Epi::PERM ? ((R & ~31) + perm32(R & 31)) : R;
        voffA[i] = (unsigned)(R * K + C) * 2u; voffB[i] = (unsigned)(Rb * K + C) * 2u; }
    const size_t kstep = (size_t)(BK * 2);
    const size_t hstep = (size_t)HALF * K * 2;
    const size_t tstep = 2 * hstep;
    const unsigned ldsw = (unsigned)wid * 1024u;
    const int aoff = lds_byte(wr * 64 + fr, fq * 8), boff = lds_byte(wc * 32 + fr, fq * 8);
#define PG8_SA(b, h) (((b) * 2 + (h)) * HTB)
#define PG8_SB(b, h) ((4 + (b) * 2 + (h)) * HTB)
#define PG8_STAGE(bufoff, gbase, voff) do { _Pragma("unroll") for (int _i = 0; _i < 2; ++_i) \
        __builtin_amdgcn_global_load_lds((const unsigned*)((const char*)(gbase) + (voff)[_i]), (PG8_LAS unsigned*)(lds + (bufoff) + ldsw + _i * 8192), 16, 0, 0); } while (0)
#define PG8_LDA(dst, b, h) do { _Pragma("unroll") for (int m = 0; m < 4; ++m) _Pragma("unroll") for (int k = 0; k < 2; ++k) dst[m][k] = *(const PG8_LAS bf16x8*)(lds + PG8_SA(b, h) + aoff + m * 2048 + k * 1024); } while (0)
#define PG8_LDB(dst, b, h) do { _Pragma("unroll") for (int n = 0; n < 2; ++n) _Pragma("unroll") for (int k = 0; k < 2; ++k) dst[n][k] = *(const PG8_LAS bf16x8*)(lds + PG8_SB(b, h) + boff + n * 2048 + k * 1024); } while (0)
#define PG8_MMA(ai, bj, At, Bt) do { __builtin_amdgcn_s_setprio(1); _Pragma("unroll") for (int m = 0; m < 4; ++m) _Pragma("unroll") for (int n = 0; n < 2; ++n) _Pragma("unroll") for (int k = 0; k < 2; ++k) \
        acc[ai][bj][m][n] = __builtin_amdgcn_mfma_f32_16x16x32_bf16(Bt[n][k], At[m][k], acc[ai][bj][m][n], 0, 0, 0); __builtin_amdgcn_s_setprio(0); } while (0)
#define PG8_WAIT_V(n) asm volatile("s_waitcnt vmcnt(" #n ")" ::: "memory")
#define PG8_WAIT_L(n) asm volatile("s_waitcnt lgkmcnt(" #n ")" ::: "memory")
#define PG8_BAR __builtin_amdgcn_s_barrier()
#define PG8_SCHED __builtin_amdgcn_sched_barrier(0)
    Unit cur, nxt; int ui = 0;
    if (!S.next(0, cur)) return;
    f32x4 acc[2][2][4][2];
#pragma unroll
    for (int a = 0; a < 2; ++a)
#pragma unroll
        for (int b = 0; b < 2; ++b)
#pragma unroll
            for (int m = 0; m < 4; ++m)
#pragma unroll
                for (int n = 0; n < 2; ++n) acc[a][b][m][n] = (f32x4){0.f, 0.f, 0.f, 0.f};
    bf16x8 At[4][2], B0[2][2], B1[2][2];
    const char* cA = (const char*)g.A + (size_t)cur.pm * tstep; const char* cB = (const char*)g.Bt + (size_t)cur.pn * tstep;
    S.a_ready(cur);
    if constexpr (SP2) {
        PG8_STAGE(PG8_SB(0, 0), cB, voffB); PG8_STAGE(PG8_SB(0, 1), cB + hstep, voffB); PG8_STAGE(PG8_SA(0, 0), cA, voffA); PG8_STAGE(PG8_SA(0, 1), cA + hstep, voffA);
        if (wr == 1) PG8_BAR;
        PG8_WAIT_V(2); PG8_BAR;
        PG8_STAGE(PG8_SB(1, 0), cB + kstep, voffB); PG8_STAGE(PG8_SA(1, 0), cA + kstep, voffA); PG8_STAGE(PG8_SB(1, 1), cB + hstep + kstep, voffB);
        PG8_WAIT_V(6); PG8_BAR;
    } else {
        PG8_STAGE(PG8_SB(0, 0), cB, voffB); PG8_STAGE(PG8_SA(0, 0), cA, voffA); PG8_STAGE(PG8_SB(0, 1), cB + hstep, voffB); PG8_STAGE(PG8_SA(0, 1), cA + hstep, voffA);
        if (wr == 1) PG8_BAR;
        PG8_WAIT_V(4); PG8_BAR;
        PG8_STAGE(PG8_SB(1, 0), cB + kstep, voffB); PG8_STAGE(PG8_SA(1, 0), cA + kstep, voffA); PG8_STAGE(PG8_SB(1, 1), cB + hstep + kstep, voffB);
        PG8_WAIT_V(6); PG8_BAR;
    }
    for (;;) {
        const bool has_next = S.next(ui + 1, nxt);
        const char* nA = has_next ? (const char*)g.A + (size_t)nxt.pm * tstep : cA; const char* nB = has_next ? (const char*)g.Bt + (size_t)nxt.pn * tstep : cB;
        for (int t = 0; t < nt; t += 2) {
            const bool last = (t == nt - 2);
            const char* a1 = cA + (size_t)(t + 1) * kstep;
            const char* a2 = last ? nA : cA + (size_t)(t + 2) * kstep; const char* b2 = last ? nB : cB + (size_t)(t + 2) * kstep;
            const char* a3 = a2 + kstep; const char* b3 = b2 + kstep;
            if (last && has_next) S.a_ready(nxt);
            if constexpr (SP2) {
            PG8_LDB(B0, 0, 0); PG8_LDB(B1, 0, 1); PG8_SCHED; PG8_LDA(At, 0, 0); PG8_STAGE(PG8_SA(1, 1), a1 + hstep, voffA);
            PG8_WAIT_V(8); PG8_WAIT_L(0); PG8_BAR; PG8_MMA(0, 0, At, B0); PG8_MMA(0, 1, At, B1); PG8_BAR; PG8_SCHED;
            PG8_LDA(At, 0, 1); PG8_STAGE(PG8_SB(0, 0), b2, voffB); PG8_STAGE(PG8_SB(0, 1), b2 + hstep, voffB); PG8_STAGE(PG8_SA(0, 0), a2, voffA);
            PG8_WAIT_V(8); PG8_WAIT_L(0); PG8_BAR; PG8_MMA(1, 0, At, B0); PG8_MMA(1, 1, At, B1); PG8_BAR; PG8_SCHED;
            PG8_LDB(B0, 1, 0); PG8_LDB(B1, 1, 1); PG8_SCHED; PG8_LDA(At, 1, 0); PG8_STAGE(PG8_SA(0, 1), a2 + hstep, voffA);
            PG8_WAIT_V(8); PG8_WAIT_L(0); PG8_BAR; PG8_MMA(0, 0, At, B0); PG8_MMA(0, 1, At, B1); PG8_BAR; PG8_SCHED;
            PG8_LDA(At, 1, 1); PG8_STAGE(PG8_SB(1, 0), b3, voffB); PG8_STAGE(PG8_SB(1, 1), b3 + hstep, voffB); PG8_STAGE(PG8_SA(1, 0), a3, voffA);
            PG8_WAIT_V(8); PG8_WAIT_L(0); PG8_BAR; PG8_MMA(1, 0, At, B0); PG8_MMA(1, 1, At, B1); PG8_BAR; PG8_SCHED;
            } else {
            PG8_LDB(B0, 0, 0); PG8_SCHED; PG8_LDA(At, 0, 0); PG8_STAGE(PG8_SA(1, 1), a1 + hstep, voffA);
            PG8_WAIT_L(8); PG8_BAR; PG8_WAIT_L(0); PG8_MMA(0, 0, At, B0); PG8_BAR; PG8_SCHED;
            PG8_LDB(B1, 0, 1); PG8_STAGE(PG8_SB(0, 0), b2, voffB);
            PG8_BAR; PG8_WAIT_L(0); PG8_MMA(0, 1, At, B1); PG8_BAR;
            PG8_LDA(At, 0, 1); PG8_STAGE(PG8_SA(0, 0), a2, voffA);
            PG8_BAR; PG8_WAIT_L(0); PG8_MMA(1, 0, At, B0); PG8_BAR; PG8_SCHED;
            PG8_STAGE(PG8_SB(0, 1), b2 + hstep, voffB);
            PG8_WAIT_V(6); PG8_BAR; PG8_MMA(1, 1, At, B1); PG8_BAR;
            PG8_LDB(B0, 1, 0); PG8_SCHED; PG8_LDA(At, 1, 0); PG8_STAGE(PG8_SA(0, 1), a2 + hstep, voffA);
            PG8_WAIT_L(8); PG8_BAR; PG8_WAIT_L(0); PG8_MMA(0, 0, At, B0); PG8_BAR; PG8_SCHED;
            PG8_LDB(B1, 1, 1); PG8_STAGE(PG8_SB(1, 0), b3, voffB);
            PG8_BAR; PG8_WAIT_L(0); PG8_MMA(0, 1, At, B1); PG8_BAR;
            PG8_LDA(At, 1, 1); PG8_STAGE(PG8_SA(1, 0), a3, voffA);
            PG8_BAR; PG8_WAIT_L(0); PG8_MMA(1, 0, At, B0); PG8_BAR; PG8_SCHED;
            PG8_STAGE(PG8_SB(1, 1), b3 + hstep, voffB);
            PG8_WAIT_V(6); PG8_BAR; PG8_MMA(1, 1, At, B1); PG8_BAR;
            }
        }
        if constexpr (ALIGN_EPI) { if (wr == 0) PG8_BAR; }
        if constexpr (!Epi::AFTER_DRAIN) { E(acc, cur, wr, wc, fr, fq); S.done(cur); }
        if (!has_next) break;
#pragma unroll
        for (int a = 0; a < 2; ++a)
#pragma unroll
            for (int b = 0; b < 2; ++b)
#pragma unroll
                for (int m = 0; m < 4; ++m)
#pragma unroll
                    for (int n = 0; n < 2; ++n) acc[a][b][m][n] = (f32x4){0.f, 0.f, 0.f, 0.f};
        cur = nxt; cA = nA; cB = nB; ++ui;
        if constexpr (ALIGN_EPI) { if (wr == 1) PG8_BAR; }
    }
    PG8_WAIT_V(0);
    if constexpr (!ALIGN_EPI) { if (wr == 0) PG8_BAR; }
    PG8_BAR;
    if constexpr (Epi::AFTER_DRAIN) { E.fused(acc, cur, wr, wc, fr, fq, lds, wid, lane); S.done(cur); }
#undef PG8_SA
#undef PG8_SB
#undef PG8_STAGE
#undef PG8_LDA
#undef PG8_LDB
#undef PG8_MMA
#undef PG8_WAIT_V
#undef PG8_WAIT_L
#undef PG8_BAR
#undef PG8_SCHED
}
}
#define LAS __attribute__((address_space(3)))
typedef unsigned short bf16;
typedef float f32x4 __attribute__((ext_vector_type(4)));
typedef float f32x16 __attribute__((ext_vector_type(16)));
typedef short bf16x8 __attribute__((ext_vector_type(8)));
typedef short s16x4 __attribute__((ext_vector_type(4)));
typedef unsigned u32x4 __attribute__((ext_vector_type(4)));
typedef unsigned u32x2 __attribute__((ext_vector_type(2)));
using pg8::cvt_pk_bf16;

constexpr int NTHREADS = 512, NWAVES = 8;
constexpr int M = 65536, D = 1024, FF = 4096, DIN = 3104, DIN_PAD = 3328, LDH = 3104;
constexpr int NSEQ = 10, S_P = 16384, S_S = 4096, NPR = 32768;
constexpr int O_DQ = 0, O_DK = 512, O_DV = 1024, O_GQ = 1536, O_GK = 1792, O_GV = 2048, O_GR = 2560, O_LRF = 3072, O_LRB = 3088;
constexpr float LN_EPS = 1e-5f;
constexpr float ALPHA = 1.189207115002721f;
constexpr float LAM_INIT = 0.2f;
constexpr float C1 = 0.125f * 1.4426950408889634f;

constexpr size_t MiB = 1u << 20;
constexpr size_t WS_CTL = 0;
constexpr size_t WS_WIN = 2 * MiB, WS_WO = 9 * MiB, WS_W1 = 11 * MiB, WS_W2 = 19 * MiB, WS_GG = 27 * MiB;
constexpr size_t WS_H = 32 * MiB;
constexpr size_t WS_XB = 420 * MiB;
constexpr size_t WS_MIX = 548 * MiB;
constexpr size_t WS_ST = 676 * MiB;
constexpr size_t WS_X1B = 676 * MiB;
constexpr size_t WS_HID = 32 * MiB;
constexpr size_t WS_KD = 832 * MiB, WS_VD = 896 * MiB;
constexpr size_t WS_END = 960 * MiB;
static_assert(WS_H + (size_t)M * LDH * 2 <= WS_XB && WS_HID + (size_t)M * FF * 2 <= WS_MIX && WS_X1B + (size_t)M * D * 2 <= WS_END, "ws map");

constexpr int RING_BYTES = 131072;
constexpr int LDS_BYTES = 160 * 1024;

struct Params {
    const float* in[20];
    float* out;
    unsigned char* ws;
    int ph_lo, ph_hi;
};

__device__ __forceinline__ float wave_sum(float v) {
#pragma unroll
    for (int o = 1; o < 64; o <<= 1) v += __shfl_xor(v, o);
    return v;
}
__device__ __forceinline__ const float* xrow_ptr(const Params& p, int m) { return (m < NPR) ? p.in[0] + (size_t)m * D : p.in[1] + (size_t)(m - NPR) * D; }

__device__ __forceinline__ void p0_transpose_item(const float* W, int K, int N, bf16* WT, LAS float* scr, int item, int lane) {
    const int nblk = N / 32, kb = item / nblk, nb = item % nblk, k0 = 64 * kb, n0 = 32 * nb;
#pragma unroll 8
    for (int i = 0; i < 32; ++i) { const int kk = 2 * i + (lane >> 5); scr[kk * 33 + (lane & 31)] = W[(size_t)(k0 + kk) * N + n0 + (lane & 31)]; }
    asm volatile("s_waitcnt vmcnt(0) lgkmcnt(0)" ::: "memory");
    const int c = lane & 7;
#pragma unroll
    for (int j = 0; j < 4; ++j) { const int n = (lane >> 3) + 8 * j; const LAS float* s = scr + (8 * c) * 33 + n;
        u32x4 o; o.x = cvt_pk_bf16(s[0 * 33], s[1 * 33]); o.y = cvt_pk_bf16(s[2 * 33], s[3 * 33]); o.z = cvt_pk_bf16(s[4 * 33], s[5 * 33]); o.w = cvt_pk_bf16(s[6 * 33], s[7 * 33]);
        *(u32x4*)(WT + (size_t)(n0 + n) * K + k0 + 8 * c) = o; }
    asm volatile("s_waitcnt lgkmcnt(0)" ::: "memory");
}

__device__ __forceinline__ void ln_row(const float* in, float* outf, bf16* outb, const float* g, const float* b, int lane) {
    const f32x4* xr = (const f32x4*)in + lane;
    f32x4 v[4]; float s = 0.f;
#pragma unroll
    for (int j = 0; j < 4; ++j) { v[j] = xr[64 * j]; s += (v[j].x + v[j].y) + (v[j].z + v[j].w); }
    const float mean = wave_sum(s) * (1.f / D); float s2 = 0.f;
#pragma unroll
    for (int j = 0; j < 4; ++j) { v[j] = v[j] - mean; s2 += (v[j].x * v[j].x + v[j].y * v[j].y) + (v[j].z * v[j].z + v[j].w * v[j].w); }
    const float rstd = 1.f / sqrtf(wave_sum(s2) * (1.f / D) + LN_EPS);
#pragma unroll
    for (int j = 0; j < 4; ++j) {
        const f32x4 g4 = ((const f32x4*)g)[lane + 64 * j], b4 = ((const f32x4*)b)[lane + 64 * j];
        const f32x4 o = v[j] * rstd * g4 + b4;
        ((f32x4*)outf)[lane + 64 * j] = o;
        if (outb) { u32x2 w; w.x = cvt_pk_bf16(o.x, o.y); w.y = cvt_pk_bf16(o.z, o.w); ((u32x2*)outb)[lane + 64 * j] = w; }
    }
}

__device__ __forceinline__ void ln_row_b(const bf16* in, float* outf, bf16* outb, const float* g, const float* b, int lane) {
    const u32x4 wa = ((const u32x4*)in)[lane], wb = ((const u32x4*)in)[64 + lane];
    float v[16];
#pragma unroll
    for (int i = 0; i < 4; ++i) { v[2 * i] = __uint_as_float(wa[i] << 16); v[2 * i + 1] = __uint_as_float(wa[i] & 0xffff0000u); v[8 + 2 * i] = __uint_as_float(wb[i] << 16); v[8 + 2 * i + 1] = __uint_as_float(wb[i] & 0xffff0000u); }
    float s = 0.f;
#pragma unroll
    for (int i = 0; i < 16; ++i) s += v[i];
    const float mean = wave_sum(s) * (1.f / D); float s2 = 0.f;
#pragma unroll
    for (int i = 0; i < 16; ++i) { v[i] -= mean; s2 += v[i] * v[i]; }
    const float rstd = 1.f / sqrtf(wave_sum(s2) * (1.f / D) + LN_EPS);
#pragma unroll
    for (int h = 0; h < 2; ++h) {
        const int e0 = h * 512 + 8 * lane;
        const f32x4 g0 = *(const f32x4*)(g + e0), g1 = *(const f32x4*)(g + e0 + 4), b0 = *(const f32x4*)(b + e0), b1 = *(const f32x4*)(b + e0 + 4);
        const f32x4 o0 = (f32x4){v[8 * h + 0], v[8 * h + 1], v[8 * h + 2], v[8 * h + 3]} * rstd * g0 + b0;
        const f32x4 o1 = (f32x4){v[8 * h + 4], v[8 * h + 5], v[8 * h + 6], v[8 * h + 7]} * rstd * g1 + b1;
        if (outf) { *(f32x4*)(outf + e0) = o0; *(f32x4*)(outf + e0 + 4) = o1; }
        if (outb) { u32x4 w; w.x = cvt_pk_bf16(o0.x, o0.y); w.y = cvt_pk_bf16(o0.z, o0.w); w.z = cvt_pk_bf16(o1.x, o1.y); w.w = cvt_pk_bf16(o1.z, o1.w); *(u32x4*)(outb + e0) = w; }
    }
}

__device__ __forceinline__ void ln_rows4_b(const bf16* in, float* outf, bf16* outb, const float* g, const float* b, int lane) {
    u32x4 wa[4], wb[4];
#pragma unroll
    for (int r = 0; r < 4; ++r) { wa[r] = ((const u32x4*)(in + (size_t)r * D))[lane]; wb[r] = ((const u32x4*)(in + (size_t)r * D))[64 + lane]; }
    float v[4][16], s[4], s2[4];
#pragma unroll
    for (int r = 0; r < 4; ++r) { s[r] = 0.f;
#pragma unroll
        for (int i = 0; i < 4; ++i) { v[r][2 * i] = __uint_as_float(wa[r][i] << 16); v[r][2 * i + 1] = __uint_as_float(wa[r][i] & 0xffff0000u); v[r][8 + 2 * i] = __uint_as_float(wb[r][i] << 16); v[r][8 + 2 * i + 1] = __uint_as_float(wb[r][i] & 0xffff0000u); }
#pragma unroll
        for (int i = 0; i < 16; ++i) s[r] += v[r][i]; }
#pragma unroll
    for (int o = 1; o < 64; o <<= 1) {
#pragma unroll
        for (int r = 0; r < 4; ++r) s[r] += __shfl_xor(s[r], o); }
#pragma unroll
    for (int r = 0; r < 4; ++r) { const float mean = s[r] * (1.f / D); s2[r] = 0.f;
#pragma unroll
        for (int i = 0; i < 16; ++i) { v[r][i] -= mean; s2[r] += v[r][i] * v[r][i]; } }
#pragma unroll
    for (int o = 1; o < 64; o <<= 1) {
#pragma unroll
        for (int r = 0; r < 4; ++r) s2[r] += __shfl_xor(s2[r], o); }
#pragma unroll
    for (int h = 0; h < 2; ++h) {
        const int e0 = h * 512 + 8 * lane;
        const f32x4 g0 = *(const f32x4*)(g + e0), g1 = *(const f32x4*)(g + e0 + 4), b0 = *(const f32x4*)(b + e0), b1 = *(const f32x4*)(b + e0 + 4);
#pragma unroll
        for (int r = 0; r < 4; ++r) {
            const float rstd = 1.f / sqrtf(s2[r] * (1.f / D) + LN_EPS);
            const f32x4 o0 = (f32x4){v[r][8 * h + 0], v[r][8 * h + 1], v[r][8 * h + 2], v[r][8 * h + 3]} * rstd * g0 + b0;
            const f32x4 o1 = (f32x4){v[r][8 * h + 4], v[r][8 * h + 5], v[r][8 * h + 6], v[r][8 * h + 7]} * rstd * g1 + b1;
            if (outf) { __builtin_nontemporal_store(o0, (f32x4*)(outf + (size_t)r * D + e0)); __builtin_nontemporal_store(o1, (f32x4*)(outf + (size_t)r * D + e0 + 4)); }
            if (outb) { u32x4 w; w.x = cvt_pk_bf16(o0.x, o0.y); w.y = cvt_pk_bf16(o0.z, o0.w); w.z = cvt_pk_bf16(o1.x, o1.y); w.w = cvt_pk_bf16(o1.z, o1.w); *(u32x4*)(outb + (size_t)r * D + e0) = w; }
        }
    }
}
#define RLX_AGENT __ATOMIC_RELAXED, __HIP_MEMORY_SCOPE_AGENT
#define XB_TMO      128
#define XB_XCNT(j)  (256  + 64 * (j))
#define XB_XSUB(j)  (1280 + 64 * (j))
#define XB_XGEN(j)  (2304 + 64 * (j))
#define XB_TOP      3328
#define XB_TOPGEN   3392
#define XCD_BAR_WORDS 3456
#define XB_SPIN_CAP (1u << 18)

__device__ __forceinline__ unsigned xb_ld(unsigned* p)              { return __hip_atomic_load(p, __ATOMIC_RELAXED, __HIP_MEMORY_SCOPE_AGENT); }
__device__ __forceinline__ unsigned xb_add(unsigned* p, unsigned v) { return __hip_atomic_fetch_add(p, v, __ATOMIC_RELAXED, __HIP_MEMORY_SCOPE_AGENT); }
__device__ __forceinline__ unsigned xb_xcc_id() { return (unsigned)__builtin_amdgcn_s_getreg((3 << 11) | 20) & 0xFu; }
#define XB_SPIN(cond, bar) do { unsigned _sp = 0; while (cond) { __builtin_amdgcn_s_sleep(1); \
    if ((++_sp & 255u) == 0u) { if (xb_ld(&(bar)[XB_TMO])) break; if (_sp > XB_SPIN_CAP) { atomicAdd(&(bar)[XB_TMO], 1u); break; } } } } while (0)

struct XcdBarrier {
    unsigned* bar; unsigned x; int wv;
    volatile LAS unsigned* st;
};

__device__ __forceinline__ XcdBarrier xcd_barrier_post(unsigned* bar, volatile LAS unsigned* st, int wave_u) {
    XcdBarrier b; b.bar = bar; b.x = xb_xcc_id(); b.st = st; b.wv = wave_u;
    if (tid_of(wave_u) == 0) (void)xb_add(&bar[XB_XCNT(b.x)], 1u);
    return b;
}
__device__ __forceinline__ void xcd_barrier_complete(unsigned* bar, unsigned x, unsigned& nloc, unsigned& nx) {
    const unsigned G = gridDim.x * gridDim.y * gridDim.z;
    unsigned sum, cnt, mine, sp = 0u;
    for (;;) {
        sum = 0u; cnt = 0u; mine = 0u;
#pragma unroll
        for (unsigned j = 0; j < 16; ++j) { const unsigned c = xb_ld(&bar[XB_XCNT(j)]); sum += c; cnt += (c > 0u) ? 1u : 0u; mine = (j == x) ? c : mine; }
        if (sum == G) break;
        __builtin_amdgcn_s_sleep(1);
        if ((++sp & 255u) == 0u) { if (xb_ld(&bar[XB_TMO])) break; if (sp > XB_SPIN_CAP) { atomicAdd(&bar[XB_TMO], 1u); break; } }
    }
    nloc = mine > 0u ? mine : 1u; nx = cnt > 0u ? cnt : 1u;
}

__device__ __forceinline__ void xcd_barrier(const XcdBarrier& b) {
    asm volatile("s_waitcnt vmcnt(0)" ::: "memory");
    __syncthreads();
    if (tid_of(b.wv) == 0) {
        unsigned* bar = b.bar;
        __builtin_amdgcn_s_waitcnt(0);
        unsigned nloc = b.st[0], nx = b.st[1];
        if (nloc == 0u) { xcd_barrier_complete(bar, b.x, nloc, nx); b.st[0] = nloc; b.st[1] = nx; }
        const unsigned old = xb_add(&bar[XB_XSUB(b.x)], 1u);
        const unsigned gen = old / nloc;
        if (old + 1u == (gen + 1u) * nloc) {
            __builtin_amdgcn_fence(__ATOMIC_RELEASE, "agent");
            asm volatile("s_waitcnt vmcnt(0)" ::: "memory");
            const unsigned og = xb_add(&bar[XB_TOP], 1u);
            const unsigned tg = og / nx;
            if (og + 1u == (tg + 1u) * nx) xb_add(&bar[XB_TOPGEN], 1u);
            else XB_SPIN(xb_ld(&bar[XB_TOPGEN]) == tg, bar);
            __builtin_amdgcn_fence(__ATOMIC_ACQUIRE, "agent");
            xb_add(&bar[XB_XGEN(b.x)], 1u);
            asm volatile("s_waitcnt vmcnt(0)" ::: "memory");
        } else {
            XB_SPIN(xb_ld(&bar[XB_XGEN(b.x)]) == gen, bar);
            __builtin_amdgcn_fence(__ATOMIC_ACQUIRE, "agent");
            asm volatile("s_waitcnt vmcnt(0)" ::: "memory");
        }
    }
    __syncthreads();
}
#ifndef ATT_REPS
#define ATT_REPS 1
#endif
namespace att {
typedef short v4i16_t __attribute__((ext_vector_type(4)));
typedef float f32x2 __attribute__((ext_vector_type(2)));
typedef __bf16 bf16x2_t __attribute__((ext_vector_type(2)));
__device__ __forceinline__ unsigned cvtpk_n(float lo, float hi) { const f32x2 v = {lo, hi}; return __builtin_bit_cast(unsigned, __builtin_convertvector(v, bf16x2_t)); }
constexpr int KSTR = 272, VSTR = 320;
constexpr int KBUF = 64 * KSTR, VBUF = 64 * VSTR, BUFB = KBUF + VBUF;
constexpr int XS = 132;
constexpr int TILEB = 32768;
constexpr int L_RED = 4 * TILEB;
constexpr int L_CTL = 160 * 1024 - 256;
constexpr float SKIP_T = 38.f;
constexpr int CW_UNIT = 160, CW_KN = 64;
__device__ __forceinline__ int crow(int r, int hi) { return (r & 3) + 8 * (r >> 2) + 4 * hi; }
__device__ __forceinline__ s16x4 vtr(LAS unsigned char* p) { return __builtin_bit_cast(s16x4, __builtin_amdgcn_ds_read_tr16_b64_v4i16((LAS v4i16_t*)p)); }
__device__ __forceinline__ float bf_lo(unsigned w) { return __uint_as_float(w << 16); }
__device__ __forceinline__ float bf_hi(unsigned w) { return __uint_as_float(w & 0xffff0000u); }

__device__ __forceinline__ void knorm_phase(const bf16* KD, unsigned* ctl, int bid, int G, int wave_u) {
    const int tid_l = tid_of(wave_u);
    const int gt = bid * NTHREADS + tid_l, NTH = G * NTHREADS;
    for (int idx = gt; idx < M * 8; idx += NTH) {
        const int row = idx >> 3, hc = idx & 7;
        const u32x4* kp = (const u32x4*)(KD + ((size_t)(hc >> 1) * M + row) * 128 + (hc & 1) * 64);
        float ss = 0.f;
#pragma unroll
        for (int i = 0; i < 8; ++i) { const u32x4 w = kp[i];
#pragma unroll
            for (int e = 0; e < 4; ++e) { const float a = bf_lo(w[e]), b = bf_hi(w[e]); ss = fmaf(a, a, ss); ss = fmaf(b, b, ss); } }
        float nr = sqrtf(ss);
        nr = fmaxf(nr, __shfl_xor(nr, 8)); nr = fmaxf(nr, __shfl_xor(nr, 16)); nr = fmaxf(nr, __shfl_xor(nr, 32));
        const int seq = (row < NPR) ? (row >> 14) : 2 + ((row - NPR) >> 12);
        if ((tid_l & 63) < 8) atomicMax(ctl + CW_KN + seq * 8 + hc, __float_as_uint(nr));
    }
}

__device__ __forceinline__ void attn_unit(const bf16* Hb, const bf16* KD, const bf16* VD, bf16* MIX, int row0, int S, int head, int qb, float lam, const float* dng, float kn0, float kn1, LAS unsigned char* lds, int wave_u) {
    const int tid_l = tid_of(wave_u);
    const int tid = tid_l, lane = tid & 63, wid = __builtin_amdgcn_readfirstlane(tid >> 6), r32 = lane & 31, hh = lane >> 5;
    const int c = wid >> 2, qs = wid & 3;
    const int q0 = qb * 128 + qs * 32;
    const float slope2 = __uint_as_float(__builtin_amdgcn_readfirstlane(__float_as_uint(exp2f(-2.f * (float)(head + 1)) * 1.4426950408889634f)));
    lam = __uint_as_float(__builtin_amdgcn_readfirstlane(__float_as_uint(lam)));
    bf16x8 qr[4];
    float mub;
    float m;
    {   const bf16* Qp = Hb + (size_t)(row0 + q0 + r32) * LDH + O_DQ + head * 128 + c * 64 + hh * 8;
        const bf16* Kp = KD + ((size_t)head * M + row0 + q0 + r32) * 128 + c * 64 + hh * 8;
        float qq = 0.f, dot = 0.f;
#pragma unroll
        for (int d0 = 0; d0 < 4; ++d0) { qr[d0] = *(const bf16x8*)(Qp + d0 * 16); const u32x4 qw = __builtin_bit_cast(u32x4, qr[d0]); const u32x4 kw = *(const u32x4*)(Kp + d0 * 16);
#pragma unroll
            for (int e = 0; e < 4; ++e) { const float qa = bf_lo(qw[e]), qb_ = bf_hi(qw[e]), ka = bf_lo(kw[e]), kb = bf_hi(kw[e]);
                qq = fmaf(qa, qa, qq); qq = fmaf(qb_, qb_, qq); dot = fmaf(qa, ka, dot); dot = fmaf(qb_, kb, dot); } }
        qq += __shfl_xor(qq, 32); dot += __shfl_xor(dot, 32);
        m = dot;
        float am = sqrtf(qq) * (c ? kn1 : kn0) * 1.001f + 0.01f, bm = dot;
        mub = am;
        float sp = am - dot;
#pragma unroll
        for (int o = 1; o < 32; o <<= 1) { am = fmaxf(am, __shfl_xor(am, o)); bm = fminf(bm, __shfl_xor(bm, o)); sp = fmaxf(sp, __shfl_xor(sp, o)); }
        LAS float* red = (LAS float*)(lds + L_RED);
        if (lane == 0) { red[wid * 4] = am; red[wid * 4 + 1] = bm; red[wid * 4 + 2] = sp; }
    }
    __syncthreads();
    int tlo, thi; bool fast;
    {   LAS float* red = (LAS float*)(lds + L_RED); float am = red[0], bm = red[1], sp = red[2];
#pragma unroll
        for (int w = 1; w < 8; ++w) { am = fmaxf(am, red[4 * w]); bm = fminf(bm, red[4 * w + 1]); sp = fmaxf(sp, red[4 * w + 2]); }
        fast = sp < 100.f;
        const float Wf = (sp + SKIP_T) / slope2 + 1.f; (void)am; (void)bm;
        const int W = (Wf < 1.0e6f) ? (int)Wf : 1000000;
        const int Q0 = qb * 128, NTall = S / 64;
        int lo = Q0 - 63 - W; lo = lo > 0 ? (lo + 63) / 64 : 0;
        int hi_ = (Q0 + 127 + W) / 64; hi_ = hi_ < NTall - 1 ? hi_ : NTall - 1;
        tlo = __builtin_amdgcn_readfirstlane(lo); thi = __builtin_amdgcn_readfirstlane(hi_);
    }
    if (((thi - tlo + 1) & 1) != 0) { if (tlo > 0) --tlo; else ++thi; }
    const int drow = 8 * wid + (lane >> 4);
    const int f0 = ((drow & 3) << 2) | ((drow >> 2) & 3), f1 = (((drow + 4) & 3) << 2) | (((drow + 4) >> 2) & 3);
    const unsigned kg0 = (unsigned)((((size_t)head * M + row0 + drow) * 128 + ((lane & 15) ^ f0) * 8) * 2);
    const unsigned kg1 = (unsigned)((((size_t)head * M + row0 + drow + 4) * 128 + ((lane & 15) ^ f1) * 8) * 2);
    const char* Kc = (const char*)KD; const char* Vc = (const char*)VD;
    const int dmaw = wid * 2048;
#define ATT_DMA(t, st) do { const unsigned off_ = (unsigned)(t) * 16384u; LAS unsigned char* S_ = lds + (st) * TILEB + dmaw; \
        __builtin_amdgcn_global_load_lds((const unsigned*)(Kc + (size_t)(kg0 + off_)), (LAS unsigned*)(S_), 16, 0, 0); \
        __builtin_amdgcn_global_load_lds((const unsigned*)(Kc + (size_t)(kg1 + off_)), (LAS unsigned*)(S_ + 1024), 16, 0, 0); \
        __builtin_amdgcn_global_load_lds((const unsigned*)(Vc + (size_t)(kg0 + off_)), (LAS unsigned*)(S_ + 16384), 16, 0, 0); \
        __builtin_amdgcn_global_load_lds((const unsigned*)(Vc + (size_t)(kg1 + off_)), (LAS unsigned*)(S_ + 16384 + 1024), 16, 0, 0); } while (0)
    ATT_DMA(tlo, 0); ATT_DMA(tlo + 1, 1);
    asm volatile("s_waitcnt vmcnt(0)" ::: "memory");
    __syncthreads();
    float l = 0.f;
    f32x16 o[4];
#pragma unroll
    for (int b = 0; b < 4; ++b)
#pragma unroll
        for (int r = 0; r < 16; ++r) o[b][r] = 0.f;
    const int fk = ((r32 & 3) << 2) | ((r32 >> 2) & 3);
    const int kbase = 256 * r32 + 16 * ((c * 8 + hh) ^ fk);
    const int q4 = (lane & 15) >> 2, pp4 = lane & 3, g1 = (lane >> 4) & 1;
    const int vlow0 = (2 * g1 + (pp4 >> 1)) ^ hh;
    const int vbase0 = 16384 + 256 * (4 * hh + q4) + 64 * q4 + 16 * vlow0 + 8 * (pp4 & 1);
    const int vbase1 = 16384 + 256 * (4 * hh + q4 + 8) + 64 * q4 + 16 * (vlow0 ^ 2) + 8 * (pp4 & 1);
    f32x2 l2 = (f32x2){0.f, 0.f};
#define ATT_CINIT(P0, P1, T) do { const int krel_ = (T) * 64 - q0; const float dbase_ = (float)(krel_ + 4 * hh - r32); \
        if (krel_ + 63 <= 0 || krel_ >= 31) { const float sg_ = (krel_ + 63 <= 0) ? slope2 : -slope2; const float base_ = fmaf(sg_, dbase_, -m); \
            _Pragma("unroll") for (int r = 0; r < 16; ++r) { const float cr = (float)((r & 3) + 8 * (r >> 2)); P0[r] = fmaf(sg_, cr, base_); P1[r] = fmaf(sg_, cr + 32.f, base_); } } \
        else { _Pragma("unroll") for (int r = 0; r < 16; ++r) { const float cr = (float)((r & 3) + 8 * (r >> 2)); P0[r] = fmaf(fabsf(dbase_ + cr), -slope2, -m); P1[r] = fmaf(fabsf(dbase_ + cr + 32.f), -slope2, -m); } } } while (0)
#define ATT_SB() __builtin_amdgcn_sched_barrier(0)
#define ATT_EXPPACK(P, S8, W) do { float e0 = __builtin_amdgcn_exp2f(P[S8 + 0]), e1 = __builtin_amdgcn_exp2f(P[S8 + 1]), e2 = __builtin_amdgcn_exp2f(P[S8 + 2]), e3 = __builtin_amdgcn_exp2f(P[S8 + 3]), \
        e4 = __builtin_amdgcn_exp2f(P[S8 + 4]), e5 = __builtin_amdgcn_exp2f(P[S8 + 5]), e6 = __builtin_amdgcn_exp2f(P[S8 + 6]), e7 = __builtin_amdgcn_exp2f(P[S8 + 7]); \
        l += ((e0 + e1) + (e2 + e3)) + ((e4 + e5) + (e6 + e7)); \
        u32x4 w_; w_.x = cvt_pk_bf16(e0, e1); w_.y = cvt_pk_bf16(e2, e3); w_.z = cvt_pk_bf16(e4, e5); w_.w = cvt_pk_bf16(e6, e7); W = __builtin_bit_cast(bf16x8, w_); } while (0)
#define ATT_VRD(S, L, H) do { _Pragma("unroll") for (int db = 0; db < 4; ++db) { \
        asm volatile("ds_read_b64_tr_b16 %0, %1 offset:%c2" : "=&v"(L[db]) : "v"(va0[db]), "i"(4096 * (S)) : "memory"); \
        asm volatile("ds_read_b64_tr_b16 %0, %1 offset:%c2" : "=&v"(H[db]) : "v"(va1[db]), "i"(4096 * (S)) : "memory"); } } while (0)
#define ATT_WAITV(L, H) asm volatile("s_waitcnt lgkmcnt(0)" : "+v"(L[0]), "+v"(L[1]), "+v"(L[2]), "+v"(L[3]), "+v"(H[0]), "+v"(H[1]), "+v"(H[2]), "+v"(H[3]) : : "memory")
#define ATT_PVM(L, H, PF) do { _Pragma("unroll") for (int db = 0; db < 4; ++db) \
        o[db] = __builtin_amdgcn_mfma_f32_32x32x16_bf16(__builtin_bit_cast(bf16x8, (u32x4){L[db].x, L[db].y, H[db].x, H[db].y}), PF, o[db], 0, 0, 0); } while (0)
#define ATT_TILE(Bt, T) do { \
        f32x16 p0, p1; ATT_CINIT(p0, p1, T); \
        unsigned va0[4], va1[4]; { const unsigned tb_ = (unsigned)(uintptr_t)(Bt); \
            _Pragma("unroll") for (int db = 0; db < 4; ++db) { va0[db] = tb_ + (unsigned)(vbase0 ^ (64 * db)); va1[db] = tb_ + (unsigned)(vbase1 ^ (64 * db)); } } \
        bf16x8 kf[8]; \
        _Pragma("unroll") for (int d0 = 0; d0 < 4; ++d0) { kf[2 * d0] = *(LAS bf16x8*)(Bt + (kbase ^ (32 * d0))); kf[2 * d0 + 1] = *(LAS bf16x8*)(Bt + 8192 + (kbase ^ (32 * d0))); } \
        ATT_SB(); \
        _Pragma("unroll") for (int d0 = 0; d0 < 4; ++d0) { p0 = __builtin_amdgcn_mfma_f32_32x32x16_bf16(kf[2 * d0], qr[d0], p0, 0, 0, 0); p1 = __builtin_amdgcn_mfma_f32_32x32x16_bf16(kf[2 * d0 + 1], qr[d0], p1, 0, 0, 0); } \
        u32x2 vl[4], vh[4], wl[4], wh[4]; \
        ATT_VRD(0, vl, vh); \
        ATT_SB(); \
        float mt = fmaxf(p0[0], p1[0]); \
        _Pragma("unroll") for (int r = 1; r < 16; ++r) mt = fmaxf(mt, fmaxf(p0[r], p1[r])); \
        mt = fmaxf(mt, __shfl_xor(mt, 32)); \
        if (__any(mt > 0.f)) { \
            const float dl = fmaxf(mt, 0.f), alpha = __builtin_amdgcn_exp2f(-dl); \
            m += dl; l *= alpha; \
            _Pragma("unroll") for (int r = 0; r < 16; ++r) { p0[r] -= dl; p1[r] -= dl; } \
            _Pragma("unroll") for (int b = 0; b < 4; ++b) _Pragma("unroll") for (int r = 0; r < 16; ++r) o[b][r] *= alpha; \
        } \
        bf16x8 f0, f1, f2, f3; \
        ATT_EXPPACK(p0, 0, f0); ATT_EXPPACK(p0, 8, f1); ATT_EXPPACK(p1, 0, f2); ATT_EXPPACK(p1, 8, f3); \
        ATT_SB(); \
        ATT_WAITV(vl, vh); ATT_VRD(1, wl, wh); ATT_SB(); ATT_PVM(vl, vh, f0); ATT_SB(); \
        ATT_WAITV(wl, wh); ATT_VRD(2, vl, vh); ATT_SB(); ATT_PVM(wl, wh, f1); ATT_SB(); \
        ATT_WAITV(vl, vh); ATT_VRD(3, wl, wh); ATT_SB(); ATT_PVM(vl, vh, f2); ATT_SB(); \
        ATT_WAITV(wl, wh); ATT_SB(); ATT_PVM(wl, wh, f3); ATT_SB(); \
    } while (0)
#define ATT_TILE_FAST(Bt, T) do { \
        f32x16 p0, p1; \
        { const int krel_ = (T) * 64 - q0; const float dbase_ = (float)(krel_ + 4 * hh - r32); \
          if (krel_ + 63 <= 0 || krel_ >= 31) { const float sg_ = (krel_ + 63 <= 0) ? slope2 : -slope2; const float b0_ = fmaf(sg_, dbase_, -mub), b1_ = fmaf(sg_, 32.f, b0_); \
              _Pragma("unroll") for (int r = 0; r < 16; ++r) { const float cr = (float)((r & 3) + 8 * (r >> 2)); p0[r] = fmaf(sg_, cr, b0_); p1[r] = fmaf(sg_, cr, b1_); } } \
          else { _Pragma("unroll") for (int r = 0; r < 16; ++r) { const float cr = (float)((r & 3) + 8 * (r >> 2)); p0[r] = fmaf(fabsf(dbase_ + cr), -slope2, -mub); p1[r] = fmaf(fabsf(dbase_ + cr + 32.f), -slope2, -mub); } } } \
        unsigned va0[4], va1[4]; { const unsigned tb_ = (unsigned)(uintptr_t)(Bt); \
            _Pragma("unroll") for (int db = 0; db < 4; ++db) { va0[db] = tb_ + (unsigned)(vbase0 ^ (64 * db)); va1[db] = tb_ + (unsigned)(vbase1 ^ (64 * db)); } } \
        bf16x8 kf[8]; \
        _Pragma("unroll") for (int d0 = 0; d0 < 4; ++d0) { kf[2 * d0] = *(LAS bf16x8*)(Bt + (kbase ^ (32 * d0))); kf[2 * d0 + 1] = *(LAS bf16x8*)(Bt + 8192 + (kbase ^ (32 * d0))); } \
        ATT_SB(); \
        _Pragma("unroll") for (int d0 = 0; d0 < 4; ++d0) { p0 = __builtin_amdgcn_mfma_f32_32x32x16_bf16(kf[2 * d0], qr[d0], p0, 0, 0, 0); p1 = __builtin_amdgcn_mfma_f32_32x32x16_bf16(kf[2 * d0 + 1], qr[d0], p1, 0, 0, 0); } \
        u32x2 vl[4], vh[4], wl[4], wh[4]; \
        ATT_VRD(0, vl, vh); \
        ATT_SB(); \
        bf16x8 f0, f1, f2, f3; \
        ATT_EXPPACK2(p0, 0, f0); ATT_EXPPACK2(p0, 8, f1); ATT_EXPPACK2(p1, 0, f2); ATT_EXPPACK2(p1, 8, f3); \
        ATT_SB(); \
        ATT_WAITV(vl, vh); ATT_VRD(1, wl, wh); ATT_SB(); ATT_PVM(vl, vh, f0); ATT_SB(); \
        ATT_WAITV(wl, wh); ATT_VRD(2, vl, vh); ATT_SB(); ATT_PVM(wl, wh, f1); ATT_SB(); \
        ATT_WAITV(vl, vh); ATT_VRD(3, wl, wh); ATT_SB(); ATT_PVM(vl, vh, f2); ATT_SB(); \
        ATT_WAITV(wl, wh); ATT_SB(); ATT_PVM(wl, wh, f3); ATT_SB(); \
    } while (0)
#define ATT_EXPPACK2(P, S8, W) do { f32x2 ea_ = (f32x2){__builtin_amdgcn_exp2f(P[S8 + 0]), __builtin_amdgcn_exp2f(P[S8 + 1])}, eb_ = (f32x2){__builtin_amdgcn_exp2f(P[S8 + 2]), __builtin_amdgcn_exp2f(P[S8 + 3])}, \
        ec_ = (f32x2){__builtin_amdgcn_exp2f(P[S8 + 4]), __builtin_amdgcn_exp2f(P[S8 + 5])}, ed_ = (f32x2){__builtin_amdgcn_exp2f(P[S8 + 6]), __builtin_amdgcn_exp2f(P[S8 + 7])}; \
        l2 += (ea_ + eb_) + (ec_ + ed_); \
        u32x4 w_; w_.x = cvt_pk_bf16(ea_.x, ea_.y); w_.y = cvt_pk_bf16(eb_.x, eb_.y); w_.z = cvt_pk_bf16(ec_.x, ec_.y); w_.w = cvt_pk_bf16(ed_.x, ed_.y); W = __builtin_bit_cast(bf16x8, w_); } while (0)
#define ATT_CINITH(P, T, H) do { const int krel_ = (T) * 64 - q0; const float dbase_ = (float)(krel_ + 4 * hh - r32 + 32 * (H)); \
          if (krel_ + 63 <= 0 || krel_ >= 31) { const float sg_ = (krel_ + 63 <= 0) ? slope2 : -slope2; const float b0_ = fmaf(sg_, dbase_, -mref); \
              _Pragma("unroll") for (int r = 0; r < 16; ++r) { const float cr = (float)((r & 3) + 8 * (r >> 2)); P[r] = fmaf(sg_, cr, b0_); } } \
          else { _Pragma("unroll") for (int r = 0; r < 16; ++r) { const float cr = (float)((r & 3) + 8 * (r >> 2)); P[r] = fmaf(fabsf(dbase_ + cr), -slope2, -mref); } } } while (0)
#define ATT_SGB(mask, n) __builtin_amdgcn_sched_group_barrier(mask, n, 0)
#define ATT_KLD(Bt, H) do { _Pragma("unroll") for (int d0 = 0; d0 < 4; ++d0) kf[d0] = *(LAS bf16x8*)(Bt + 8192 * (H) + (kbase ^ (32 * d0))); } while (0)
#define ATT_QK(P) do { _Pragma("unroll") for (int d0 = 0; d0 < 4; ++d0) P = __builtin_amdgcn_mfma_f32_32x32x16_bf16(kf[d0], qr[d0], P, 0, 0, 0); } while (0)
#define ATT_VADDR(Bt) do { const unsigned tb_ = (unsigned)(uintptr_t)(Bt); \
            _Pragma("unroll") for (int db = 0; db < 4; ++db) { va0[db] = tb_ + (unsigned)(vbase0 ^ (64 * db)); va1[db] = tb_ + (unsigned)(vbase1 ^ (64 * db)); } } while (0)
#define ATT_PAIR_FAST(BtA, BtB, T) do { \
        f32x16 a0, a1, b0, b1; bf16x8 kf[4]; unsigned va0[4], va1[4]; u32x2 vl[4], vh[4], wl[4], wh[4]; \
        bf16x8 fa0, fa1, fa2, fa3, fb0, fb1, fb2, fb3; \
        ATT_CINITH(a0, T, 0); ATT_CINITH(a1, T, 1); ATT_VADDR(BtA); \
        ATT_KLD(BtA, 0); ATT_SB(); ATT_QK(a0); ATT_VRD(0, vl, vh); ATT_KLD(BtA, 1); ATT_SB(); \
        ATT_QK(a1); ATT_EXPPACK2(a0, 0, fa0); ATT_EXPPACK2(a0, 8, fa1); \
        _Pragma("unroll") for (int i_ = 0; i_ < 4; ++i_) { ATT_SGB(0x8, 1); ATT_SGB(0x2, 7); } ATT_SB(); \
        ATT_CINITH(b0, (T) + 1, 0); ATT_WAITV(vl, vh); ATT_VRD(1, wl, wh); ATT_KLD(BtB, 0); ATT_SB(); \
        ATT_PVM(vl, vh, fa0); ATT_QK(b0); ATT_EXPPACK2(a1, 0, fa2); ATT_EXPPACK2(a1, 8, fa3); \
        _Pragma("unroll") for (int i_ = 0; i_ < 8; ++i_) { ATT_SGB(0x8, 1); ATT_SGB(0x2, 4); } ATT_SB(); \
        ATT_CINITH(b1, (T) + 1, 1); ATT_WAITV(wl, wh); ATT_VRD(2, vl, vh); ATT_KLD(BtB, 1); ATT_SB(); \
        ATT_PVM(wl, wh, fa1); ATT_QK(b1); ATT_EXPPACK2(b0, 0, fb0); ATT_EXPPACK2(b0, 8, fb1); \
        _Pragma("unroll") for (int i_ = 0; i_ < 8; ++i_) { ATT_SGB(0x8, 1); ATT_SGB(0x2, 4); } ATT_SB(); \
        ATT_WAITV(vl, vh); ATT_VRD(3, wl, wh); ATT_SB(); \
        ATT_PVM(vl, vh, fa2); ATT_EXPPACK2(b1, 0, fb2); \
        _Pragma("unroll") for (int i_ = 0; i_ < 4; ++i_) { ATT_SGB(0x8, 1); ATT_SGB(0x2, 4); } ATT_SB(); \
        ATT_WAITV(wl, wh); ATT_VRD(8, vl, vh); ATT_SB(); \
        ATT_PVM(wl, wh, fa3); ATT_EXPPACK2(b1, 8, fb3); \
        _Pragma("unroll") for (int i_ = 0; i_ < 4; ++i_) { ATT_SGB(0x8, 1); ATT_SGB(0x2, 4); } ATT_SB(); \
        ATT_WAITV(vl, vh); ATT_VRD(9, wl, wh); ATT_SB(); ATT_PVM(vl, vh, fb0); ATT_SB(); \
        ATT_WAITV(wl, wh); ATT_VRD(10, vl, vh); ATT_SB(); ATT_PVM(wl, wh, fb1); ATT_SB(); \
        ATT_WAITV(vl, vh); ATT_VRD(11, wl, wh); ATT_SB(); ATT_PVM(vl, vh, fb2); ATT_SB(); \
        ATT_WAITV(wl, wh); ATT_SB(); ATT_PVM(wl, wh, fb3); ATT_SB(); \
    } while (0)
    if (fast) {
    for (int t = tlo; t <= thi; t += 2) {
        const int pbuf = ((t - tlo) >> 1) & 1;
        if (t + 2 <= thi) { ATT_DMA(t + 2, 2 * (pbuf ^ 1)); ATT_DMA(t + 3, 2 * (pbuf ^ 1) + 1); }
        LAS unsigned char* BA = lds + (2 * pbuf) * TILEB;
        LAS unsigned char* BB = BA + TILEB;
#ifndef ATT_DUP
#define ATT_DUP 1
#endif
        _Pragma("nounroll") for (int dup_ = ATT_DUP - 1; dup_ >= 0; --dup_) { const float mref = mub + (dup_ ? 1000.f : 0.f); ATT_PAIR_FAST(BA, BB, t); }
        asm volatile("s_waitcnt vmcnt(0)" ::: "memory");
        __syncthreads();
    }
    } else {
    for (int t = tlo; t <= thi; t += 2) {
        const int pbuf = ((t - tlo) >> 1) & 1;
        if (t + 2 <= thi) { ATT_DMA(t + 2, 2 * (pbuf ^ 1)); ATT_DMA(t + 3, 2 * (pbuf ^ 1) + 1); }
        LAS unsigned char* BA = lds + (2 * pbuf) * TILEB;
        LAS unsigned char* BB = BA + TILEB;
        ATT_TILE(BA, t); ATT_TILE(BB, t + 1);
        asm volatile("s_waitcnt vmcnt(0)" ::: "memory");
        __syncthreads();
    }
    }
#undef ATT_DMA
#undef ATT_CINIT
#undef ATT_EXPPACK
#undef ATT_VRD
#undef ATT_WAITV
#undef ATT_PVM
#undef ATT_TILE
#undef ATT_TILE_FAST
#undef ATT_PAIR_FAST
#undef ATT_CINITH
#undef ATT_KLD
#undef ATT_QK
#undef ATT_VADDR
#undef ATT_SGB
#undef ATT_EXPPACK2
#undef ATT_SB
    int ln2 = tid_of(wave_u) & 63;
    const int r32e = ln2 & 31, hhe = ln2 >> 5;
    if (fast) l = l2.x + l2.y;
    l += __shfl_xor(l, 32);
    const float rl = 1.f / l;
    LAS float* X = (LAS float*)lds;
    if (c == 1) {
        const float f = rl * lam;
#pragma unroll
        for (int b = 0; b < 4; ++b)
#pragma unroll
            for (int r = 0; r < 16; ++r) X[(qs * 32 + r32e) * XS + 32 * b + crow(r, hhe)] = o[b][r] * f;
    }
    __syncthreads();
    if (c == 0) {
        float ss = 0.f;
#pragma unroll
        for (int b = 0; b < 4; ++b)
#pragma unroll
            for (int r = 0; r < 16; ++r) { const float v = o[b][r] * rl - X[(qs * 32 + r32e) * XS + 32 * b + crow(r, hhe)]; o[b][r] = v; ss += v * v; }
        ss += __shfl_xor(ss, 32);
        const float rn = (1.f - LAM_INIT) / sqrtf(ss * (1.f / 128.f) + 1e-5f);
        bf16* orow = MIX + (size_t)(row0 + q0 + r32e) * D + head * 128;
#pragma unroll
        for (int b = 0; b < 4; ++b)
#pragma unroll
            for (int rg = 0; rg < 4; ++rg) { const int d = 32 * b + 8 * rg + 4 * hhe; const f32x4 g4 = *(const f32x4*)(dng + d);
                u32x2 w; w.x = cvt_pk_bf16(o[b][4 * rg + 0] * rn * g4.x, o[b][4 * rg + 1] * rn * g4.y); w.y = cvt_pk_bf16(o[b][4 * rg + 2] * rn * g4.z, o[b][4 * rg + 3] * rn * g4.w);
                *(u32x2*)(orow + d) = w; }
    }
    __syncthreads();
}

__device__ __forceinline__ void attn_phase(const Params& p, const bf16* Hb, const bf16* KD, const bf16* VD, bf16* MIX, unsigned* ctl, LAS unsigned char* lds, int bid, int G, int wave_u) {
    float s1 = 0.f, s2 = 0.f;
    for (int i = 0; i < 64; ++i) { s1 += p.in[4][i] * p.in[5][i]; s2 += p.in[6][i] * p.in[7][i]; }
    const float lam = expf(s1) - expf(s2) + LAM_INIT;
    LAS int* slot = (LAS int*)(lds + L_CTL);
    const int myx = (int)(__builtin_amdgcn_s_getreg((3 << 11) | 20) & 7u);
    for (int rep = 0; rep < ATT_REPS; ++rep)
    for (int qi = 0; qi < 8; ++qi) {
      const int x = (myx + qi) & 7;
      for (;;) {
        if (tid_of(wave_u) == 0) *slot = (int)atomicAdd(ctl + CW_UNIT + x + 8 * rep, 1u);
        __syncthreads();
        const int j = __builtin_amdgcn_readfirstlane(*slot);
        __syncthreads();
        if (j >= 256) break;
        const int grp = j >> 5, i = j & 31;
        const bool prompt = (grp == 0) | (grp == 1) | (grp == 4) | (grp == 6);
        const int head = (grp == 0 || grp == 2) ? 3 : (grp == 1 || grp == 3) ? 2 : (grp == 4 || grp == 5) ? 1 : 0;
        int seq, qb, row0, S;
        if (prompt) { seq = x & 1; qb = i * 4 + (x >> 1); row0 = seq * S_P; S = S_P; }
        else { seq = 2 + x; qb = i; row0 = NPR + x * S_S; S = S_S; }
        const float kn0 = __uint_as_float(__hip_atomic_load(ctl + CW_KN + seq * 8 + head * 2, __ATOMIC_RELAXED, __HIP_MEMORY_SCOPE_AGENT));
        const float kn1 = __uint_as_float(__hip_atomic_load(ctl + CW_KN + seq * 8 + head * 2 + 1, __ATOMIC_RELAXED, __HIP_MEMORY_SCOPE_AGENT));
        attn_unit(Hb, KD, VD, MIX, row0, S, head, qb, lam, p.in[8], kn0, kn1, lds, wave_u);
      }
    }
}
}
namespace gla {
using att::crow; using att::vtr; using att::VSTR;
constexpr int L_LR = 0, L_B = 4096, L_TOT = 20480, L_BT = 22528, L_QT = 23040, L_KT = 32256, L_V = 41472, L_Z = 82432;
constexpr int L_V2 = 116224, L_LR2 = 136704;
constexpr int QSTR = 144, ZS = 132, SEGC = 16;
constexpr float LOG2E = 1.4426950408889634f, LN2 = 0.6931471805599453f;
__device__ __forceinline__ float bf2f(unsigned h) { return __uint_as_float(h << 16); }
__device__ __forceinline__ float fexp(float x) { return __builtin_amdgcn_exp2f(x * LOG2E); }

struct ChunkRegs { u32x4 v0, v1, q, k, lr; };
template <bool NEEDQ> __device__ __forceinline__ void chunk_load(ChunkRegs& R, const bf16* Hb, int rowbase, int head, int dir, int tid) {
    const int srow = tid >> 4, sch = tid & 15;
    const bf16* Vg = Hb + (size_t)(rowbase + srow) * LDH + O_GV + head * 128 + sch * 8;
    R.v0 = *(const u32x4*)Vg; R.v1 = *(const u32x4*)(Vg + (size_t)32 * LDH);
    const int pr = tid >> 3, dk0 = (tid & 7) * 8;
    R.k = *(const u32x4*)(Hb + (size_t)(rowbase + pr) * LDH + O_GK + head * 64 + dk0);
    if (NEEDQ) R.q = *(const u32x4*)(Hb + (size_t)(rowbase + pr) * LDH + O_GQ + head * 64 + dk0);
    if (tid < 128) R.lr = *(const u32x4*)(Hb + (size_t)(rowbase + (tid >> 1)) * LDH + O_LRF + dir * 16 + (tid & 1) * 8);
}
__device__ __forceinline__ void stage_vlr(const ChunkRegs& R, int buf, LAS unsigned char* lds, int tid) {
    LAS float* LR = (LAS float*)(lds + (buf ? L_LR2 : L_LR));
    { const int srow = tid >> 4, sch = tid & 15; LAS unsigned char* V = lds + (buf ? L_V2 : L_V);
      *(LAS u32x4*)(V + srow * VSTR + sch * 16) = R.v0; *(LAS u32x4*)(V + (srow + 32) * VSTR + sch * 16) = R.v1; }
    if (tid < 128) { const int tok = tid >> 1, hf = tid & 1;
#pragma unroll
        for (int i = 0; i < 4; ++i) { const unsigned ww = R.lr[i]; LR[tok * 16 + hf * 8 + 2 * i] = bf2f(ww & 0xffffu); LR[tok * 16 + hf * 8 + 2 * i + 1] = bf2f(ww >> 16); } }
}
template <bool NEEDQ> __device__ __forceinline__ float chunk_front(const ChunkRegs& C, const ChunkRegs& N, bool stage_next, int cur, int dir, const bf16x8& bhi, const bf16x8& blo, float biasd, LAS unsigned char* lds, int tid) {
    LAS float* LR = (LAS float*)(lds + (cur ? L_LR2 : L_LR)); LAS float* Bm = (LAS float*)(lds + L_B); LAS float* TOT = (LAS float*)(lds + L_TOT); LAS float* BT = (LAS float*)(lds + L_BT);
    const int d = tid & 63, grp = tid >> 6;
    if (grp < 4) { const int ln = tid & 63, r32_ = ln & 31, hh_ = ln >> 5, pblk = grp >> 1, dblk = grp & 1;
        const f32x4 a0 = *(const LAS f32x4*)(LR + (32 * pblk + r32_) * 16 + 8 * hh_), a1 = *(const LAS f32x4*)(LR + (32 * pblk + r32_) * 16 + 8 * hh_ + 4);
        u32x4 aw; aw.x = att::cvtpk_n(a0.x, a0.y); aw.y = att::cvtpk_n(a0.z, a0.w); aw.z = att::cvtpk_n(a1.x, a1.y); aw.w = att::cvtpk_n(a1.z, a1.w);
        f32x16 zc;
#pragma unroll
        for (int r = 0; r < 16; ++r) zc[r] = biasd;
        zc = __builtin_amdgcn_mfma_f32_32x32x16_bf16(__builtin_bit_cast(bf16x8, aw), bhi, zc, 0, 0, 0);
        zc = __builtin_amdgcn_mfma_f32_32x32x16_bf16(__builtin_bit_cast(bf16x8, aw), blo, zc, 0, 0, 0);
#pragma unroll
        for (int r = 0; r < 16; ++r) Bm[(32 * pblk + crow(r, hh_)) * 64 + 32 * dblk + r32_] = zc[r]; }
    __syncthreads();
    float la[8];
#pragma unroll
    for (int i = 0; i < 8; ++i) { const int p = grp * 8 + i; const float z = Bm[p * 64 + d];
        const float t = __builtin_amdgcn_exp2f(-fabsf(z) * LOG2E);
        la[i] = (fminf(z, 0.f) * LOG2E - __builtin_amdgcn_logf(1.f + t)) * (1.f / 16.f); }
    if (dir == 0) {
#pragma unroll
        for (int i = 1; i < 8; ++i) la[i] += la[i - 1];
        TOT[grp * 64 + d] = la[7];
    } else {
#pragma unroll
        for (int i = 6; i >= 0; --i) la[i] += la[i + 1];
        TOT[grp * 64 + d] = la[0];
    }
    __syncthreads();
    float pre = 0.f, tot = 0.f;
#pragma unroll
    for (int g = 0; g < 8; ++g) { const float tv = TOT[g * 64 + d]; tot += tv; if (dir == 0 ? (g < grp) : (g > grp)) pre += tv; }
#pragma unroll
    for (int i = 0; i < 8; ++i) Bm[(grp * 8 + i) * 64 + d] = la[i] + pre;
    if (grp == 0) BT[d] = __builtin_amdgcn_exp2f(tot);
    __syncthreads();
    { const int pr = tid >> 3, dk0 = (tid & 7) * 8;
      float qt[8], kt[8];
#pragma unroll
      for (int i = 0; i < 8; ++i) { const unsigned wk = C.k[i >> 1]; const float bb = Bm[pr * 64 + dk0 + i];
          kt[i] = bf2f((i & 1) ? (wk >> 16) : (wk & 0xffffu)) * __builtin_amdgcn_exp2f(-bb);
          if (NEEDQ) { const unsigned wq = C.q[i >> 1]; qt[i] = bf2f((i & 1) ? (wq >> 16) : (wq & 0xffffu)) * __builtin_amdgcn_exp2f(bb); } }
      u32x4 wk4; wk4.x = cvt_pk_bf16(kt[0], kt[1]); wk4.y = cvt_pk_bf16(kt[2], kt[3]); wk4.z = cvt_pk_bf16(kt[4], kt[5]); wk4.w = cvt_pk_bf16(kt[6], kt[7]);
      *(LAS u32x4*)(lds + L_KT + pr * QSTR + dk0 * 2) = wk4;
      if (NEEDQ) { u32x4 wq4; wq4.x = cvt_pk_bf16(qt[0], qt[1]); wq4.y = cvt_pk_bf16(qt[2], qt[3]); wq4.z = cvt_pk_bf16(qt[4], qt[5]); wq4.w = cvt_pk_bf16(qt[6], qt[7]);
          *(LAS u32x4*)(lds + L_QT + pr * QSTR + dk0 * 2) = wq4; } }
    if (stage_next) stage_vlr(N, cur ^ 1, lds, tid);
    __syncthreads();
    return tot;
}
__device__ __forceinline__ void state_update(f32x16& S, int mb, int nb, int LV, LAS unsigned char* lds, int hh, int q4, int pp4, int g1) {
#pragma unroll
    for (int s = 0; s < 4; ++s) {
        LAS unsigned char* kb = lds + L_KT + (16 * s + 8 * hh + q4) * QSTR + (32 * mb + 16 * g1 + 4 * pp4) * 2;
        LAS unsigned char* vb = lds + LV + (16 * s + 8 * hh + q4) * VSTR + (32 * nb + 16 * g1 + 4 * pp4) * 2;
        const s16x4 alo = vtr(kb), ahi = vtr(kb + 4 * QSTR), blo = vtr(vb), bhi = vtr(vb + 4 * VSTR);
        S = __builtin_amdgcn_mfma_f32_32x32x16_bf16((bf16x8){alo[0], alo[1], alo[2], alo[3], ahi[0], ahi[1], ahi[2], ahi[3]},
                                                    (bf16x8){blo[0], blo[1], blo[2], blo[3], bhi[0], bhi[1], bhi[2], bhi[3]}, S, 0, 0, 0);
    }
    LAS float* BT = (LAS float*)(lds + L_BT);
#pragma unroll
    for (int r = 0; r < 16; ++r) S[r] *= BT[32 * mb + crow(r, hh)];
}
__device__ __forceinline__ void load_gate_b(bf16x8& bhi, bf16x8& blo, float& biasd, const Params& p, int head, int dir, int tid) {
    const float* wa2 = dir ? p.in[11] : p.in[9]; const float* ba = dir ? p.in[12] : p.in[10];
    const int ln = tid & 63, r32_ = ln & 31, hh_ = ln >> 5, dblk = (tid >> 6) & 1, dcol = head * 64 + 32 * dblk + r32_;
    float wv[8], hf[8];
#pragma unroll
    for (int j = 0; j < 8; ++j) { wv[j] = wa2[(8 * hh_ + j) * 256 + dcol]; hf[j] = __uint_as_float(att::cvtpk_n(wv[j], 0.f) << 16); }
    u32x4 h4, l4;
    h4.x = att::cvtpk_n(hf[0], hf[1]); h4.y = att::cvtpk_n(hf[2], hf[3]); h4.z = att::cvtpk_n(hf[4], hf[5]); h4.w = att::cvtpk_n(hf[6], hf[7]);
    l4.x = att::cvtpk_n(wv[0] - hf[0], wv[1] - hf[1]); l4.y = att::cvtpk_n(wv[2] - hf[2], wv[3] - hf[3]); l4.z = att::cvtpk_n(wv[4] - hf[4], wv[5] - hf[5]); l4.w = att::cvtpk_n(wv[6] - hf[6], wv[7] - hf[7]);
    bhi = __builtin_bit_cast(bf16x8, h4); blo = __builtin_bit_cast(bf16x8, l4); biasd = ba[dcol];
}

__device__ __forceinline__ void passA(const Params& p, const bf16* Hb, float* SEG, float* LG, LAS unsigned char* lds, int bid, int G, int wave_u) {
    const int tid_l = tid_of(wave_u);
    const int tid = tid_l, lane = tid & 63, wid = __builtin_amdgcn_readfirstlane(tid >> 6), r32 = lane & 31, hh = lane >> 5;
    const int mb = wid >> 2, nb = wid & 3, q4 = (lane & 15) >> 2, pp4 = lane & 3, g1 = (lane >> 4) & 1;
    for (int si = bid; si < 512; si += G) {
        const int dir = si & 1, head = (si >> 1) & 3, sg = si >> 3;
        bf16x8 bhi, blo; float biasd; load_gate_b(bhi, blo, biasd, p, head, dir, tid);
        f32x16 S;
#pragma unroll
        for (int r = 0; r < 16; ++r) S[r] = 0.f;
        float lg = 0.f;
        ChunkRegs R;
        chunk_load<false>(R, Hb, (sg * SEGC + (dir ? SEGC - 1 : 0)) * 64, head, dir, tid);
        __syncthreads();
        stage_vlr(R, 0, lds, tid);
        __syncthreads();
        for (int n = 0; n < SEGC; ++n) {
            const ChunkRegs C = R; const int cur = n & 1;
            if (n + 1 < SEGC) chunk_load<false>(R, Hb, (sg * SEGC + (dir ? SEGC - 2 - n : n + 1)) * 64, head, dir, tid);
            lg += chunk_front<false>(C, R, n + 1 < SEGC, cur, dir, bhi, blo, biasd, lds, tid);
            state_update(S, mb, nb, cur ? L_V2 : L_V, lds, hh, q4, pp4, g1);
        }
        float* Up = SEG + (size_t)si * 8192;
#pragma unroll
        for (int r = 0; r < 16; ++r) Up[(32 * mb + crow(r, hh)) * 128 + 32 * nb + r32] = S[r];
        if (tid < 64) LG[si * 64 + tid] = lg;
    }
}
__device__ __forceinline__ void passB(float* SEG, const float* LG, int bid, int G, int wave_u) {
    const int tid_l = tid_of(wave_u);
    const int gt = bid * NTHREADS + tid_l, NTH = G * NTHREADS;
    for (int v = gt; v < 80 * 2048; v += NTH) {
        const int chain = v >> 11, e4 = v & 2047, dir = chain & 1, head = (chain >> 1) & 3, seq = chain >> 3;
        const int sg0 = seq < 2 ? seq * 16 : 32 + (seq - 2) * 4, ns = seq < 2 ? 16 : 4;
        f32x4 S = (f32x4){0.f, 0.f, 0.f, 0.f};
        for (int n = 0; n < ns; ++n) { const int si = ((sg0 + (dir ? ns - 1 - n : n)) * 4 + head) * 2 + dir;
            float* ptr = SEG + (size_t)si * 8192 + e4 * 4; const f32x4 u = *(const f32x4*)ptr; const float g = __builtin_amdgcn_exp2f(LG[si * 64 + (e4 >> 5)]);
            *(f32x4*)ptr = S; S = S * g + u; }
    }
}
__device__ __forceinline__ void passC(const Params& p, const bf16* Hb, const float* SEG, float* Z0, bf16* MIX, LAS unsigned char* lds, int bid, int G, int wave_u) {
    const int tid_l = tid_of(wave_u);
    const int tid = tid_l, lane = tid & 63, wid = __builtin_amdgcn_readfirstlane(tid >> 6), r32 = lane & 31, hh = lane >> 5;
    const int pb = wid >> 2, db = wid & 3, q4 = (lane & 15) >> 2, pp4 = lane & 3, g1 = (lane >> 4) & 1;
    for (int item = bid; item < 256; item += G) {
        const int head = item & 3, sg = item >> 2;
        for (int dir = 0; dir < 2; ++dir) {
            bf16x8 bhi, blo; float biasd; load_gate_b(bhi, blo, biasd, p, head, dir, tid);
            f32x16 S0, S1;
            { const float* Sp = SEG + (size_t)((sg * 4 + head) * 2 + dir) * 8192 + 32 * db + r32;
#pragma unroll
              for (int r = 0; r < 16; ++r) { S0[r] = Sp[crow(r, hh) * 128]; S1[r] = Sp[(32 + crow(r, hh)) * 128]; } }
            ChunkRegs R;
            chunk_load<true>(R, Hb, (sg * SEGC + (dir ? SEGC - 1 : 0)) * 64, head, dir, tid);
            __syncthreads();
            stage_vlr(R, 0, lds, tid);
            __syncthreads();
            for (int n = 0; n < SEGC; ++n) {
                const int rowbase = (sg * SEGC + (dir ? SEGC - 1 - n : n)) * 64;
                const ChunkRegs C = R; const int cur = n & 1; const int LV = cur ? L_V2 : L_V;
                if (n + 1 < SEGC) chunk_load<true>(R, Hb, (sg * SEGC + (dir ? SEGC - 2 - n : n + 1)) * 64, head, dir, tid);
                f32x16 Z;
                float* Zg = Z0 + (size_t)(rowbase + 32 * pb) * 512 + head * 128 + 32 * db + r32;
                if (dir == 0) {
#pragma unroll
                    for (int r = 0; r < 16; ++r) Z[r] = 0.f;
                } else {
#pragma unroll
                    for (int r = 0; r < 16; ++r) Z[r] = Zg[(size_t)crow(r, hh) * 512];
                }
                (void)chunk_front<true>(C, R, n + 1 < SEGC, cur, dir, bhi, blo, biasd, lds, tid);
                for (int mbp = 0; mbp < 2; ++mbp) {
                    if (dir == 0 ? (mbp > pb) : (mbp < pb)) continue;
                    f32x16 X;
#pragma unroll
                    for (int r = 0; r < 16; ++r) X[r] = 0.f;
#pragma unroll
                    for (int s = 0; s < 4; ++s) {
                        const bf16x8 a = *(LAS bf16x8*)(lds + L_KT + (32 * mbp + r32) * QSTR + (16 * s + 8 * hh) * 2);
                        const bf16x8 b = *(LAS bf16x8*)(lds + L_QT + (32 * pb + r32) * QSTR + (16 * s + 8 * hh) * 2);
                        X = __builtin_amdgcn_mfma_f32_32x32x16_bf16(a, b, X, 0, 0, 0);
                    }
#pragma unroll
                    for (int r = 0; r < 16; ++r) { const int pk = 32 * mbp + crow(r, hh), pq = 32 * pb + r32; const bool keep = dir == 0 ? (pk <= pq) : (pk >= pq); X[r] = keep ? X[r] : 0.f; }
#pragma unroll
                    for (int s2 = 0; s2 < 2; ++s2) {
                        u32x4 ww; ww.x = cvt_pk_bf16(X[8 * s2 + 0], X[8 * s2 + 1]); ww.y = cvt_pk_bf16(X[8 * s2 + 2], X[8 * s2 + 3]); ww.z = cvt_pk_bf16(X[8 * s2 + 4], X[8 * s2 + 5]); ww.w = cvt_pk_bf16(X[8 * s2 + 6], X[8 * s2 + 7]);
                        LAS unsigned char* vb = lds + LV + (32 * mbp + 16 * s2 + 4 * hh + q4) * VSTR + (32 * db + 16 * g1 + 4 * pp4) * 2;
                        const s16x4 lo = vtr(vb), hi = vtr(vb + 8 * VSTR);
                        Z = __builtin_amdgcn_mfma_f32_32x32x16_bf16(__builtin_bit_cast(bf16x8, ww), (bf16x8){lo[0], lo[1], lo[2], lo[3], hi[0], hi[1], hi[2], hi[3]}, Z, 0, 0, 0);
                    }
                }
#pragma unroll
                for (int mbs = 0; mbs < 2; ++mbs)
#pragma unroll
                    for (int s2 = 0; s2 < 2; ++s2) {
                        u32x4 ww;
                        if (mbs == 0) { ww.x = cvt_pk_bf16(S0[8 * s2 + 0], S0[8 * s2 + 1]); ww.y = cvt_pk_bf16(S0[8 * s2 + 2], S0[8 * s2 + 3]); ww.z = cvt_pk_bf16(S0[8 * s2 + 4], S0[8 * s2 + 5]); ww.w = cvt_pk_bf16(S0[8 * s2 + 6], S0[8 * s2 + 7]); }
                        else { ww.x = cvt_pk_bf16(S1[8 * s2 + 0], S1[8 * s2 + 1]); ww.y = cvt_pk_bf16(S1[8 * s2 + 2], S1[8 * s2 + 3]); ww.z = cvt_pk_bf16(S1[8 * s2 + 4], S1[8 * s2 + 5]); ww.w = cvt_pk_bf16(S1[8 * s2 + 6], S1[8 * s2 + 7]); }
                        LAS unsigned char* qa = lds + L_QT + (32 * pb + r32) * QSTR + (32 * mbs + 16 * s2 + 4 * hh) * 2;
                        const u32x2 alo = *(LAS u32x2*)qa, ahi = *(LAS u32x2*)(qa + 16);
                        const u32x4 aw = (u32x4){alo.x, alo.y, ahi.x, ahi.y};
                        Z = __builtin_amdgcn_mfma_f32_32x32x16_bf16(__builtin_bit_cast(bf16x8, aw), __builtin_bit_cast(bf16x8, ww), Z, 0, 0, 0);
                    }
                state_update(S0, 0, db, LV, lds, hh, q4, pp4, g1);
                state_update(S1, 1, db, LV, lds, hh, q4, pp4, g1);
                if (dir == 0) {
#pragma unroll
                    for (int r = 0; r < 16; ++r) Zg[(size_t)crow(r, hh) * 512] = Z[r];
                } else {
                    LAS float* Zl = (LAS float*)(lds + L_Z);
#pragma unroll
                    for (int r = 0; r < 16; ++r) Zl[(32 * pb + crow(r, hh)) * ZS + 32 * db + r32] = Z[r];
                    __syncthreads();
                    { const int pr = tid >> 3, dv0 = (tid & 7) * 16;
                      float v[16]; float ss = 0.f;
#pragma unroll
                      for (int i = 0; i < 16; ++i) { v[i] = Zl[pr * ZS + dv0 + i]; ss += v[i] * v[i]; }
                      ss += __shfl_xor(ss, 1); ss += __shfl_xor(ss, 2); ss += __shfl_xor(ss, 4);
                      const float rn = __builtin_amdgcn_rsqf(ss * (1.f / 128.f) + 1e-5f);
                      const bf16* grp_ = Hb + (size_t)(rowbase + pr) * LDH + O_GR + head * 128 + dv0;
                      const u32x4 g0 = *(const u32x4*)grp_, g1v = *(const u32x4*)(grp_ + 8);
                      const float* gn = p.in[13] + dv0;
                      float o[16];
#pragma unroll
                      for (int i = 0; i < 16; ++i) { const unsigned wv = (i < 8) ? g0[i >> 1] : g1v[(i - 8) >> 1]; const float gr = bf2f((i & 1) ? (wv >> 16) : (wv & 0xffffu));
                          const float sl = gr * __builtin_amdgcn_rcpf(1.f + fexp(-gr)); o[i] = v[i] * rn * gn[i] * sl; }
                      u32x4 a, b; a.x = cvt_pk_bf16(o[0], o[1]); a.y = cvt_pk_bf16(o[2], o[3]); a.z = cvt_pk_bf16(o[4], o[5]); a.w = cvt_pk_bf16(o[6], o[7]);
                      b.x = cvt_pk_bf16(o[8], o[9]); b.y = cvt_pk_bf16(o[10], o[11]); b.z = cvt_pk_bf16(o[12], o[13]); b.w = cvt_pk_bf16(o[14], o[15]);
                      bf16* orow = MIX + (size_t)(rowbase + pr) * D + 512 + head * 128 + dv0;
                      *(u32x4*)orow = a; *(u32x4*)(orow + 8) = b; }
                }
            }
        }
    }
}
}
__global__ void __launch_bounds__(NTHREADS) mega(Params p) {
    extern __shared__ __attribute__((aligned(16))) unsigned char lds_raw[];
    LAS unsigned char* lds = (LAS unsigned char*)lds_raw;
    cg::grid_group grid = cg::this_grid();
    const int tid = threadIdx.x, lane = tid & 63, wave = __builtin_amdgcn_readfirstlane(tid >> 6);
    const int G = gridDim.x, bid = blockIdx.x;
    unsigned char* ws = p.ws;
    bf16* WTin = (bf16*)(ws + WS_WIN); bf16* WTo = (bf16*)(ws + WS_WO); bf16* WT1 = (bf16*)(ws + WS_W1); bf16* WT2 = (bf16*)(ws + WS_W2);
    bf16* Hb = (bf16*)(ws + WS_H); bf16* XB = (bf16*)(ws + WS_XB); bf16* MIX = (bf16*)(ws + WS_MIX); bf16* X1B = (bf16*)(ws + WS_X1B); bf16* HID = (bf16*)(ws + WS_HID);
    float* ST = (float*)(ws + WS_ST); float* SEG = (float*)(ws + WS_ST + 128 * MiB); float* LG = (float*)(ws + WS_GG);
    unsigned* ctl = (unsigned*)(ws + WS_CTL);
    bf16* Y1B = (bf16*)p.out;
    bf16* Y2B = (bf16*)(ws + WS_MIX);
    bf16* KD = (bf16*)(ws + WS_KD); bf16* VD = (bf16*)(ws + WS_VD);
    const int lo = p.ph_lo, hi = p.ph_hi;
    volatile LAS unsigned* xst = (volatile LAS unsigned*)(lds + 160 * 1024 - 128);
    if (tid < 2) xst[tid] = 0u;
    __syncthreads();
    const XcdBarrier xbar = xcd_barrier_post(ctl + 1024, xst, wave);
    if (hi > 1000) grid.sync();
#ifndef R_P0
#define R_P0 1
#endif
#ifndef R_G1
#define R_G1 1
#endif
#ifndef R_G2
#define R_G2 1
#endif
#define IN(k) (lo <= (k) && (k) < hi)
#define SEAM(k) do { if (IN(k) && IN((k) + 1)) { xcd_barrier(xbar); } } while (0)
    const int gw = bid * NWAVES + wave, NGW = G * NWAVES;

for (int rp_ = 0; rp_ < R_P0; ++rp_) {     if (IN(0)) {
        if (bid == 0 && tid < 256) ctl[tid] = 0u;
        LAS float* scr = (LAS float*)(lds + wave * 16384);
        constexpr int I_IN = (D / 64) * (DIN / 32), I_O = (D / 64) * (D / 32), I_1 = (D / 64) * (FF / 32), I_2 = (FF / 64) * (D / 32);
        constexpr int NITEMS = I_IN + I_O + I_1 + I_2;
        for (int it = gw; it < NITEMS; it += NGW) {
            int r = it;
            if (r < I_IN) { p0_transpose_item(p.in[2], D, DIN, WTin, scr, r, lane); continue; } r -= I_IN;
            if (r < I_O) { p0_transpose_item(p.in[3], D, D, WTo, scr, r, lane); continue; } r -= I_O;
            if (r < I_1) { p0_transpose_item(p.in[16], D, FF, WT1, scr, r, lane); continue; } r -= I_1;
            p0_transpose_item(p.in[17], FF, D, WT2, scr, r, lane);
        }
        { u32x4* z = (u32x4*)(WTin + (size_t)DIN * D); const int nz = (DIN_PAD - DIN) * D * 2 / 16;
          for (int i = bid * NTHREADS + tid; i < nz; i += G * NTHREADS) z[i] = (u32x4){0u, 0u, 0u, 0u}; }
        { const int ln0 = tid_of(wave) & 63;
        for (int m = gw * 2; m < M; m += NGW * 2) {
            f32x4 v[2][4];
#pragma unroll
            for (int r = 0; r < 2; ++r) { const f32x4* xr = (const f32x4*)xrow_ptr(p, m + r) + ln0;
#pragma unroll
                for (int j = 0; j < 4; ++j) v[r][j] = __builtin_nontemporal_load(xr + 64 * j); }
#pragma unroll
            for (int r = 0; r < 2; ++r) { u32x2* o = (u32x2*)(XB + (size_t)(m + r) * D) + ln0;
#pragma unroll
                for (int j = 0; j < 4; ++j) { u32x2 w; w.x = cvt_pk_bf16(v[r][j].x, v[r][j].y); w.y = cvt_pk_bf16(v[r][j].z, v[r][j].w); o[64 * j] = w; } }
        } }
#if MIXER_STAGE < 1
        { u32x4* z = (u32x4*)MIX; const size_t nz = (size_t)M * D * 2 / 16;
          for (size_t i = (size_t)bid * NTHREADS + tid; i < nz; i += (size_t)G * NTHREADS) z[i] = (u32x4){0u, 0u, 0u, 0u}; }
#endif
    } }
    SEAM(0);
for (int rp_ = 0; rp_ < R_G1; ++rp_) {     if (IN(1)) {
#if MIXER_STAGE >= 1
        pg8::Gemm g{XB, WTin, M, DIN_PAD, D}; pg8::StaticOrder S; S.init(M, DIN_PAD, G, bid);
        pg8::EpiH E{Hb, LDH, DIN, C1, KD, VD};
        pg8::gemm_phase<pg8::EpiH, pg8::StaticOrder, true, true>(lds, g, S, E, wave);
#endif
    } }
    SEAM(1);
#ifndef GLA_REPS
#define GLA_REPS 1
#endif
#ifndef ATT_REPS
#define ATT_REPS 1
#endif
    for (int rep = 0; rep < GLA_REPS; ++rep) {
    if (IN(2)) {
#if MIXER_STAGE >= 1
        if (rep == 0) att::knorm_phase(KD, ctl, bid, G, wave);
#endif
#if MIXER_STAGE >= 2
        gla::passA(p, Hb, SEG, LG, lds, bid, G, wave);
#endif
    }
    SEAM(2);
    if (IN(3)) {
#if MIXER_STAGE >= 2
        gla::passB(SEG, LG, bid, G, wave);
#endif
    }
    SEAM(3);
    }
    if (IN(4)) {
#if MIXER_STAGE >= 2
        for (int rep = 0; rep < GLA_REPS; ++rep) gla::passC(p, Hb, SEG, ST, MIX, lds, bid, G, wave);
#endif
#if MIXER_STAGE >= 1
        att::attn_phase(p, Hb, KD, VD, MIX, ctl, lds, bid, G, wave);
#endif
    }
    SEAM(4);
for (int rp_ = 0; rp_ < R_G1; ++rp_) {     if (IN(5)) {
        pg8::Gemm g{MIX, WTo, M, D, D}; pg8::StaticOrder S; S.init(M, D, G, bid);
        pg8::EpiResB E{nullptr, nullptr, XB, Y1B, ALPHA};
        pg8::gemm_phase<pg8::EpiResB, pg8::StaticOrder, true, true>(lds, g, S, E, wave);
    } }
    SEAM(5);
for (int rp_ = 0; rp_ < R_P0; ++rp_) {     if (IN(6)) { const int ln_ = tid_of(wave) & 63; for (int m = gw * 4; m < M; m += NGW * 4) ln_rows4_b(Y1B + (size_t)m * D, nullptr, X1B + (size_t)m * D, p.in[14], p.in[15], ln_); } }
    SEAM(6);
for (int rp_ = 0; rp_ < R_G2; ++rp_) {     if (IN(7)) {
        pg8::Gemm g{X1B, WT1, M, FF, D}; pg8::StaticOrder S; S.init(M, FF, G, bid);
        pg8::EpiHid E{HID, FF};
        pg8::gemm_phase<pg8::EpiHid, pg8::StaticOrder, true, true>(lds, g, S, E, wave);
    } }
    SEAM(7);
for (int rp_ = 0; rp_ < R_G2; ++rp_) {     if (IN(8)) {
        pg8::Gemm g{HID, WT2, M, D, FF}; pg8::StaticOrder S; S.init(M, D, G, bid);
        pg8::EpiResB E{nullptr, nullptr, X1B, Y2B, ALPHA};
        pg8::gemm_phase<pg8::EpiResB, pg8::StaticOrder, true, true>(lds, g, S, E, wave);
    } }
    SEAM(8);
for (int rp_ = 0; rp_ < R_P0; ++rp_) {     if (IN(9)) { const int ln_ = tid_of(wave) & 63; for (int m = gw * 4; m < M; m += NGW * 4) ln_rows4_b(Y2B + (size_t)m * D, p.out + (size_t)m * D, nullptr, p.in[18], p.in[19], ln_); } }
#undef IN
#undef SEAM
}

extern "C" void kernel_launch(void* const* d_in, const int* in_sizes, int n_in, void* d_out, int out_size,
                              void* d_ws, size_t ws_size, hipStream_t stream) {
    static int grid = 0;
    if (grid == 0) {
        if (n_in != 20 || out_size != M * D || ws_size < WS_END) { fprintf(stderr, "kernel_launch: unexpected shapes (n_in %d out %d ws %zu)\n", n_in, out_size, ws_size); grid = -1; return; }
        int dev = 0, cus = 0, per_cu = 0;
        (void)hipGetDevice(&dev);
        (void)hipDeviceGetAttribute(&cus, hipDeviceAttributeMultiprocessorCount, dev);
        (void)hipFuncSetAttribute((const void*)mega, hipFuncAttributeMaxDynamicSharedMemorySize, LDS_BYTES);
        (void)hipOccupancyMaxActiveBlocksPerMultiprocessor(&per_cu, (const void*)mega, NTHREADS, LDS_BYTES);
        (void)hipGetLastError();
        grid = cus;
        fprintf(stderr, "kernel_launch: grid %d (cus %d, occupancy query %d/CU), ws %zu\n", grid, cus, per_cu, ws_size);
    }
    if (grid < 0) return;
    (void)hipMemsetAsync(d_ws, 0, 65536, stream);
    Params p{};
    for (int i = 0; i < 20; ++i) p.in[i] = (const float*)d_in[i];
    p.out = (float*)d_out; p.ws = (unsigned char*)d_ws; p.ph_lo = 0; p.ph_hi = 10;
    void* args[] = {&p};
    hipError_t e = hipLaunchCooperativeKernel((const void*)mega, dim3(grid), dim3(NTHREADS), args, LDS_BYTES, stream);
    if (e != hipSuccess) fprintf(stderr, "cooperative launch failed: %s\n", hipGetErrorString(e));
}
```

```cpp
#include <hip/hip_runtime.h>
#include <hip/hip_cooperative_groups.h>
#include <cstdio>
#include <cstdint>
namespace cg = cooperative_groups;
__device__ __forceinline__ int tid_of(int wave_u) { int t; asm volatile("v_mbcnt_lo_u32_b32 %0, -1, 0\n\tv_mbcnt_hi_u32_b32 %0, -1, %0" : "=v"(t)); return t | (wave_u << 6); }
#define MIXER_STAGE 2
namespace pg8 {
#define PG8_LAS __attribute__((address_space(3)))
typedef unsigned short bf16_t;
typedef short bf16x8 __attribute__((ext_vector_type(8)));
typedef float f32x4 __attribute__((ext_vector_type(4)));
typedef unsigned u32x4 __attribute__((ext_vector_type(4)));
constexpr int BM = 256, BK = 64, HALF = 128, HTB = HALF * BK * 2  , STAGE_BYTES = 8 * HTB, NXCD = 8, WGM = 8;

__host__ __device__ __forceinline__ int lds_byte(int r, int c) { const int st = (r >> 4) * 2 + (c >> 5), rr = r & 15, cc = c & 31, ob = rr * 64 + cc * 2; return st * 1024 + (ob ^ (((ob >> 9) & 1) << 5)); }
__host__ __device__ __forceinline__ void stage_rc(int b, int& R, int& C) { const int st = b / 1024, sb = b % 1024, swz = sb ^ (((sb >> 9) & 1) << 5); R = (st >> 1) * 16 + swz / 64; C = (st & 1) * 32 + (swz % 64) / 2; }
__host__ __device__ __forceinline__ int perm32(int rho) { const int n = rho >> 4, i = rho & 15; return 8 * (i >> 2) + 4 * n + (i & 3); }

struct Unit { int pm, pn; };
struct Gemm { const bf16_t* A; const bf16_t* Bt; int M, N, K; };

struct StaticOrder {
    int nM, nN, nwg, G, c;
    __host__ __device__ void init(int M, int N, int G_, int c_) { nM = M / BM; nN = N / BM; nwg = nM * nN; G = G_; c = c_; }
    __host__ __device__ bool next(int i, Unit& u) const {
        const long L = (long)i * G + c; if (L >= nwg) return false;
        int wgid = (int)L; { const int q = nwg / NXCD, r = nwg % NXCD, xcd = wgid % NXCD, off = wgid / NXCD; wgid = (xcd < r ? xcd * (q + 1) : r * (q + 1) + (xcd - r) * q) + off; }
        const int nig = WGM * nN, gid = wgid / nig, fm = gid * WGM, gsz = (nM - fm) < WGM ? (nM - fm) : WGM;
        u.pm = fm + ((wgid % nig) % gsz); u.pn = (wgid % nig) / gsz; return true;
    }
    __device__ __forceinline__ void a_ready(const Unit&) const {}
    __device__ __forceinline__ void done(const Unit&) const {}
};

__device__ __forceinline__ unsigned cvt_pk_bf16(float lo, float hi) { unsigned r; asm volatile("v_cvt_pk_bf16_f32 %0, %1, %2" : "=v"(r) : "v"(lo), "v"(hi)); return r; }
constexpr int M_TOK = 65536, NPROMPT = 32768, DMODEL = 1024;
struct EpiH {
    static constexpr bool PERM = true, AFTER_DRAIN = false;
    bf16_t* O; int ldc; int nvalid; float c1; bf16_t* KD; bf16_t* VD;
    __device__ __forceinline__ void operator()(const f32x4 (&acc)[2][2][4][2], const Unit& u, int wr, int wc, int fr, int fq) const {
        const int row0 = u.pm * BM + wr * 64 + fr;
        const int col0 = u.pn * BM + wc * 32 + 8 * fq;
        const float sc = (u.pn < 2) ? c1 : (u.pn == 6 ? 0.125f : 1.0f);
        const bool dense = (u.pn >= 2) && (u.pn < 6);
        bf16_t* db = (u.pn < 4) ? KD : VD;
        const int crel = col0 - ((u.pn < 4) ? 512 : 1024);
#pragma unroll
        for (int ai = 0; ai < 2; ++ai)
#pragma unroll
            for (int m = 0; m < 4; ++m) { const int row = row0 + ai * HALF + m * 16; bf16_t* rowp = O + (size_t)row * ldc + col0;
#pragma unroll
                for (int bj = 0; bj < 2; ++bj) { if (col0 + bj * HALF < nvalid) { const f32x4 v0 = acc[ai][bj][m][0] * sc, v1 = acc[ai][bj][m][1] * sc;
                    u32x4 w; w.x = cvt_pk_bf16(v0[0], v0[1]); w.y = cvt_pk_bf16(v0[2], v0[3]); w.z = cvt_pk_bf16(v1[0], v1[1]); w.w = cvt_pk_bf16(v1[2], v1[3]);
                    if (dense) { const int cr = crel + bj * HALF; __builtin_nontemporal_store(w, (u32x4*)(db + ((size_t)(cr >> 7) * M_TOK + row) * 128 + (cr & 127))); }
                    else __builtin_nontemporal_store(w, (u32x4*)(rowp + bj * HALF)); } } }
    }
};
struct EpiHid {
    static constexpr bool PERM = true, AFTER_DRAIN = false;
    bf16_t* O; int ldc;
    __device__ __forceinline__ void operator()(const f32x4 (&acc)[2][2][4][2], const Unit& u, int wr, int wc, int fr, int fq) const {
        const int row0 = u.pm * BM + wr * 64 + fr;
        const int col0 = u.pn * BM + wc * 32 + 8 * fq;
#pragma unroll
        for (int ai = 0; ai < 2; ++ai)
#pragma unroll
            for (int m = 0; m < 4; ++m) { bf16_t* rowp = O + (size_t)(row0 + ai * HALF + m * 16) * ldc + col0;
#pragma unroll
                for (int bj = 0; bj < 2; ++bj) { f32x4 v0 = acc[ai][bj][m][0], v1 = acc[ai][bj][m][1];
#pragma unroll
                    for (int e = 0; e < 4; ++e) { const float a = fmaxf(v0[e], 0.f), b = fmaxf(v1[e], 0.f); v0[e] = a * a; v1[e] = b * b; }
                    u32x4 w; w.x = cvt_pk_bf16(v0[0], v0[1]); w.y = cvt_pk_bf16(v0[2], v0[3]); w.z = cvt_pk_bf16(v1[0], v1[1]); w.w = cvt_pk_bf16(v1[2], v1[3]);
                    __builtin_nontemporal_store(w, (u32x4*)(rowp + bj * HALF)); } }
    }
};
struct EpiRes {
    static constexpr bool PERM = false, AFTER_DRAIN = false;
    const float* xp; const float* xs; float* out; float alpha;
    __device__ __forceinline__ void operator()(const f32x4 (&acc)[2][2][4][2], const Unit& u, int wr, int wc, int fr, int fq) const {
        const int col0 = u.pn * BM + wc * 32 + 4 * fq;
#pragma unroll
        for (int ai = 0; ai < 2; ++ai)
#pragma unroll
            for (int m = 0; m < 4; ++m) { const int row = u.pm * BM + ai * HALF + wr * 64 + m * 16 + fr;
                float* orow = out + (size_t)row * DMODEL;
                const float* xr = xp ? ((row < NPROMPT) ? xp + (size_t)row * DMODEL : xs + (size_t)(row - NPROMPT) * DMODEL) : orow;
#pragma unroll
                for (int bj = 0; bj < 2; ++bj)
#pragma unroll
                    for (int n = 0; n < 2; ++n) { const int c = col0 + bj * HALF + n * 16; const f32x4 xv = *(const f32x4*)(xr + c); *(f32x4*)(orow + c) = xv * alpha + acc[ai][bj][m][n]; } }
    }
};


struct EpiResB {
    static constexpr bool PERM = true, AFTER_DRAIN = false;
    const float* xp; const float* xs; const bf16_t* RB; bf16_t* Y; float alpha;
    __device__ __forceinline__ void operator()(const f32x4 (&acc)[2][2][4][2], const Unit& u, int wr, int wc, int fr, int fq) const {
        const int col0 = u.pn * BM + wc * 32 + 8 * fq;
#pragma unroll
        for (int ai = 0; ai < 2; ++ai)
#pragma unroll
            for (int m = 0; m < 4; ++m) { const int row = u.pm * BM + ai * HALF + wr * 64 + m * 16 + fr;
#pragma unroll
                for (int bj = 0; bj < 2; ++bj) { const int c = col0 + bj * HALF;
                    f32x4 r0, r1;
                    if (xp) { const float* xr = ((row < NPROMPT) ? xp + (size_t)row * DMODEL : xs + (size_t)(row - NPROMPT) * DMODEL) + c; r0 = *(const f32x4*)xr; r1 = *(const f32x4*)(xr + 4); }
                    else { const u32x4 w = *(const u32x4*)(RB + (size_t)row * DMODEL + c);
                        r0 = (f32x4){__uint_as_float(w.x << 16), __uint_as_float(w.x & 0xffff0000u), __uint_as_float(w.y << 16), __uint_as_float(w.y & 0xffff0000u)};
                        r1 = (f32x4){__uint_as_float(w.z << 16), __uint_as_float(w.z & 0xffff0000u), __uint_as_float(w.w << 16), __uint_as_float(w.w & 0xffff0000u)}; }
                    const f32x4 v0 = r0 * alpha + acc[ai][bj][m][0], v1 = r1 * alpha + acc[ai][bj][m][1];
                    u32x4 o; o.x = cvt_pk_bf16(v0[0], v0[1]); o.y = cvt_pk_bf16(v0[2], v0[3]); o.z = cvt_pk_bf16(v1[0], v1[1]); o.w = cvt_pk_bf16(v1[2], v1[3]);
                    *(u32x4*)(Y + (size_t)row * DMODEL + c) = o; } }
    }
};

template <class Epi, class Sched, bool ALIGN_EPI = false, bool SP2 = false>
__device__ __forceinline__ void gemm_phase(PG8_LAS unsigned char* lds, const Gemm g, const Sched& S, const Epi& E, int wave_u) {
    const int tid_l = tid_of(wave_u);
    const int tid = tid_l, wid = __builtin_amdgcn_readfirstlane(tid >> 6), lane = tid & 63, wr = wid >> 2, wc = wid & 3, fr = lane & 15, fq = lane >> 4;
    const int K = g.K, nt = K / BK;
    unsigned voffA[2], voffB[2];
#pragma unroll
    for (int i = 0; i < 2; ++i) { int R, C; stage_rc(tid * 16 + i * 8192, R, C); const int Rb = Epi::PERM ? ((R & ~31) + perm32(R & 31)) : R;
        voffA[i] = (unsigned)(R * K + C) * 2u; voffB[i] = (unsigned)(Rb * K + C) * 2u; }
    const size_t kstep = (size_t)(BK * 2);
    const size_t hstep = (size_t)HALF * K * 2;
    const size_t tstep = 2 * hstep;
    const unsigned ldsw = (unsigned)wid * 1024u;
    const int aoff = lds_byte(wr * 64 + fr, fq * 8), boff = lds_byte(wc * 32 + fr, fq * 8);
#define PG8_SA(b, h) (((b) * 2 + (h)) * HTB)
#define PG8_SB(b, h) ((4 + (b) * 2 + (h)) * HTB)
#define PG8_STAGE(bufoff, gbase, voff) do { _Pragma("unroll") for (int _i = 0; _i < 2; ++_i) \
        __builtin_amdgcn_global_load_lds((const unsigned*)((const char*)(gbase) + (voff)[_i]), (PG8_LAS unsigned*)(lds + (bufoff) + ldsw + _i * 8192), 16, 0, 0); } while (0)
#define PG8_LDA(dst, b, h) do { _Pragma("unroll") for (int m = 0; m < 4; ++m) _Pragma("unroll") for (int k = 0; k < 2; ++k) dst[m][k] = *(const PG8_LAS bf16x8*)(lds + PG8_SA(b, h) + aoff + m * 2048 + k * 1024); } while (0)
#define PG8_LDB(dst, b, h) do { _Pragma("unroll") for (int n = 0; n < 2; ++n) _Pragma("unroll") for (int k = 0; k < 2; ++k) dst[n][k] = *(const PG8_LAS bf16x8*)(lds + PG8_SB(b, h) + boff + n * 2048 + k * 1024); } while (0)
#define PG8_MMA(ai, bj, At, Bt) do { __builtin_amdgcn_s_setprio(1); _Pragma("unroll") for (int m = 0; m < 4; ++m) _Pragma("unroll") for (int n = 0; n < 2; ++n) _Pragma("unroll") for (int k = 0; k < 2; ++k) \
        acc[ai][bj][m][n] = __builtin_amdgcn_mfma_f32_16x16x32_bf16(Bt[n][k], At[m][k], acc[ai][bj][m][n], 0, 0, 0); __builtin_amdgcn_s_setprio(0); } while (0)
#define PG8_WAIT_V(n) asm volatile("s_waitcnt vmcnt(" #n ")" ::: "memory")
#define PG8_WAIT_L(n) asm volatile("s_waitcnt lgkmcnt(" #n ")" ::: "memory")
#define PG8_BAR __builtin_amdgcn_s_barrier()
#define PG8_SCHED __builtin_amdgcn_sched_barrier(0)
    Unit cur, nxt; int ui = 0;
    if (!S.next(0, cur)) return;
    f32x4 acc[2][2][4][2];
#pragma unroll
    for (int a = 0; a < 2; ++a)
#pragma unroll
        for (int b = 0; b < 2; ++b)
#pragma unroll
            for (int m = 0; m < 4; ++m)
#pragma unroll
                for (int n = 0; n < 2; ++n) acc[a][b][m][n] = (f32x4){0.f, 0.f, 0.f, 0.f};
    bf16x8 At[4][2], B0[2][2], B1[2][2];
    const char* cA = (const char*)g.A + (size_t)cur.pm * tstep; const char* cB = (const char*)g.Bt + (size_t)cur.pn * tstep;
    S.a_ready(cur);
    if constexpr (SP2) {
        PG8_STAGE(PG8_SB(0, 0), cB, voffB); PG8_STAGE(PG8_SB(0, 1), cB + hstep, voffB); PG8_STAGE(PG8_SA(0, 0), cA, voffA); PG8_STAGE(PG8_SA(0, 1), cA + hstep, voffA);
        if (wr == 1) PG8_BAR;
        PG8_WAIT_V(2); PG8_BAR;
        PG8_STAGE(PG8_SB(1, 0), cB + kstep, voffB); PG8_STAGE(PG8_SA(1, 0), cA + kstep, voffA); PG8_STAGE(PG8_SB(1, 1), cB + hstep + kstep, voffB);
        PG8_WAIT_V(6); PG8_BAR;
    } else {
        PG8_STAGE(PG8_SB(0, 0), cB, voffB); PG8_STAGE(PG8_SA(0, 0), cA, voffA); PG8_STAGE(PG8_SB(0, 1), cB + hstep, voffB); PG8_STAGE(PG8_SA(0, 1), cA + hstep, voffA);
        if (wr == 1) PG8_BAR;
        PG8_WAIT_V(4); PG8_BAR;
        PG8_STAGE(PG8_SB(1, 0), cB + kstep, voffB); PG8_STAGE(PG8_SA(1, 0), cA + kstep, voffA); PG8_STAGE(PG8_SB(1, 1), cB + hstep + kstep, voffB);
        PG8_WAIT_V(6); PG8_BAR;
    }
    for (;;) {
        const bool has_next = S.next(ui + 1, nxt);
        const char* nA = has_next ? (const char*)g.A + (size_t)nxt.pm * tstep : cA; const char* nB = has_next ? (const char*)g.Bt + (size_t)nxt.pn * tstep : cB;
        for (int t = 0; t < nt; t += 2) {
            const bool last = (t == nt - 2);
            const char* a1 = cA + (size_t)(t + 1) * kstep;
            const char* a2 = last ? nA : cA + (size_t)(t + 2) * kstep; const char* b2 = last ? nB : cB + (size_t)(t + 2) * kstep;
            const char* a3 = a2 + kstep; const char* b3 = b2 + kstep;
            if (last && has_next) S.a_ready(nxt);
            if constexpr (SP2) {
            PG8_LDB(B0, 0, 0); PG8_LDB(B1, 0, 1); PG8_SCHED; PG8_LDA(At, 0, 0); PG8_STAGE(PG8_SA(1, 1), a1 + hstep, voffA);
            PG8_WAIT_V(8); PG8_WAIT_L(0); PG8_BAR; PG8_MMA(0, 0, At, B0); PG8_MMA(0, 1, At, B1); PG8_BAR; PG8_SCHED;
            PG8_LDA(At, 0, 1); PG8_STAGE(PG8_SB(0, 0), b2, voffB); PG8_STAGE(PG8_SB(0, 1), b2 + hstep, voffB); PG8_STAGE(PG8_SA(0, 0), a2, voffA);
            PG8_WAIT_V(8); PG8_WAIT_L(0); PG8_BAR; PG8_MMA(1, 0, At, B0); PG8_MMA(1, 1, At, B1); PG8_BAR; PG8_SCHED;
            PG8_LDB(B0, 1, 0); PG8_LDB(B1, 1, 1); PG8_SCHED; PG8_LDA(At, 1, 0); PG8_STAGE(PG8_SA(0, 1), a2 + hstep, voffA);
            PG8_WAIT_V(8); PG8_WAIT_L(0); PG8_BAR; PG8_MMA(0, 0, At, B0); PG8_MMA(0, 1, At, B1); PG8_BAR; PG8_SCHED;
            PG8_LDA(At, 1, 1); PG8_STAGE(PG8_SB(1, 0), b3, voffB); PG8_STAGE(PG8_SB(1, 1), b3 + hstep, voffB); PG8_STAGE(PG8_SA(1, 0), a3, voffA);
            PG8_WAIT_V(8); PG8_WAIT_L(0); PG8_BAR; PG8_MMA(1, 0, At, B0); PG8_MMA(1, 1, At, B1); PG8_BAR; PG8_SCHED;
            } else {
            PG8_LDB(B0, 0, 0); PG8_SCHED; PG8_LDA(At, 0, 0); PG8_STAGE(PG8_SA(1, 1), a1 + hstep, voffA);
            PG8_WAIT_L(8); PG8_BAR; PG8_WAIT_L(0); PG8_MMA(0, 0, At, B0); PG8_BAR; PG8_SCHED;
            PG8_LDB(B1, 0, 1); PG8_STAGE(PG8_SB(0, 0), b2, voffB);
            PG8_BAR; PG8_WAIT_L(0); PG8_MMA(0, 1, At, B1); PG8_BAR;
            PG8_LDA(At, 0, 1); PG8_STAGE(PG8_SA(0, 0), a2, voffA);
            PG8_BAR; PG8_WAIT_L(0); PG8_MMA(1, 0, At, B0); PG8_BAR; PG8_SCHED;
            PG8_STAGE(PG8_SB(0, 1), b2 + hstep, voffB);
            PG8_WAIT_V(6); PG8_BAR; PG8_MMA(1, 1, At, B1); PG8_BAR;
            PG8_LDB(B0, 1, 0); PG8_SCHED; PG8_LDA(At, 1, 0); PG8_STAGE(PG8_SA(0, 1), a2 + hstep, voffA);
            PG8_WAIT_L(8); PG8_BAR; PG8_WAIT_L(0); PG8_MMA(0, 0, At, B0); PG8_BAR; PG8_SCHED;
            PG8_LDB(B1, 1, 1); PG8_STAGE(PG8_SB(1, 0), b3, voffB);
            PG8_BAR; PG8_WAIT_L(0); PG8_MMA(0, 1, At, B1); PG8_BAR;
            PG8_LDA(At, 1, 1); PG8_STAGE(PG8_SA(1, 0), a3, voffA);
            PG8_BAR; PG8_WAIT_L(0); PG8_MMA(1, 0, At, B0); PG8_BAR; PG8_SCHED;
            PG8_STAGE(PG8_SB(1, 1), b3 + hstep, voffB);
            PG8_WAIT_V(6); PG8_BAR; PG8_MMA(1, 1, At, B1); PG8_BAR;
            }
        }
        if constexpr (ALIGN_EPI) { if (wr == 0) PG8_BAR; }
        if constexpr (!Epi::AFTER_DRAIN) { E(acc, cur, wr, wc, fr, fq); S.done(cur); }
        if (!has_next) break;
#pragma unroll
        for (int a = 0; a < 2; ++a)
#pragma unroll
            for (int b = 0; b < 2; ++b)
#pragma unroll
                for (int m = 0; m < 4; ++m)
#pragma unroll
                    for (int n = 0; n < 2; ++n) acc[a][b][m][n] = (f32x4){0.f, 0.f, 0.f, 0.f};
        cur = nxt; cA = nA; cB = nB; ++ui;
        if constexpr (ALIGN_EPI) { if (wr == 1) PG8_BAR; }
    }
    PG8_WAIT_V(0);
    if constexpr (!ALIGN_EPI) { if (wr == 0) PG8_BAR; }
    PG8_BAR;
    if constexpr (Epi::AFTER_DRAIN) { E.fused(acc, cur, wr, wc, fr, fq, lds, wid, lane); S.done(cur); }
#undef PG8_SA
#undef PG8_SB
#undef PG8_STAGE
#undef PG8_LDA
#undef PG8_LDB
#undef PG8_MMA
#undef PG8_WAIT_V
#undef PG8_WAIT_L
#undef PG8_BAR
#undef PG8_SCHED
}
}
#define LAS __attribute__((address_space(3)))
typedef unsigned short bf16;
typedef float f32x4 __attribute__((ext_vector_type(4)));
typedef float f32x16 __attribute__((ext_vector_type(16)));
typedef short bf16x8 __attribute__((ext_vector_type(8)));
typedef short s16x4 __attribute__((ext_vector_type(4)));
typedef unsigned u32x4 __attribute__((ext_vector_type(4)));
typedef unsigned u32x2 __attribute__((ext_vector_type(2)));
using pg8::cvt_pk_bf16;

constexpr int NTHREADS = 512, NWAVES = 8;
constexpr int M = 65536, D = 1024, FF = 4096, DIN = 3104, DIN_PAD = 3328, LDH = 3104;
constexpr int NSEQ = 10, S_P = 16384, S_S = 4096, NPR = 32768;
constexpr int O_DQ = 0, O_DK = 512, O_DV = 1024, O_GQ = 1536, O_GK = 1792, O_GV = 2048, O_GR = 2560, O_LRF = 3072, O_LRB = 3088;
constexpr float LN_EPS = 1e-5f;
constexpr float ALPHA = 1.189207115002721f;
constexpr float LAM_INIT = 0.2f;
constexpr float C1 = 0.125f * 1.4426950408889634f;

constexpr size_t MiB = 1u << 20;
constexpr size_t WS_CTL = 0;
constexpr size_t WS_WIN = 2 * MiB, WS_WO = 9 * MiB, WS_W1 = 11 * MiB, WS_W2 = 19 * MiB, WS_GG = 27 * MiB;
constexpr size_t WS_H = 32 * MiB;
constexpr size_t WS_XB = 420 * MiB;
constexpr size_t WS_MIX = 548 * MiB;
constexpr size_t WS_ST = 676 * MiB;
constexpr size_t WS_X1B = 676 * MiB;
constexpr size_t WS_HID = 32 * MiB;
constexpr size_t WS_KD = 832 * MiB, WS_VD = 896 * MiB;
constexpr size_t WS_END = 960 * MiB;
static_assert(WS_H + (size_t)M * LDH * 2 <= WS_XB && WS_HID + (size_t)M * FF * 2 <= WS_MIX && WS_X1B + (size_t)M * D * 2 <= WS_END, "ws map");

constexpr int RING_BYTES = 131072;
constexpr int LDS_BYTES = 160 * 1024;

struct Params {
    const float* in[20];
    float* out;
    unsigned char* ws;
    int ph_lo, ph_hi;
};

__device__ __forceinline__ float wave_sum(float v) {
#pragma unroll
    for (int o = 1; o < 64; o <<= 1) v += __shfl_xor(v, o);
    return v;
}
__device__ __forceinline__ const float* xrow_ptr(const Params& p, int m) { return (m < NPR) ? p.in[0] + (size_t)m * D : p.in[1] + (size_t)(m - NPR) * D; }

__device__ __forceinline__ void p0_transpose_item(const float* W, int K, int N, bf16* WT, LAS float* scr, int item, int lane) {
    const int nblk = N / 32, kb = item / nblk, nb = item % nblk, k0 = 64 * kb, n0 = 32 * nb;
#pragma unroll 8
    for (int i = 0; i < 32; ++i) { const int kk = 2 * i + (lane >> 5); scr[kk * 33 + (lane & 31)] = W[(size_t)(k0 + kk) * N + n0 + (lane & 31)]; }
    asm volatile("s_waitcnt vmcnt(0) lgkmcnt(0)" ::: "memory");
    const int c = lane & 7;
#pragma unroll
    for (int j = 0; j < 4; ++j) { const int n = (lane >> 3) + 8 * j; const LAS float* s = scr + (8 * c) * 33 + n;
        u32x4 o; o.x = cvt_pk_bf16(s[0 * 33], s[1 * 33]); o.y = cvt_pk_bf16(s[2 * 33], s[3 * 33]); o.z = cvt_pk_bf16(s[4 * 33], s[5 * 33]); o.w = cvt_pk_bf16(s[6 * 33], s[7 * 33]);
        *(u32x4*)(WT + (size_t)(n0 + n) * K + k0 + 8 * c) = o; }
    asm volatile("s_waitcnt lgkmcnt(0)" ::: "memory");
}

__device__ __forceinline__ void ln_row(const float* in, float* outf, bf16* outb, const float* g, const float* b, int lane) {
    const f32x4* xr = (const f32x4*)in + lane;
    f32x4 v[4]; float s = 0.f;
#pragma unroll
    for (int j = 0; j < 4; ++j) { v[j] = xr[64 * j]; s += (v[j].x + v[j].y) + (v[j].z + v[j].w); }
    const float mean = wave_sum(s) * (1.f / D); float s2 = 0.f;
#pragma unroll
    for (int j = 0; j < 4; ++j) { v[j] = v[j] - mean; s2 += (v[j].x * v[j].x + v[j].y * v[j].y) + (v[j].z * v[j].z + v[j].w * v[j].w); }
    const float rstd = 1.f / sqrtf(wave_sum(s2) * (1.f / D) + LN_EPS);
#pragma unroll
    for (int j = 0; j < 4; ++j) {
        const f32x4 g4 = ((const f32x4*)g)[lane + 64 * j], b4 = ((const f32x4*)b)[lane + 64 * j];
        const f32x4 o = v[j] * rstd * g4 + b4;
        ((f32x4*)outf)[lane + 64 * j] = o;
        if (outb) { u32x2 w; w.x = cvt_pk_bf16(o.x, o.y); w.y = cvt_pk_bf16(o.z, o.w); ((u32x2*)outb)[lane + 64 * j] = w; }
    }
}

__device__ __forceinline__ void ln_row_b(const bf16* in, float* outf, bf16* outb, const float* g, const float* b, int lane) {
    const u32x4 wa = ((const u32x4*)in)[lane], wb = ((const u32x4*)in)[64 + lane];
    float v[16];
#pragma unroll
    for (int i = 0; i < 4; ++i) { v[2 * i] = __uint_as_float(wa[i] << 16); v[2 * i + 1] = __uint_as_float(wa[i] & 0xffff0000u); v[8 + 2 * i] = __uint_as_float(wb[i] << 16); v[8 + 2 * i + 1] = __uint_as_float(wb[i] & 0xffff0000u); }
    float s = 0.f;
#pragma unroll
    for (int i = 0; i < 16; ++i) s += v[i];
    const float mean = wave_sum(s) * (1.f / D); float s2 = 0.f;
#pragma unroll
    for (int i = 0; i < 16; ++i) { v[i] -= mean; s2 += v[i] * v[i]; }
    const float rstd = 1.f / sqrtf(wave_sum(s2) * (1.f / D) + LN_EPS);
#pragma unroll
    for (int h = 0; h < 2; ++h) {
        const int e0 = h * 512 + 8 * lane;
        const f32x4 g0 = *(const f32x4*)(g + e0), g1 = *(const f32x4*)(g + e0 + 4), b0 = *(const f32x4*)(b + e0), b1 = *(const f32x4*)(b + e0 + 4);
        const f32x4 o0 = (f32x4){v[8 * h + 0], v[8 * h + 1], v[8 * h + 2], v[8 * h + 3]} * rstd * g0 + b0;
        const f32x4 o1 = (f32x4){v[8 * h + 4], v[8 * h + 5], v[8 * h + 6], v[8 * h + 7]} * rstd * g1 + b1;
        if (outf) { *(f32x4*)(outf + e0) = o0; *(f32x4*)(outf + e0 + 4) = o1; }
        if (outb) { u32x4 w; w.x = cvt_pk_bf16(o0.x, o0.y); w.y = cvt_pk_bf16(o0.z, o0.w); w.z = cvt_pk_bf16(o1.x, o1.y); w.w = cvt_pk_bf16(o1.z, o1.w); *(u32x4*)(outb + e0) = w; }
    }
}

__device__ __forceinline__ void ln_rows4_b(const bf16* in, float* outf, bf16* outb, const float* g, const float* b, int lane) {
    u32x4 wa[4], wb[4];
#pragma unroll
    for (int r = 0; r < 4; ++r) { wa[r] = __builtin_nontemporal_load((const u32x4*)(in + (size_t)r * D) + lane); wb[r] = __builtin_nontemporal_load((const u32x4*)(in + (size_t)r * D) + 64 + lane); }
    float v[4][16], s[4], s2[4];
#pragma unroll
    for (int r = 0; r < 4; ++r) { s[r] = 0.f;
#pragma unroll
        for (int i = 0; i < 4; ++i) { v[r][2 * i] = __uint_as_float(wa[r][i] << 16); v[r][2 * i + 1] = __uint_as_float(wa[r][i] & 0xffff0000u); v[r][8 + 2 * i] = __uint_as_float(wb[r][i] << 16); v[r][8 + 2 * i + 1] = __uint_as_float(wb[r][i] & 0xffff0000u); }
#pragma unroll
        for (int i = 0; i < 16; ++i) s[r] += v[r][i]; }
#pragma unroll
    for (int o = 1; o < 64; o <<= 1) {
#pragma unroll
        for (int r = 0; r < 4; ++r) s[r] += __shfl_xor(s[r], o); }
#pragma unroll
    for (int r = 0; r < 4; ++r) { const float mean = s[r] * (1.f / D); s2[r] = 0.f;
#pragma unroll
        for (int i = 0; i < 16; ++i) { v[r][i] -= mean; s2[r] += v[r][i] * v[r][i]; } }
#pragma unroll
    for (int o = 1; o < 64; o <<= 1) {
#pragma unroll
        for (int r = 0; r < 4; ++r) s2[r] += __shfl_xor(s2[r], o); }
#pragma unroll
    for (int h = 0; h < 2; ++h) {
        const int e0 = h * 512 + 8 * lane;
        const f32x4 g0 = *(const f32x4*)(g + e0), g1 = *(const f32x4*)(g + e0 + 4), b0 = *(const f32x4*)(b + e0), b1 = *(const f32x4*)(b + e0 + 4);
#pragma unroll
        for (int r = 0; r < 4; ++r) {
            const float rstd = 1.f / sqrtf(s2[r] * (1.f / D) + LN_EPS);
            const f32x4 o0 = (f32x4){v[r][8 * h + 0], v[r][8 * h + 1], v[r][8 * h + 2], v[r][8 * h + 3]} * rstd * g0 + b0;
            const f32x4 o1 = (f32x4){v[r][8 * h + 4], v[r][8 * h + 5], v[r][8 * h + 6], v[r][8 * h + 7]} * rstd * g1 + b1;
            if (outf) { __builtin_nontemporal_store(o0, (f32x4*)(outf + (size_t)r * D + e0)); __builtin_nontemporal_store(o1, (f32x4*)(outf + (size_t)r * D + e0 + 4)); }
            if (outb) { u32x4 w; w.x = cvt_pk_bf16(o0.x, o0.y); w.y = cvt_pk_bf16(o0.z, o0.w); w.z = cvt_pk_bf16(o1.x, o1.y); w.w = cvt_pk_bf16(o1.z, o1.w); *(u32x4*)(outb + (size_t)r * D + e0) = w; }
        }
    }
}
#define RLX_AGENT __ATOMIC_RELAXED, __HIP_MEMORY_SCOPE_AGENT
#define XB_TMO      128
#define XB_XCNT(j)  (256  + 64 * (j))
#define XB_XSUB(j)  (1280 + 64 * (j))
#define XB_XGEN(j)  (2304 + 64 * (j))
#define XB_TOP      3328
#define XB_TOPGEN   3392
#define XCD_BAR_WORDS 3456
#define XB_SPIN_CAP (1u << 18)

__device__ __forceinline__ unsigned xb_ld(unsigned* p)              { return __hip_atomic_load(p, __ATOMIC_RELAXED, __HIP_MEMORY_SCOPE_AGENT); }
__device__ __forceinline__ unsigned xb_add(unsigned* p, unsigned v) { return __hip_atomic_fetch_add(p, v, __ATOMIC_RELAXED, __HIP_MEMORY_SCOPE_AGENT); }
__device__ __forceinline__ unsigned xb_xcc_id() { return (unsigned)__builtin_amdgcn_s_getreg((3 << 11) | 20) & 0xFu; }
#define XB_SPIN(cond, bar) do { unsigned _sp = 0; while (cond) { __builtin_amdgcn_s_sleep(1); \
    if ((++_sp & 255u) == 0u) { if (xb_ld(&(bar)[XB_TMO])) break; if (_sp > XB_SPIN_CAP) { atomicAdd(&(bar)[XB_TMO], 1u); break; } } } } while (0)

struct XcdBarrier {
    unsigned* bar; unsigned x; int wv;
    volatile LAS unsigned* st;
};

__device__ __forceinline__ XcdBarrier xcd_barrier_post(unsigned* bar, volatile LAS unsigned* st, int wave_u) {
    XcdBarrier b; b.bar = bar; b.x = xb_xcc_id(); b.st = st; b.wv = wave_u;
    if (tid_of(wave_u) == 0) (void)xb_add(&bar[XB_XCNT(b.x)], 1u);
    return b;
}
__device__ __forceinline__ void xcd_barrier_complete(unsigned* bar, unsigned x, unsigned& nloc, unsigned& nx) {
    const unsigned G = gridDim.x * gridDim.y * gridDim.z;
    unsigned sum, cnt, mine, sp = 0u;
    for (;;) {
        sum = 0u; cnt = 0u; mine = 0u;
#pragma unroll
        for (unsigned j = 0; j < 16; ++j) { const unsigned c = xb_ld(&bar[XB_XCNT(j)]); sum += c; cnt += (c > 0u) ? 1u : 0u; mine = (j == x) ? c : mine; }
        if (sum == G) break;
        __builtin_amdgcn_s_sleep(1);
        if ((++sp & 255u) == 0u) { if (xb_ld(&bar[XB_TMO])) break; if (sp > XB_SPIN_CAP) { atomicAdd(&bar[XB_TMO], 1u); break; } }
    }
    nloc = mine > 0u ? mine : 1u; nx = cnt > 0u ? cnt : 1u;
}

__device__ __forceinline__ void xcd_barrier(const XcdBarrier& b) {
    asm volatile("s_waitcnt vmcnt(0)" ::: "memory");
    __syncthreads();
    if (tid_of(b.wv) == 0) {
        unsigned* bar = b.bar;
        __builtin_amdgcn_s_waitcnt(0);
        unsigned nloc = b.st[0], nx = b.st[1];
        if (nloc == 0u) { xcd_barrier_complete(bar, b.x, nloc, nx); b.st[0] = nloc; b.st[1] = nx; }
        const unsigned old = xb_add(&bar[XB_XSUB(b.x)], 1u);
        const unsigned gen = old / nloc;
        if (old + 1u == (gen + 1u) * nloc) {
            __builtin_amdgcn_fence(__ATOMIC_RELEASE, "agent");
            asm volatile("s_waitcnt vmcnt(0)" ::: "memory");
            const unsigned og = xb_add(&bar[XB_TOP], 1u);
            const unsigned tg = og / nx;
            if (og + 1u == (tg + 1u) * nx) xb_add(&bar[XB_TOPGEN], 1u);
            else XB_SPIN(xb_ld(&bar[XB_TOPGEN]) == tg, bar);
            __builtin_amdgcn_fence(__ATOMIC_ACQUIRE, "agent");
            xb_add(&bar[XB_XGEN(b.x)], 1u);
            asm volatile("s_waitcnt vmcnt(0)" ::: "memory");
        } else {
            XB_SPIN(xb_ld(&bar[XB_XGEN(b.x)]) == gen, bar);
            __builtin_amdgcn_fence(__ATOMIC_ACQUIRE, "agent");
            asm volatile("s_waitcnt vmcnt(0)" ::: "memory");
        }
    }
    __syncthreads();
}
#ifndef ATT_REPS
#define ATT_REPS 1
#endif
namespace att {
typedef short v4i16_t __attribute__((ext_vector_type(4)));
typedef float f32x2 __attribute__((ext_vector_type(2)));
typedef __bf16 bf16x2_t __attribute__((ext_vector_type(2)));
__device__ __forceinline__ unsigned cvtpk_n(float lo, float hi) { const f32x2 v = {lo, hi}; return __builtin_bit_cast(unsigned, __builtin_convertvector(v, bf16x2_t)); }
constexpr int KSTR = 272, VSTR = 320;
constexpr int KBUF = 64 * KSTR, VBUF = 64 * VSTR, BUFB = KBUF + VBUF;
constexpr int XS = 132;
constexpr int TILEB = 32768;
constexpr int L_RED = 4 * TILEB;
constexpr int L_CTL = 160 * 1024 - 256;
constexpr float SKIP_T = 38.f;
constexpr int CW_UNIT = 160, CW_KN = 64;
__device__ __forceinline__ int crow(int r, int hi) { return (r & 3) + 8 * (r >> 2) + 4 * hi; }
__device__ __forceinline__ s16x4 vtr(LAS unsigned char* p) { return __builtin_bit_cast(s16x4, __builtin_amdgcn_ds_read_tr16_b64_v4i16((LAS v4i16_t*)p)); }
__device__ __forceinline__ float bf_lo(unsigned w) { return __uint_as_float(w << 16); }
__device__ __forceinline__ float bf_hi(unsigned w) { return __uint_as_float(w & 0xffff0000u); }

__device__ __forceinline__ void knorm_phase(const bf16* KD, unsigned* ctl, int bid, int G, int wave_u) {
    const int tid_l = tid_of(wave_u);
    const int gt = bid * NTHREADS + tid_l, NTH = G * NTHREADS;
    for (int idx = gt; idx < M * 8; idx += NTH) {
        const int row = idx >> 3, hc = idx & 7;
        const u32x4* kp = (const u32x4*)(KD + ((size_t)(hc >> 1) * M + row) * 128 + (hc & 1) * 64);
        float ss = 0.f;
#pragma unroll
        for (int i = 0; i < 8; ++i) { const u32x4 w = kp[i];
#pragma unroll
            for (int e = 0; e < 4; ++e) { const float a = bf_lo(w[e]), b = bf_hi(w[e]); ss = fmaf(a, a, ss); ss = fmaf(b, b, ss); } }
        float nr = sqrtf(ss);
        nr = fmaxf(nr, __shfl_xor(nr, 8)); nr = fmaxf(nr, __shfl_xor(nr, 16)); nr = fmaxf(nr, __shfl_xor(nr, 32));
        const int seq = (row < NPR) ? (row >> 14) : 2 + ((row - NPR) >> 12);
        if ((tid_l & 63) < 8) atomicMax(ctl + CW_KN + seq * 8 + hc, __float_as_uint(nr));
    }
}

__device__ __forceinline__ void attn_unit(const bf16* Hb, const bf16* KD, const bf16* VD, bf16* MIX, int row0, int S, int head, int qb, float lam, const float* dng, float kn0, float kn1, LAS unsigned char* lds, int wave_u) {
    const int tid_l = tid_of(wave_u);
    const int tid = tid_l, lane = tid & 63, wid = __builtin_amdgcn_readfirstlane(tid >> 6), r32 = lane & 31, hh = lane >> 5;
    const int c = wid >> 2, qs = wid & 3;
    const int q0 = qb * 128 + qs * 32;
    const float slope2 = __uint_as_float(__builtin_amdgcn_readfirstlane(__float_as_uint(exp2f(-2.f * (float)(head + 1)) * 1.4426950408889634f)));
    lam = __uint_as_float(__builtin_amdgcn_readfirstlane(__float_as_uint(lam)));
    bf16x8 qr[4];
    float mub;
    float m;
    {   const bf16* Qp = Hb + (size_t)(row0 + q0 + r32) * LDH + O_DQ + head * 128 + c * 64 + hh * 8;
        const bf16* Kp = KD + ((size_t)head * M + row0 + q0 + r32) * 128 + c * 64 + hh * 8;
        float qq = 0.f, dot = 0.f;
#pragma unroll
        for (int d0 = 0; d0 < 4; ++d0) { qr[d0] = *(const bf16x8*)(Qp + d0 * 16); const u32x4 qw = __builtin_bit_cast(u32x4, qr[d0]); const u32x4 kw = *(const u32x4*)(Kp + d0 * 16);
#pragma unroll
            for (int e = 0; e < 4; ++e) { const float qa = bf_lo(qw[e]), qb_ = bf_hi(qw[e]), ka = bf_lo(kw[e]), kb = bf_hi(kw[e]);
                qq = fmaf(qa, qa, qq); qq = fmaf(qb_, qb_, qq); dot = fmaf(qa, ka, dot); dot = fmaf(qb_, kb, dot); } }
        qq += __shfl_xor(qq, 32); dot += __shfl_xor(dot, 32);
        m = dot;
        float am = sqrtf(qq) * (c ? kn1 : kn0) * 1.001f + 0.01f, bm = dot;
        mub = am;
        float sp = am - dot;
#pragma unroll
        for (int o = 1; o < 32; o <<= 1) { am = fmaxf(am, __shfl_xor(am, o)); bm = fminf(bm, __shfl_xor(bm, o)); sp = fmaxf(sp, __shfl_xor(sp, o)); }
        LAS float* red = (LAS float*)(lds + L_RED);
        if (lane == 0) { red[wid * 4] = am; red[wid * 4 + 1] = bm; red[wid * 4 + 2] = sp; }
    }
    __syncthreads();
    int tlo, thi; bool fast;
    {   LAS float* red = (LAS float*)(lds + L_RED); float am = red[0], bm = red[1], sp = red[2];
#pragma unroll
        for (int w = 1; w < 8; ++w) { am = fmaxf(am, red[4 * w]); bm = fminf(bm, red[4 * w + 1]); sp = fmaxf(sp, red[4 * w + 2]); }
        fast = sp < 100.f;
        const float Wf = (sp + SKIP_T) / slope2 + 1.f; (void)am; (void)bm;
        const int W = (Wf < 1.0e6f) ? (int)Wf : 1000000;
        const int Q0 = qb * 128, NTall = S / 64;
        int lo = Q0 - 63 - W; lo = lo > 0 ? (lo + 63) / 64 : 0;
        int hi_ = (Q0 + 127 + W) / 64; hi_ = hi_ < NTall - 1 ? hi_ : NTall - 1;
        tlo = __builtin_amdgcn_readfirstlane(lo); thi = __builtin_amdgcn_readfirstlane(hi_);
    }
    if (((thi - tlo + 1) & 1) != 0) { if (tlo > 0) --tlo; else ++thi; }
    const int drow = 8 * wid + (lane >> 4);
    const int f0 = ((drow & 3) << 2) | ((drow >> 2) & 3), f1 = (((drow + 4) & 3) << 2) | (((drow + 4) >> 2) & 3);
    const unsigned kg0 = (unsigned)((((size_t)head * M + row0 + drow) * 128 + ((lane & 15) ^ f0) * 8) * 2);
    const unsigned kg1 = (unsigned)((((size_t)head * M + row0 + drow + 4) * 128 + ((lane & 15) ^ f1) * 8) * 2);
    const char* Kc = (const char*)KD; const char* Vc = (const char*)VD;
    const int dmaw = wid * 2048;
#define ATT_DMA(t, st) do { const unsigned off_ = (unsigned)(t) * 16384u; LAS unsigned char* S_ = lds + (st) * TILEB + dmaw; \
        __builtin_amdgcn_global_load_lds((const unsigned*)(Kc + (size_t)(kg0 + off_)), (LAS unsigned*)(S_), 16, 0, 0); \
        __builtin_amdgcn_global_load_lds((const unsigned*)(Kc + (size_t)(kg1 + off_)), (LAS unsigned*)(S_ + 1024), 16, 0, 0); \
        __builtin_amdgcn_global_load_lds((const unsigned*)(Vc + (size_t)(kg0 + off_)), (LAS unsigned*)(S_ + 16384), 16, 0, 0); \
        __builtin_amdgcn_global_load_lds((const unsigned*)(Vc + (size_t)(kg1 + off_)), (LAS unsigned*)(S_ + 16384 + 1024), 16, 0, 0); } while (0)
    ATT_DMA(tlo, 0); ATT_DMA(tlo + 1, 1);
    asm volatile("s_waitcnt vmcnt(0)" ::: "memory");
    __syncthreads();
    float l = 0.f;
    f32x16 o[4];
#pragma unroll
    for (int b = 0; b < 4; ++b)
#pragma unroll
        for (int r = 0; r < 16; ++r) o[b][r] = 0.f;
    const int fk = ((r32 & 3) << 2) | ((r32 >> 2) & 3);
    const int kbase = 256 * r32 + 16 * ((c * 8 + hh) ^ fk);
    const int q4 = (lane & 15) >> 2, pp4 = lane & 3, g1 = (lane >> 4) & 1;
    const int vlow0 = (2 * g1 + (pp4 >> 1)) ^ hh;
    const int vbase0 = 16384 + 256 * (4 * hh + q4) + 64 * q4 + 16 * vlow0 + 8 * (pp4 & 1);
    const int vbase1 = 16384 + 256 * (4 * hh + q4 + 8) + 64 * q4 + 16 * (vlow0 ^ 2) + 8 * (pp4 & 1);
    f32x2 l2 = (f32x2){0.f, 0.f};
#define ATT_CINIT(P0, P1, T) do { const int krel_ = (T) * 64 - q0; const float dbase_ = (float)(krel_ + 4 * hh - r32); \
        if (krel_ + 63 <= 0 || krel_ >= 31) { const float sg_ = (krel_ + 63 <= 0) ? slope2 : -slope2; const float base_ = fmaf(sg_, dbase_, -m); \
            _Pragma("unroll") for (int r = 0; r < 16; ++r) { const float cr = (float)((r & 3) + 8 * (r >> 2)); P0[r] = fmaf(sg_, cr, base_); P1[r] = fmaf(sg_, cr + 32.f, base_); } } \
        else { _Pragma("unroll") for (int r = 0; r < 16; ++r) { const float cr = (float)((r & 3) + 8 * (r >> 2)); P0[r] = fmaf(fabsf(dbase_ + cr), -slope2, -m); P1[r] = fmaf(fabsf(dbase_ + cr + 32.f), -slope2, -m); } } } while (0)
#define ATT_SB() __builtin_amdgcn_sched_barrier(0)
#define ATT_EXPPACK(P, S8, W) do { float e0 = __builtin_amdgcn_exp2f(P[S8 + 0]), e1 = __builtin_amdgcn_exp2f(P[S8 + 1]), e2 = __builtin_amdgcn_exp2f(P[S8 + 2]), e3 = __builtin_amdgcn_exp2f(P[S8 + 3]), \
        e4 = __builtin_amdgcn_exp2f(P[S8 + 4]), e5 = __builtin_amdgcn_exp2f(P[S8 + 5]), e6 = __builtin_amdgcn_exp2f(P[S8 + 6]), e7 = __builtin_amdgcn_exp2f(P[S8 + 7]); \
        l += ((e0 + e1) + (e2 + e3)) + ((e4 + e5) + (e6 + e7)); \
        u32x4 w_; w_.x = cvt_pk_bf16(e0, e1); w_.y = cvt_pk_bf16(e2, e3); w_.z = cvt_pk_bf16(e4, e5); w_.w = cvt_pk_bf16(e6, e7); W = __builtin_bit_cast(bf16x8, w_); } while (0)
#define ATT_VRD(S, L, H) do { _Pragma("unroll") for (int db = 0; db < 4; ++db) { \
        asm volatile("ds_read_b64_tr_b16 %0, %1 offset:%c2" : "=&v"(L[db]) : "v"(va0[db]), "i"(4096 * (S)) : "memory"); \
        asm volatile("ds_read_b64_tr_b16 %0, %1 offset:%c2" : "=&v"(H[db]) : "v"(va1[db]), "i"(4096 * (S)) : "memory"); } } while (0)
#define ATT_WAITV(L, H) asm volatile("s_waitcnt lgkmcnt(0)" : "+v"(L[0]), "+v"(L[1]), "+v"(L[2]), "+v"(L[3]), "+v"(H[0]), "+v"(H[1]), "+v"(H[2]), "+v"(H[3]) : : "memory")
#define ATT_PVM(L, H, PF) do { _Pragma("unroll") for (int db = 0; db < 4; ++db) \
        o[db] = __builtin_amdgcn_mfma_f32_32x32x16_bf16(__builtin_bit_cast(bf16x8, (u32x4){L[db].x, L[db].y, H[db].x, H[db].y}), PF, o[db], 0, 0, 0); } while (0)
#define ATT_TILE(Bt, T) do { \
        f32x16 p0, p1; ATT_CINIT(p0, p1, T); \
        unsigned va0[4], va1[4]; { const unsigned tb_ = (unsigned)(uintptr_t)(Bt); \
            _Pragma("unroll") for (int db = 0; db < 4; ++db) { va0[db] = tb_ + (unsigned)(vbase0 ^ (64 * db)); va1[db] = tb_ + (unsigned)(vbase1 ^ (64 * db)); } } \
        bf16x8 kf[8]; \
        _Pragma("unroll") for (int d0 = 0; d0 < 4; ++d0) { kf[2 * d0] = *(LAS bf16x8*)(Bt + (kbase ^ (32 * d0))); kf[2 * d0 + 1] = *(LAS bf16x8*)(Bt + 8192 + (kbase ^ (32 * d0))); } \
        ATT_SB(); \
        _Pragma("unroll") for (int d0 = 0; d0 < 4; ++d0) { p0 = __builtin_amdgcn_mfma_f32_32x32x16_bf16(kf[2 * d0], qr[d0], p0, 0, 0, 0); p1 = __builtin_amdgcn_mfma_f32_32x32x16_bf16(kf[2 * d0 + 1], qr[d0], p1, 0, 0, 0); } \
        u32x2 vl[4], vh[4], wl[4], wh[4]; \
        ATT_VRD(0, vl, vh); \
        ATT_SB(); \
        float mt = fmaxf(p0[0], p1[0]); \
        _Pragma("unroll") for (int r = 1; r < 16; ++r) mt = fmaxf(mt, fmaxf(p0[r], p1[r])); \
        mt = fmaxf(mt, __shfl_xor(mt, 32)); \
        if (__any(mt > 0.f)) { \
            const float dl = fmaxf(mt, 0.f), alpha = __builtin_amdgcn_exp2f(-dl); \
            m += dl; l *= alpha; \
            _Pragma("unroll") for (int r = 0; r < 16; ++r) { p0[r] -= dl; p1[r] -= dl; } \
            _Pragma("unroll") for (int b = 0; b < 4; ++b) _Pragma("unroll") for (int r = 0; r < 16; ++r) o[b][r] *= alpha; \
        } \
        bf16x8 f0, f1, f2, f3; \
        ATT_EXPPACK(p0, 0, f0); ATT_EXPPACK(p0, 8, f1); ATT_EXPPACK(p1, 0, f2); ATT_EXPPACK(p1, 8, f3); \
        ATT_SB(); \
        ATT_WAITV(vl, vh); ATT_VRD(1, wl, wh); ATT_SB(); ATT_PVM(vl, vh, f0); ATT_SB(); \
        ATT_WAITV(wl, wh); ATT_VRD(2, vl, vh); ATT_SB(); ATT_PVM(wl, wh, f1); ATT_SB(); \
        ATT_WAITV(vl, vh); ATT_VRD(3, wl, wh); ATT_SB(); ATT_PVM(vl, vh, f2); ATT_SB(); \
        ATT_WAITV(wl, wh); ATT_SB(); ATT_PVM(wl, wh, f3); ATT_SB(); \
    } while (0)
#define ATT_TILE_FAST(Bt, T) do { \
        f32x16 p0, p1; \
        { const int krel_ = (T) * 64 - q0; const float dbase_ = (float)(krel_ + 4 * hh - r32); \
          if (krel_ + 63 <= 0 || krel_ >= 31) { const float sg_ = (krel_ + 63 <= 0) ? slope2 : -slope2; const float b0_ = fmaf(sg_, dbase_, -mub), b1_ = fmaf(sg_, 32.f, b0_); \
              _Pragma("unroll") for (int r = 0; r < 16; ++r) { const float cr = (float)((r & 3) + 8 * (r >> 2)); p0[r] = fmaf(sg_, cr, b0_); p1[r] = fmaf(sg_, cr, b1_); } } \
          else { _Pragma("unroll") for (int r = 0; r < 16; ++r) { const float cr = (float)((r & 3) + 8 * (r >> 2)); p0[r] = fmaf(fabsf(dbase_ + cr), -slope2, -mub); p1[r] = fmaf(fabsf(dbase_ + cr + 32.f), -slope2, -mub); } } } \
        unsigned va0[4], va1[4]; { const unsigned tb_ = (unsigned)(uintptr_t)(Bt); \
            _Pragma("unroll") for (int db = 0; db < 4; ++db) { va0[db] = tb_ + (unsigned)(vbase0 ^ (64 * db)); va1[db] = tb_ + (unsigned)(vbase1 ^ (64 * db)); } } \
        bf16x8 kf[8]; \
        _Pragma("unroll") for (int d0 = 0; d0 < 4; ++d0) { kf[2 * d0] = *(LAS bf16x8*)(Bt + (kbase ^ (32 * d0))); kf[2 * d0 + 1] = *(LAS bf16x8*)(Bt + 8192 + (kbase ^ (32 * d0))); } \
        ATT_SB(); \
        _Pragma("unroll") for (int d0 = 0; d0 < 4; ++d0) { p0 = __builtin_amdgcn_mfma_f32_32x32x16_bf16(kf[2 * d0], qr[d0], p0, 0, 0, 0); p1 = __builtin_amdgcn_mfma_f32_32x32x16_bf16(kf[2 * d0 + 1], qr[d0], p1, 0, 0, 0); } \
        u32x2 vl[4], vh[4], wl[4], wh[4]; \
        ATT_VRD(0, vl, vh); \
        ATT_SB(); \
        bf16x8 f0, f1, f2, f3; \
        ATT_EXPPACK2(p0, 0, f0); ATT_EXPPACK2(p0, 8, f1); ATT_EXPPACK2(p1, 0, f2); ATT_EXPPACK2(p1, 8, f3); \
        ATT_SB(); \
        ATT_WAITV(vl, vh); ATT_VRD(1, wl, wh); ATT_SB(); ATT_PVM(vl, vh, f0); ATT_SB(); \
        ATT_WAITV(wl, wh); ATT_VRD(2, vl, vh); ATT_SB(); ATT_PVM(wl, wh, f1); ATT_SB(); \
        ATT_WAITV(vl, vh); ATT_VRD(3, wl, wh); ATT_SB(); ATT_PVM(vl, vh, f2); ATT_SB(); \
        ATT_WAITV(wl, wh); ATT_SB(); ATT_PVM(wl, wh, f3); ATT_SB(); \
    } while (0)
#define ATT_EXPPACK2(P, S8, W) do { f32x2 ea_ = (f32x2){__builtin_amdgcn_exp2f(P[S8 + 0]), __builtin_amdgcn_exp2f(P[S8 + 1])}, eb_ = (f32x2){__builtin_amdgcn_exp2f(P[S8 + 2]), __builtin_amdgcn_exp2f(P[S8 + 3])}, \
        ec_ = (f32x2){__builtin_amdgcn_exp2f(P[S8 + 4]), __builtin_amdgcn_exp2f(P[S8 + 5])}, ed_ = (f32x2){__builtin_amdgcn_exp2f(P[S8 + 6]), __builtin_amdgcn_exp2f(P[S8 + 7])}; \
        l2 += (ea_ + eb_) + (ec_ + ed_); \
        u32x4 w_; w_.x = cvt_pk_bf16(ea_.x, ea_.y); w_.y = cvt_pk_bf16(eb_.x, eb_.y); w_.z = cvt_pk_bf16(ec_.x, ec_.y); w_.w = cvt_pk_bf16(ed_.x, ed_.y); W = __builtin_bit_cast(bf16x8, w_); } while (0)
#define ATT_CINITH(P, T, H) do { const int krel_ = (T) * 64 - q0; const float dbase_ = (float)(krel_ + 4 * hh - r32 + 32 * (H)); \
          if (krel_ + 63 <= 0 || krel_ >= 31) { const float sg_ = (krel_ + 63 <= 0) ? slope2 : -slope2; const float b0_ = fmaf(sg_, dbase_, -mref); \
              _Pragma("unroll") for (int r = 0; r < 16; ++r) { const float cr = (float)((r & 3) + 8 * (r >> 2)); P[r] = fmaf(sg_, cr, b0_); } } \
          else { _Pragma("unroll") for (int r = 0; r < 16; ++r) { const float cr = (float)((r & 3) + 8 * (r >> 2)); P[r] = fmaf(fabsf(dbase_ + cr), -slope2, -mref); } } } while (0)
#define ATT_SGB(mask, n) __builtin_amdgcn_sched_group_barrier(mask, n, 0)
#define ATT_KLD(Bt, H) do { _Pragma("unroll") for (int d0 = 0; d0 < 4; ++d0) kf[d0] = *(LAS bf16x8*)(Bt + 8192 * (H) + (kbase ^ (32 * d0))); } while (0)
#define ATT_QK(P) do { _Pragma("unroll") for (int d0 = 0; d0 < 4; ++d0) P = __builtin_amdgcn_mfma_f32_32x32x16_bf16(kf[d0], qr[d0], P, 0, 0, 0); } while (0)
#define ATT_VADDR(Bt) do { const unsigned tb_ = (unsigned)(uintptr_t)(Bt); \
            _Pragma("unroll") for (int db = 0; db < 4; ++db) { va0[db] = tb_ + (unsigned)(vbase0 ^ (64 * db)); va1[db] = tb_ + (unsigned)(vbase1 ^ (64 * db)); } } while (0)
#define ATT_PAIR_FAST(BtA, BtB, T) do { \
        f32x16 a0, a1, b0, b1; bf16x8 kf[4]; unsigned va0[4], va1[4]; u32x2 vl[4], vh[4], wl[4], wh[4]; \
        bf16x8 fa0, fa1, fa2, fa3, fb0, fb1, fb2, fb3; \
        ATT_CINITH(a0, T, 0); ATT_CINITH(a1, T, 1); ATT_VADDR(BtA); \
        ATT_KLD(BtA, 0); ATT_SB(); ATT_QK(a0); ATT_VRD(0, vl, vh); ATT_KLD(BtA, 1); ATT_SB(); \
        ATT_QK(a1); ATT_EXPPACK2(a0, 0, fa0); ATT_EXPPACK2(a0, 8, fa1); \
        _Pragma("unroll") for (int i_ = 0; i_ < 4; ++i_) { ATT_SGB(0x8, 1); ATT_SGB(0x2, 7); } ATT_SB(); \
        ATT_CINITH(b0, (T) + 1, 0); ATT_WAITV(vl, vh); ATT_VRD(1, wl, wh); ATT_KLD(BtB, 0); ATT_SB(); \
        ATT_PVM(vl, vh, fa0); ATT_QK(b0); ATT_EXPPACK2(a1, 0, fa2); ATT_EXPPACK2(a1, 8, fa3); \
        _Pragma("unroll") for (int i_ = 0; i_ < 8; ++i_) { ATT_SGB(0x8, 1); ATT_SGB(0x2, 4); } ATT_SB(); \
        ATT_CINITH(b1, (T) + 1, 1); ATT_WAITV(wl, wh); ATT_VRD(2, vl, vh); ATT_KLD(BtB, 1); ATT_SB(); \
        ATT_PVM(wl, wh, fa1); ATT_QK(b1); ATT_EXPPACK2(b0, 0, fb0); ATT_EXPPACK2(b0, 8, fb1); \
        _Pragma("unroll") for (int i_ = 0; i_ < 8; ++i_) { ATT_SGB(0x8, 1); ATT_SGB(0x2, 4); } ATT_SB(); \
        ATT_WAITV(vl, vh); ATT_VRD(3, wl, wh); ATT_SB(); \
        ATT_PVM(vl, vh, fa2); ATT_EXPPACK2(b1, 0, fb2); \
        _Pragma("unroll") for (int i_ = 0; i_ < 4; ++i_) { ATT_SGB(0x8, 1); ATT_SGB(0x2, 4); } ATT_SB(); \
        ATT_WAITV(wl, wh); ATT_VRD(8, vl, vh); ATT_SB(); \
        ATT_PVM(wl, wh, fa3); ATT_EXPPACK2(b1, 8, fb3); \
        _Pragma("unroll") for (int i_ = 0; i_ < 4; ++i_) { ATT_SGB(0x8, 1); ATT_SGB(0x2, 4); } ATT_SB(); \
        ATT_WAITV(vl, vh); ATT_VRD(9, wl, wh); ATT_SB(); ATT_PVM(vl, vh, fb0); ATT_SB(); \
        ATT_WAITV(wl, wh); ATT_VRD(10, vl, vh); ATT_SB(); ATT_PVM(wl, wh, fb1); ATT_SB(); \
        ATT_WAITV(vl, vh); ATT_VRD(11, wl, wh); ATT_SB(); ATT_PVM(vl, vh, fb2); ATT_SB(); \
        ATT_WAITV(wl, wh); ATT_SB(); ATT_PVM(wl, wh, fb3); ATT_SB(); \
    } while (0)
    if (fast) {
    for (int t = tlo; t <= thi; t += 2) {
        const int pbuf = ((t - tlo) >> 1) & 1;
        if (t + 2 <= thi) { ATT_DMA(t + 2, 2 * (pbuf ^ 1)); ATT_DMA(t + 3, 2 * (pbuf ^ 1) + 1); }
        LAS unsigned char* BA = lds + (2 * pbuf) * TILEB;
        LAS unsigned char* BB = BA + TILEB;
#ifndef ATT_DUP
#define ATT_DUP 1
#endif
        _Pragma("nounroll") for (int dup_ = ATT_DUP - 1; dup_ >= 0; --dup_) { const float mref = mub + (dup_ ? 1000.f : 0.f); ATT_PAIR_FAST(BA, BB, t); }
        asm volatile("s_waitcnt vmcnt(0)" ::: "memory");
        __syncthreads();
    }
    } else {
    for (int t = tlo; t <= thi; t += 2) {
        const int pbuf = ((t - tlo) >> 1) & 1;
        if (t + 2 <= thi) { ATT_DMA(t + 2, 2 * (pbuf ^ 1)); ATT_DMA(t + 3, 2 * (pbuf ^ 1) + 1); }
        LAS unsigned char* BA = lds + (2 * pbuf) * TILEB;
        LAS unsigned char* BB = BA + TILEB;
        ATT_TILE(BA, t); ATT_TILE(BB, t + 1);
        asm volatile("s_waitcnt vmcnt(0)" ::: "memory");
        __syncthreads();
    }
    }
#undef ATT_DMA
#undef ATT_CINIT
#undef ATT_EXPPACK
#undef ATT_VRD
#undef ATT_WAITV
#undef ATT_PVM
#undef ATT_TILE
#undef ATT_TILE_FAST
#undef ATT_PAIR_FAST
#undef ATT_CINITH
#undef ATT_KLD
#undef ATT_QK
#undef ATT_VADDR
#undef ATT_SGB
#undef ATT_EXPPACK2
#undef ATT_SB
    int ln2 = tid_of(wave_u) & 63;
    const int r32e = ln2 & 31, hhe = ln2 >> 5;
    if (fast) l = l2.x + l2.y;
    l += __shfl_xor(l, 32);
    const float rl = 1.f / l;
    LAS float* X = (LAS float*)lds;
    if (c == 1) {
        const float f = rl * lam;
#pragma unroll
        for (int b = 0; b < 4; ++b)
#pragma unroll
            for (int r = 0; r < 16; ++r) X[(qs * 32 + r32e) * XS + 32 * b + crow(r, hhe)] = o[b][r] * f;
    }
    __syncthreads();
    if (c == 0) {
        float ss = 0.f;
#pragma unroll
        for (int b = 0; b < 4; ++b)
#pragma unroll
            for (int r = 0; r < 16; ++r) { const float v = o[b][r] * rl - X[(qs * 32 + r32e) * XS + 32 * b + crow(r, hhe)]; o[b][r] = v; ss += v * v; }
        ss += __shfl_xor(ss, 32);
        const float rn = (1.f - LAM_INIT) / sqrtf(ss * (1.f / 128.f) + 1e-5f);
        bf16* orow = MIX + (size_t)(row0 + q0 + r32e) * D + head * 128;
#pragma unroll
        for (int b = 0; b < 4; ++b)
#pragma unroll
            for (int rg = 0; rg < 4; ++rg) { const int d = 32 * b + 8 * rg + 4 * hhe; const f32x4 g4 = *(const f32x4*)(dng + d);
                u32x2 w; w.x = cvt_pk_bf16(o[b][4 * rg + 0] * rn * g4.x, o[b][4 * rg + 1] * rn * g4.y); w.y = cvt_pk_bf16(o[b][4 * rg + 2] * rn * g4.z, o[b][4 * rg + 3] * rn * g4.w);
                *(u32x2*)(orow + d) = w; }
    }
    __syncthreads();
}

__device__ __forceinline__ void attn_phase(const Params& p, const bf16* Hb, const bf16* KD, const bf16* VD, bf16* MIX, unsigned* ctl, LAS unsigned char* lds, int bid, int G, int wave_u) {
    float s1 = 0.f, s2 = 0.f;
    for (int i = 0; i < 64; ++i) { s1 += p.in[4][i] * p.in[5][i]; s2 += p.in[6][i] * p.in[7][i]; }
    const float lam = expf(s1) - expf(s2) + LAM_INIT;
    LAS int* slot = (LAS int*)(lds + L_CTL);
    const int myx = (int)(__builtin_amdgcn_s_getreg((3 << 11) | 20) & 7u);
    for (int rep = 0; rep < ATT_REPS; ++rep)
    for (int qi = 0; qi < 8; ++qi) {
      const int x = (myx + qi) & 7;
      for (;;) {
        if (tid_of(wave_u) == 0) *slot = (int)atomicAdd(ctl + CW_UNIT + x + 8 * rep, 1u);
        __syncthreads();
        const int j = __builtin_amdgcn_readfirstlane(*slot);
        __syncthreads();
        if (j >= 256) break;
        const int grp = j >> 5, i = j & 31;
        const bool prompt = (grp == 0) | (grp == 1) | (grp == 4) | (grp == 6);
        const int head = (grp == 0 || grp == 2) ? 3 : (grp == 1 || grp == 3) ? 2 : (grp == 4 || grp == 5) ? 1 : 0;
        int seq, qb, row0, S;
        if (prompt) { seq = x & 1; qb = i * 4 + (x >> 1); row0 = seq * S_P; S = S_P; }
        else { seq = 2 + x; qb = i; row0 = NPR + x * S_S; S = S_S; }
        const float kn0 = __uint_as_float(__hip_atomic_load(ctl + CW_KN + seq * 8 + head * 2, __ATOMIC_RELAXED, __HIP_MEMORY_SCOPE_AGENT));
        const float kn1 = __uint_as_float(__hip_atomic_load(ctl + CW_KN + seq * 8 + head * 2 + 1, __ATOMIC_RELAXED, __HIP_MEMORY_SCOPE_AGENT));
        attn_unit(Hb, KD, VD, MIX, row0, S, head, qb, lam, p.in[8], kn0, kn1, lds, wave_u);
      }
    }
}
}
namespace gla {
using att::crow; using att::vtr; using att::VSTR;
constexpr int L_LR = 0, L_B = 4096, L_TOT = 20480, L_BT = 22528, L_QT = 23040, L_KT = 32256, L_V = 41472, L_Z = 82432;
constexpr int L_V2 = 116224, L_LR2 = 136704;
constexpr int QSTR = 144, ZS = 132, SEGC = 16;
constexpr float LOG2E = 1.4426950408889634f, LN2 = 0.6931471805599453f;
__device__ __forceinline__ float bf2f(unsigned h) { return __uint_as_float(h << 16); }
__device__ __forceinline__ float fexp(float x) { return __builtin_amdgcn_exp2f(x * LOG2E); }

struct ChunkRegs { u32x4 v0, v1, q, k, lr; };
template <bool NEEDQ> __device__ __forceinline__ void chunk_load(ChunkRegs& R, const bf16* Hb, int rowbase, int head, int dir, int tid) {
    const int srow = tid >> 4, sch = tid & 15;
    const bf16* Vg = Hb + (size_t)(rowbase + srow) * LDH + O_GV + head * 128 + sch * 8;
    R.v0 = *(const u32x4*)Vg; R.v1 = *(const u32x4*)(Vg + (size_t)32 * LDH);
    const int pr = tid >> 3, dk0 = (tid & 7) * 8;
    R.k = *(const u32x4*)(Hb + (size_t)(rowbase + pr) * LDH + O_GK + head * 64 + dk0);
    if (NEEDQ) R.q = *(const u32x4*)(Hb + (size_t)(rowbase + pr) * LDH + O_GQ + head * 64 + dk0);
    if (tid < 128) R.lr = *(const u32x4*)(Hb + (size_t)(rowbase + (tid >> 1)) * LDH + O_LRF + dir * 16 + (tid & 1) * 8);
}
__device__ __forceinline__ void stage_vlr(const ChunkRegs& R, int buf, LAS unsigned char* lds, int tid) {
    LAS float* LR = (LAS float*)(lds + (buf ? L_LR2 : L_LR));
    { const int srow = tid >> 4, sch = tid & 15; LAS unsigned char* V = lds + (buf ? L_V2 : L_V);
      *(LAS u32x4*)(V + srow * VSTR + sch * 16) = R.v0; *(LAS u32x4*)(V + (srow + 32) * VSTR + sch * 16) = R.v1; }
    if (tid < 128) { const int tok = tid >> 1, hf = tid & 1;
#pragma unroll
        for (int i = 0; i < 4; ++i) { const unsigned ww = R.lr[i]; LR[tok * 16 + hf * 8 + 2 * i] = bf2f(ww & 0xffffu); LR[tok * 16 + hf * 8 + 2 * i + 1] = bf2f(ww >> 16); } }
}
template <bool NEEDQ> __device__ __forceinline__ float chunk_front(const ChunkRegs& C, const ChunkRegs& N, bool stage_next, int cur, int dir, const bf16x8& bhi, const bf16x8& blo, float biasd, LAS unsigned char* lds, int tid) {
    LAS float* LR = (LAS float*)(lds + (cur ? L_LR2 : L_LR)); LAS float* Bm = (LAS float*)(lds + L_B); LAS float* TOT = (LAS float*)(lds + L_TOT); LAS float* BT = (LAS float*)(lds + L_BT);
    const int d = tid & 63, grp = tid >> 6;
    if (grp < 4) { const int ln = tid & 63, r32_ = ln & 31, hh_ = ln >> 5, pblk = grp >> 1, dblk = grp & 1;
        const f32x4 a0 = *(const LAS f32x4*)(LR + (32 * pblk + r32_) * 16 + 8 * hh_), a1 = *(const LAS f32x4*)(LR + (32 * pblk + r32_) * 16 + 8 * hh_ + 4);
        u32x4 aw; aw.x = att::cvtpk_n(a0.x, a0.y); aw.y = att::cvtpk_n(a0.z, a0.w); aw.z = att::cvtpk_n(a1.x, a1.y); aw.w = att::cvtpk_n(a1.z, a1.w);
        f32x16 zc;
#pragma unroll
        for (int r = 0; r < 16; ++r) zc[r] = biasd;
        zc = __builtin_amdgcn_mfma_f32_32x32x16_bf16(__builtin_bit_cast(bf16x8, aw), bhi, zc, 0, 0, 0);
        zc = __builtin_amdgcn_mfma_f32_32x32x16_bf16(__builtin_bit_cast(bf16x8, aw), blo, zc, 0, 0, 0);
#pragma unroll
        for (int r = 0; r < 16; ++r) Bm[(32 * pblk + crow(r, hh_)) * 64 + 32 * dblk + r32_] = zc[r]; }
    __syncthreads();
    float la[8];
#pragma unroll
    for (int i = 0; i < 8; ++i) { const int p = grp * 8 + i; const float z = Bm[p * 64 + d];
        const float t = __builtin_amdgcn_exp2f(-fabsf(z) * LOG2E);
        la[i] = (fminf(z, 0.f) * LOG2E - __builtin_amdgcn_logf(1.f + t)) * (1.f / 16.f); }
    if (dir == 0) {
#pragma unroll
        for (int i = 1; i < 8; ++i) la[i] += la[i - 1];
        TOT[grp * 64 + d] = la[7];
    } else {
#pragma unroll
        for (int i = 6; i >= 0; --i) la[i] += la[i + 1];
        TOT[grp * 64 + d] = la[0];
    }
    __syncthreads();
    float pre = 0.f, tot = 0.f;
#pragma unroll
    for (int g = 0; g < 8; ++g) { const float tv = TOT[g * 64 + d]; tot += tv; if (dir == 0 ? (g < grp) : (g > grp)) pre += tv; }
#pragma unroll
    for (int i = 0; i < 8; ++i) Bm[(grp * 8 + i) * 64 + d] = la[i] + pre;
    if (grp == 0) BT[d] = __builtin_amdgcn_exp2f(tot);
    __syncthreads();
    { const int pr = tid >> 3, dk0 = (tid & 7) * 8;
      float qt[8], kt[8];
#pragma unroll
      for (int i = 0; i < 8; ++i) { const unsigned wk = C.k[i >> 1]; const float bb = Bm[pr * 64 + dk0 + i];
          kt[i] = bf2f((i & 1) ? (wk >> 16) : (wk & 0xffffu)) * __builtin_amdgcn_exp2f(-bb);
          if (NEEDQ) { const unsigned wq = C.q[i >> 1]; qt[i] = bf2f((i & 1) ? (wq >> 16) : (wq & 0xffffu)) * __builtin_amdgcn_exp2f(bb); } }
      u32x4 wk4; wk4.x = cvt_pk_bf16(kt[0], kt[1]); wk4.y = cvt_pk_bf16(kt[2], kt[3]); wk4.z = cvt_pk_bf16(kt[4], kt[5]); wk4.w = cvt_pk_bf16(kt[6], kt[7]);
      *(LAS u32x4*)(lds + L_KT + pr * QSTR + dk0 * 2) = wk4;
      if (NEEDQ) { u32x4 wq4; wq4.x = cvt_pk_bf16(qt[0], qt[1]); wq4.y = cvt_pk_bf16(qt[2], qt[3]); wq4.z = cvt_pk_bf16(qt[4], qt[5]); wq4.w = cvt_pk_bf16(qt[6], qt[7]);
          *(LAS u32x4*)(lds + L_QT + pr * QSTR + dk0 * 2) = wq4; } }
    if (stage_next) stage_vlr(N, cur ^ 1, lds, tid);
    __syncthreads();
    return tot;
}
__device__ __forceinline__ void state_update(f32x16& S, int mb, int nb, int LV, LAS unsigned char* lds, int hh, int q4, int pp4, int g1) {
#pragma unroll
    for (int s = 0; s < 4; ++s) {
        LAS unsigned char* kb = lds + L_KT + (16 * s + 8 * hh + q4) * QSTR + (32 * mb + 16 * g1 + 4 * pp4) * 2;
        LAS unsigned char* vb = lds + LV + (16 * s + 8 * hh + q4) * VSTR + (32 * nb + 16 * g1 + 4 * pp4) * 2;
        const s16x4 alo = vtr(kb), ahi = vtr(kb + 4 * QSTR), blo = vtr(vb), bhi = vtr(vb + 4 * VSTR);
        S = __builtin_amdgcn_mfma_f32_32x32x16_bf16((bf16x8){alo[0], alo[1], alo[2], alo[3], ahi[0], ahi[1], ahi[2], ahi[3]},
                                                    (bf16x8){blo[0], blo[1], blo[2], blo[3], bhi[0], bhi[1], bhi[2], bhi[3]}, S, 0, 0, 0);
    }
    LAS float* BT = (LAS float*)(lds + L_BT);
#pragma unroll
    for (int r = 0; r < 16; ++r) S[r] *= BT[32 * mb + crow(r, hh)];
}
__device__ __forceinline__ void load_gate_b(bf16x8& bhi, bf16x8& blo, float& biasd, const Params& p, int head, int dir, int tid) {
    const float* wa2 = dir ? p.in[11] : p.in[9]; const float* ba = dir ? p.in[12] : p.in[10];
    const int ln = tid & 63, r32_ = ln & 31, hh_ = ln >> 5, dblk = (tid >> 6) & 1, dcol = head * 64 + 32 * dblk + r32_;
    float wv[8], hf[8];
#pragma unroll
    for (int j = 0; j < 8; ++j) { wv[j] = wa2[(8 * hh_ + j) * 256 + dcol]; hf[j] = __uint_as_float(att::cvtpk_n(wv[j], 0.f) << 16); }
    u32x4 h4, l4;
    h4.x = att::cvtpk_n(hf[0], hf[1]); h4.y = att::cvtpk_n(hf[2], hf[3]); h4.z = att::cvtpk_n(hf[4], hf[5]); h4.w = att::cvtpk_n(hf[6], hf[7]);
    l4.x = att::cvtpk_n(wv[0] - hf[0], wv[1] - hf[1]); l4.y = att::cvtpk_n(wv[2] - hf[2], wv[3] - hf[3]); l4.z = att::cvtpk_n(wv[4] - hf[4], wv[5] - hf[5]); l4.w = att::cvtpk_n(wv[6] - hf[6], wv[7] - hf[7]);
    bhi = __builtin_bit_cast(bf16x8, h4); blo = __builtin_bit_cast(bf16x8, l4); biasd = ba[dcol];
}

__device__ __forceinline__ void passA(const Params& p, const bf16* Hb, float* SEG, float* LG, LAS unsigned char* lds, int bid, int G, int wave_u) {
    const int tid_l = tid_of(wave_u);
    const int tid = tid_l, lane = tid & 63, wid = __builtin_amdgcn_readfirstlane(tid >> 6), r32 = lane & 31, hh = lane >> 5;
    const int mb = wid >> 2, nb = wid & 3, q4 = (lane & 15) >> 2, pp4 = lane & 3, g1 = (lane >> 4) & 1;
    for (int si = bid; si < 512; si += G) {
        const int dir = si & 1, head = (si >> 1) & 3, sg = si >> 3;
        bf16x8 bhi, blo; float biasd; load_gate_b(bhi, blo, biasd, p, head, dir, tid);
        f32x16 S;
#pragma unroll
        for (int r = 0; r < 16; ++r) S[r] = 0.f;
        float lg = 0.f;
        ChunkRegs R;
        chunk_load<false>(R, Hb, (sg * SEGC + (dir ? SEGC - 1 : 0)) * 64, head, dir, tid);
        __syncthreads();
        stage_vlr(R, 0, lds, tid);
        __syncthreads();
        for (int n = 0; n < SEGC; ++n) {
            const ChunkRegs C = R; const int cur = n & 1;
            if (n + 1 < SEGC) chunk_load<false>(R, Hb, (sg * SEGC + (dir ? SEGC - 2 - n : n + 1)) * 64, head, dir, tid);
            lg += chunk_front<false>(C, R, n + 1 < SEGC, cur, dir, bhi, blo, biasd, lds, tid);
            state_update(S, mb, nb, cur ? L_V2 : L_V, lds, hh, q4, pp4, g1);
        }
        float* Up = SEG + (size_t)si * 8192;
#pragma unroll
        for (int r = 0; r < 16; ++r) Up[(32 * mb + crow(r, hh)) * 128 + 32 * nb + r32] = S[r];
        if (tid < 64) LG[si * 64 + tid] = lg;
    }
}
__device__ __forceinline__ void passB(float* SEG, const float* LG, int bid, int G, int wave_u) {
    const int tid_l = tid_of(wave_u);
    const int gt = bid * NTHREADS + tid_l, NTH = G * NTHREADS;
    for (int v = gt; v < 80 * 2048; v += NTH) {
        const int chain = v >> 11, e4 = v & 2047, dir = chain & 1, head = (chain >> 1) & 3, seq = chain >> 3;
        const int sg0 = seq < 2 ? seq * 16 : 32 + (seq - 2) * 4, ns = seq < 2 ? 16 : 4;
        f32x4 S = (f32x4){0.f, 0.f, 0.f, 0.f};
        for (int n = 0; n < ns; ++n) { const int si = ((sg0 + (dir ? ns - 1 - n : n)) * 4 + head) * 2 + dir;
            float* ptr = SEG + (size_t)si * 8192 + e4 * 4; const f32x4 u = *(const f32x4*)ptr; const float g = __builtin_amdgcn_exp2f(LG[si * 64 + (e4 >> 5)]);
            *(f32x4*)ptr = S; S = S * g + u; }
    }
}
__device__ __forceinline__ void passC(const Params& p, const bf16* Hb, const float* SEG, float* Z0, bf16* MIX, LAS unsigned char* lds, int bid, int G, int wave_u) {
    const int tid_l = tid_of(wave_u);
    const int tid = tid_l, lane = tid & 63, wid = __builtin_amdgcn_readfirstlane(tid >> 6), r32 = lane & 31, hh = lane >> 5;
    const int pb = wid >> 2, db = wid & 3, q4 = (lane & 15) >> 2, pp4 = lane & 3, g1 = (lane >> 4) & 1;
    for (int item = bid; item < 256; item += G) {
        const int head = item & 3, sg = item >> 2;
        for (int dir = 0; dir < 2; ++dir) {
            bf16x8 bhi, blo; float biasd; load_gate_b(bhi, blo, biasd, p, head, dir, tid);
            f32x16 S0, S1;
            { const float* Sp = SEG + (size_t)((sg * 4 + head) * 2 + dir) * 8192 + 32 * db + r32;
#pragma unroll
              for (int r = 0; r < 16; ++r) { S0[r] = Sp[crow(r, hh) * 128]; S1[r] = Sp[(32 + crow(r, hh)) * 128]; } }
            ChunkRegs R;
            chunk_load<true>(R, Hb, (sg * SEGC + (dir ? SEGC - 1 : 0)) * 64, head, dir, tid);
            __syncthreads();
            stage_vlr(R, 0, lds, tid);
            __syncthreads();
            for (int n = 0; n < SEGC; ++n) {
                const int rowbase = (sg * SEGC + (dir ? SEGC - 1 - n : n)) * 64;
                const ChunkRegs C = R; const int cur = n & 1; const int LV = cur ? L_V2 : L_V;
                if (n + 1 < SEGC) chunk_load<true>(R, Hb, (sg * SEGC + (dir ? SEGC - 2 - n : n + 1)) * 64, head, dir, tid);
                f32x16 Z;
                float* Zg = Z0 + (size_t)(rowbase + 32 * pb) * 512 + head * 128 + 32 * db + r32;
                if (dir == 0) {
#pragma unroll
                    for (int r = 0; r < 16; ++r) Z[r] = 0.f;
                } else {
#pragma unroll
                    for (int r = 0; r < 16; ++r) Z[r] = Zg[(size_t)crow(r, hh) * 512];
                }
                (void)chunk_front<true>(C, R, n + 1 < SEGC, cur, dir, bhi, blo, biasd, lds, tid);
                for (int mbp = 0; mbp < 2; ++mbp) {
                    if (dir == 0 ? (mbp > pb) : (mbp < pb)) continue;
                    f32x16 X;
#pragma unroll
                    for (int r = 0; r < 16; ++r) X[r] = 0.f;
#pragma unroll
                    for (int s = 0; s < 4; ++s) {
                        const bf16x8 a = *(LAS bf16x8*)(lds + L_KT + (32 * mbp + r32) * QSTR + (16 * s + 8 * hh) * 2);
                        const bf16x8 b = *(LAS bf16x8*)(lds + L_QT + (32 * pb + r32) * QSTR + (16 * s + 8 * hh) * 2);
                        X = __builtin_amdgcn_mfma_f32_32x32x16_bf16(a, b, X, 0, 0, 0);
                    }
#pragma unroll
                    for (int r = 0; r < 16; ++r) { const int pk = 32 * mbp + crow(r, hh), pq = 32 * pb + r32; const bool keep = dir == 0 ? (pk <= pq) : (pk >= pq); X[r] = keep ? X[r] : 0.f; }
#pragma unroll
                    for (int s2 = 0; s2 < 2; ++s2) {
                        u32x4 ww; ww.x = cvt_pk_bf16(X[8 * s2 + 0], X[8 * s2 + 1]); ww.y = cvt_pk_bf16(X[8 * s2 + 2], X[8 * s2 + 3]); ww.z = cvt_pk_bf16(X[8 * s2 + 4], X[8 * s2 + 5]); ww.w = cvt_pk_bf16(X[8 * s2 + 6], X[8 * s2 + 7]);
                        LAS unsigned char* vb = lds + LV + (32 * mbp + 16 * s2 + 4 * hh + q4) * VSTR + (32 * db + 16 * g1 + 4 * pp4) * 2;
                        const s16x4 lo = vtr(vb), hi = vtr(vb + 8 * VSTR);
                        Z = __builtin_amdgcn_mfma_f32_32x32x16_bf16(__builtin_bit_cast(bf16x8, ww), (bf16x8){lo[0], lo[1], lo[2], lo[3], hi[0], hi[1], hi[2], hi[3]}, Z, 0, 0, 0);
                    }
                }
#pragma unroll
                for (int mbs = 0; mbs < 2; ++mbs)
#pragma unroll
                    for (int s2 = 0; s2 < 2; ++s2) {
                        u32x4 ww;
                        if (mbs == 0) { ww.x = cvt_pk_bf16(S0[8 * s2 + 0], S0[8 * s2 + 1]); ww.y = cvt_pk_bf16(S0[8 * s2 + 2], S0[8 * s2 + 3]); ww.z = cvt_pk_bf16(S0[8 * s2 + 4], S0[8 * s2 + 5]); ww.w = cvt_pk_bf16(S0[8 * s2 + 6], S0[8 * s2 + 7]); }
                        else { ww.x = cvt_pk_bf16(S1[8 * s2 + 0], S1[8 * s2 + 1]); ww.y = cvt_pk_bf16(S1[8 * s2 + 2], S1[8 * s2 + 3]); ww.z = cvt_pk_bf16(S1[8 * s2 + 4], S1[8 * s2 + 5]); ww.w = cvt_pk_bf16(S1[8 * s2 + 6], S1[8 * s2 + 7]); }
                        LAS unsigned char* qa = lds + L_QT + (32 * pb + r32) * QSTR + (32 * mbs + 16 * s2 + 4 * hh) * 2;
                        const u32x2 alo = *(LAS u32x2*)qa, ahi = *(LAS u32x2*)(qa + 16);
                        const u32x4 aw = (u32x4){alo.x, alo.y, ahi.x, ahi.y};
                        Z = __builtin_amdgcn_mfma_f32_32x32x16_bf16(__builtin_bit_cast(bf16x8, aw), __builtin_bit_cast(bf16x8, ww), Z, 0, 0, 0);
                    }
                state_update(S0, 0, db, LV, lds, hh, q4, pp4, g1);
                state_update(S1, 1, db, LV, lds, hh, q4, pp4, g1);
                if (dir == 0) {
#pragma unroll
                    for (int r = 0; r < 16; ++r) Zg[(size_t)crow(r, hh) * 512] = Z[r];
                } else {
                    LAS float* Zl = (LAS float*)(lds + L_Z);
#pragma unroll
                    for (int r = 0; r < 16; ++r) Zl[(32 * pb + crow(r, hh)) * ZS + 32 * db + r32] = Z[r];
                    __syncthreads();
                    { const int pr = tid >> 3, dv0 = (tid & 7) * 16;
                      float v[16]; float ss = 0.f;
#pragma unroll
                      for (int i = 0; i < 16; ++i) { v[i] = Zl[pr * ZS + dv0 + i]; ss += v[i] * v[i]; }
                      ss += __shfl_xor(ss, 1); ss += __shfl_xor(ss, 2); ss += __shfl_xor(ss, 4);
                      const float rn = __builtin_amdgcn_rsqf(ss * (1.f / 128.f) + 1e-5f);
                      const bf16* grp_ = Hb + (size_t)(rowbase + pr) * LDH + O_GR + head * 128 + dv0;
                      const u32x4 g0 = *(const u32x4*)grp_, g1v = *(const u32x4*)(grp_ + 8);
                      const float* gn = p.in[13] + dv0;
                      float o[16];
#pragma unroll
                      for (int i = 0; i < 16; ++i) { const unsigned wv = (i < 8) ? g0[i >> 1] : g1v[(i - 8) >> 1]; const float gr = bf2f((i & 1) ? (wv >> 16) : (wv & 0xffffu));
                          const float sl = gr * __builtin_amdgcn_rcpf(1.f + fexp(-gr)); o[i] = v[i] * rn * gn[i] * sl; }
                      u32x4 a, b; a.x = cvt_pk_bf16(o[0], o[1]); a.y = cvt_pk_bf16(o[2], o[3]); a.z = cvt_pk_bf16(o[4], o[5]); a.w = cvt_pk_bf16(o[6], o[7]);
                      b.x = cvt_pk_bf16(o[8], o[9]); b.y = cvt_pk_bf16(o[10], o[11]); b.z = cvt_pk_bf16(o[12], o[13]); b.w = cvt_pk_bf16(o[14], o[15]);
                      bf16* orow = MIX + (size_t)(rowbase + pr) * D + 512 + head * 128 + dv0;
                      *(u32x4*)orow = a; *(u32x4*)(orow + 8) = b; }
                }
            }
        }
    }
}
}
__global__ void __launch_bounds__(NTHREADS) mega(Params p) {
    extern __shared__ __attribute__((aligned(16))) unsigned char lds_raw[];
    LAS unsigned char* lds = (LAS unsigned char*)lds_raw;
    cg::grid_group grid = cg::this_grid();
    const int tid = threadIdx.x, lane = tid & 63, wave = __builtin_amdgcn_readfirstlane(tid >> 6);
    const int G = gridDim.x, bid = blockIdx.x;
    unsigned char* ws = p.ws;
    bf16* WTin = (bf16*)(ws + WS_WIN); bf16* WTo = (bf16*)(ws + WS_WO); bf16* WT1 = (bf16*)(ws + WS_W1); bf16* WT2 = (bf16*)(ws + WS_W2);
    bf16* Hb = (bf16*)(ws + WS_H); bf16* XB = (bf16*)(ws + WS_XB); bf16* MIX = (bf16*)(ws + WS_MIX); bf16* X1B = (bf16*)(ws + WS_X1B); bf16* HID = (bf16*)(ws + WS_HID);
    float* ST = (float*)(ws + WS_ST); float* SEG = (float*)(ws + WS_ST + 128 * MiB); float* LG = (float*)(ws + WS_GG);
    unsigned* ctl = (unsigned*)(ws + WS_CTL);
    bf16* Y1B = (bf16*)p.out;
    bf16* Y2B = (bf16*)(ws + WS_MIX);
    bf16* KD = (bf16*)(ws + WS_KD); bf16* VD = (bf16*)(ws + WS_VD);
    const int lo = p.ph_lo, hi = p.ph_hi;
    volatile LAS unsigned* xst = (volatile LAS unsigned*)(lds + 160 * 1024 - 128);
    if (tid < 2) xst[tid] = 0u;
    __syncthreads();
    const XcdBarrier xbar = xcd_barrier_post(ctl + 1024, xst, wave);
    if (hi > 1000) grid.sync();
#ifndef R_P0
#define R_P0 1
#endif
#ifndef R_G1
#define R_G1 1
#endif
#ifndef R_G2
#define R_G2 1
#endif
#define IN(k) (lo <= (k) && (k) < hi)
#define SEAM(k) do { if (IN(k) && IN((k) + 1)) { xcd_barrier(xbar); } } while (0)
    const int gw = bid * NWAVES + wave, NGW = G * NWAVES;

for (int rp_ = 0; rp_ < R_P0; ++rp_) {     if (IN(0)) {
        if (bid == 0 && tid < 256) ctl[tid] = 0u;
        LAS float* scr = (LAS float*)(lds + wave * 16384);
        constexpr int I_IN = (D / 64) * (DIN / 32), I_O = (D / 64) * (D / 32), I_1 = (D / 64) * (FF / 32), I_2 = (FF / 64) * (D / 32);
        constexpr int NITEMS = I_IN + I_O + I_1 + I_2;
        for (int it = gw; it < NITEMS; it += NGW) {
            int r = it;
            if (r < I_IN) { p0_transpose_item(p.in[2], D, DIN, WTin, scr, r, lane); continue; } r -= I_IN;
            if (r < I_O) { p0_transpose_item(p.in[3], D, D, WTo, scr, r, lane); continue; } r -= I_O;
            if (r < I_1) { p0_transpose_item(p.in[16], D, FF, WT1, scr, r, lane); continue; } r -= I_1;
            p0_transpose_item(p.in[17], FF, D, WT2, scr, r, lane);
        }
        { u32x4* z = (u32x4*)(WTin + (size_t)DIN * D); const int nz = (DIN_PAD - DIN) * D * 2 / 16;
          for (int i = bid * NTHREADS + tid; i < nz; i += G * NTHREADS) z[i] = (u32x4){0u, 0u, 0u, 0u}; }
        { const int ln0 = tid_of(wave) & 63;
        for (int m = gw * 2; m < M; m += NGW * 2) {
            f32x4 v[2][4];
#pragma unroll
            for (int r = 0; r < 2; ++r) { const f32x4* xr = (const f32x4*)xrow_ptr(p, m + r) + ln0;
#pragma unroll
                for (int j = 0; j < 4; ++j) v[r][j] = __builtin_nontemporal_load(xr + 64 * j); }
#pragma unroll
            for (int r = 0; r < 2; ++r) { u32x2* o = (u32x2*)(XB + (size_t)(m + r) * D) + ln0;
#pragma unroll
                for (int j = 0; j < 4; ++j) { u32x2 w; w.x = cvt_pk_bf16(v[r][j].x, v[r][j].y); w.y = cvt_pk_bf16(v[r][j].z, v[r][j].w); o[64 * j] = w; } }
        } }
#if MIXER_STAGE < 1
        { u32x4* z = (u32x4*)MIX; const size_t nz = (size_t)M * D * 2 / 16;
          for (size_t i = (size_t)bid * NTHREADS + tid; i < nz; i += (size_t)G * NTHREADS) z[i] = (u32x4){0u, 0u, 0u, 0u}; }
#endif
    } }
    SEAM(0);
for (int rp_ = 0; rp_ < R_G1; ++rp_) {     if (IN(1)) {
#if MIXER_STAGE >= 1
        pg8::Gemm g{XB, WTin, M, DIN_PAD, D}; pg8::StaticOrder S; S.init(M, DIN_PAD, G, bid);
        pg8::EpiH E{Hb, LDH, DIN, C1, KD, VD};
        pg8::gemm_phase<pg8::EpiH, pg8::StaticOrder, true, true>(lds, g, S, E, wave);
#endif
    } }
    SEAM(1);
#ifndef GLA_REPS
#define GLA_REPS 1
#endif
#ifndef ATT_REPS
#define ATT_REPS 1
#endif
    for (int rep = 0; rep < GLA_REPS; ++rep) {
    if (IN(2)) {
#if MIXER_STAGE >= 1
        if (rep == 0) att::knorm_phase(KD, ctl, bid, G, wave);
#endif
#if MIXER_STAGE >= 2
        gla::passA(p, Hb, SEG, LG, lds, bid, G, wave);
#endif
    }
    SEAM(2);
    if (IN(3)) {
#if MIXER_STAGE >= 2
        gla::passB(SEG, LG, bid, G, wave);
#endif
    }
    SEAM(3);
    }
    if (IN(4)) {
#if MIXER_STAGE >= 2
        for (int rep = 0; rep < GLA_REPS; ++rep) gla::passC(p, Hb, SEG, ST, MIX, lds, bid, G, wave);
#endif
#if MIXER_STAGE >= 1
        att::attn_phase(p, Hb, KD, VD, MIX, ctl, lds, bid, G, wave);
#endif
    }
    SEAM(4);
for (int rp_ = 0; rp_ < R_G1; ++rp_) {     if (IN(5)) {
        pg8::Gemm g{MIX, WTo, M, D, D}; pg8::StaticOrder S; S.init(M, D, G, bid);
        pg8::EpiResB E{nullptr, nullptr, XB, Y1B, ALPHA};
        pg8::gemm_phase<pg8::EpiResB, pg8::StaticOrder, true, true>(lds, g, S, E, wave);
    } }
    SEAM(5);
for (int rp_ = 0; rp_ < R_P0; ++rp_) {     if (IN(6)) { const int ln_ = tid_of(wave) & 63; for (int m = gw * 4; m < M; m += NGW * 4) ln_rows4_b(Y1B + (size_t)m * D, nullptr, X1B + (size_t)m * D, p.in[14], p.in[15], ln_); } }
    SEAM(6);
for (int rp_ = 0; rp_ < R_G2; ++rp_) {     if (IN(7)) {
        pg8::Gemm g{X1B, WT1, M, FF, D}; pg8::StaticOrder S; S.init(M, FF, G, bid);
        pg8::EpiHid E{HID, FF};
        pg8::gemm_phase<pg8::EpiHid, pg8::StaticOrder, true, true>(lds, g, S, E, wave);
    } }
    SEAM(7);
for (int rp_ = 0; rp_ < R_G2; ++rp_) {     if (IN(8)) {
        pg8::Gemm g{HID, WT2, M, D, FF}; pg8::StaticOrder S; S.init(M, D, G, bid);
        pg8::EpiResB E{nullptr, nullptr, X1B, Y2B, ALPHA};
        pg8::gemm_phase<pg8::EpiResB, pg8::StaticOrder, true, true>(lds, g, S, E, wave);
    } }
    SEAM(8);
for (int rp_ = 0; rp_ < R_P0; ++rp_) {     if (IN(9)) { const int ln_ = tid_of(wave) & 63; for (int m = gw * 4; m < M; m += NGW * 4) ln_rows4_b(Y2B + (size_t)m * D, p.out + (size_t)m * D, nullptr, p.in[18], p.in[19], ln_); } }
#undef IN
#undef SEAM
}

extern "C" void kernel_launch(void* const* d_in, const int* in_sizes, int n_in, void* d_out, int out_size,
                              void* d_ws, size_t ws_size, hipStream_t stream) {
    static int grid = 0;
    if (grid == 0) {
        if (n_in != 20 || out_size != M * D || ws_size < WS_END) { fprintf(stderr, "kernel_launch: unexpected shapes (n_in %d out %d ws %zu)\n", n_in, out_size, ws_size); grid = -1; return; }
        int dev = 0, cus = 0, per_cu = 0;
        (void)hipGetDevice(&dev);
        (void)hipDeviceGetAttribute(&cus, hipDeviceAttributeMultiprocessorCount, dev);
        (void)hipFuncSetAttribute((const void*)mega, hipFuncAttributeMaxDynamicSharedMemorySize, LDS_BYTES);
        (void)hipOccupancyMaxActiveBlocksPerMultiprocessor(&per_cu, (const void*)mega, NTHREADS, LDS_BYTES);
        (void)hipGetLastError();
        grid = cus;
        fprintf(stderr, "kernel_launch: grid %d (cus %d, occupancy query %d/CU), ws %zu\n", grid, cus, per_cu, ws_size);
    }
    if (grid < 0) return;
    (void)hipMemsetAsync(d_ws, 0, 65536, stream);
    Params p{};
    for (int i = 0; i < 20; ++i) p.in[i] = (const float*)d_in[i];
    p.out = (float*)d_out; p.ws = (unsigned char*)d_ws; p.ph_lo = 0; p.ph_hi = 10;
    void* args[] = {&p};
    hipError_t e = hipLaunchCooperativeKernel((const void*)mega, dim3(grid), dim3(NTHREADS), args, LDS_BYTES, stream);
    if (e != hipSuccess) fprintf(stderr, "cooperative launch failed: %s\n", hipGetErrorString(e));
}
```

```cpp
#include <hip/hip_runtime.h>
#include <hip/hip_cooperative_groups.h>
#include <cstdio>
#include <cstdint>
namespace cg = cooperative_groups;
__device__ __forceinline__ int tid_of(int wave_u) { int t; asm volatile("v_mbcnt_lo_u32_b32 %0, -1, 0\n\tv_mbcnt_hi_u32_b32 %0, -1, %0" : "=v"(t)); return t | (wave_u << 6); }
#define MIXER_STAGE 2
namespace pg8 {
#define PG8_LAS __attribute__((address_space(3)))
typedef unsigned short bf16_t;
typedef short bf16x8 __attribute__((ext_vector_type(8)));
typedef float f32x4 __attribute__((ext_vector_type(4)));
typedef unsigned u32x4 __attribute__((ext_vector_type(4)));
constexpr int BM = 256, BK = 64, HALF = 128, HTB = HALF * BK * 2  , STAGE_BYTES = 8 * HTB, NXCD = 8, WGM = 8;

__host__ __device__ __forceinline__ int lds_byte(int r, int c) { const int st = (r >> 4) * 2 + (c >> 5), rr = r & 15, cc = c & 31, ob = rr * 64 + cc * 2; return st * 1024 + (ob ^ (((ob >> 9) & 1) << 5)); }
__host__ __device__ __forceinline__ void stage_rc(int b, int& R, int& C) { const int st = b / 1024, sb = b % 1024, swz = sb ^ (((sb >> 9) & 1) << 5); R = (st >> 1) * 16 + swz / 64; C = (st & 1) * 32 + (swz % 64) / 2; }
__host__ __device__ __forceinline__ int perm32(int rho) { const int n = rho >> 4, i = rho & 15; return 8 * (i >> 2) + 4 * n + (i & 3); }

struct Unit { int pm, pn; };
struct Gemm { const bf16_t* A; const bf16_t* Bt; int M, N, K; };

struct StaticOrder {
    int nM, nN, nwg, G, c;
    __host__ __device__ void init(int M, int N, int G_, int c_) { nM = M / BM; nN = N / BM; nwg = nM * nN; G = G_; c = c_; }
    __host__ __device__ bool next(int i, Unit& u) const {
        const long L = (long)i * G + c; if (L >= nwg) return false;
        int wgid = (int)L; { const int q = nwg / NXCD, r = nwg % NXCD, xcd = wgid % NXCD, off = wgid / NXCD; wgid = (xcd < r ? xcd * (q + 1) : r * (q + 1) + (xcd - r) * q) + off; }
        const int nig = WGM * nN, gid = wgid / nig, fm = gid * WGM, gsz = (nM - fm) < WGM ? (nM - fm) : WGM;
        u.pm = fm + ((wgid % nig) % gsz); u.pn = (wgid % nig) / gsz; return true;
    }
    __device__ __forceinline__ void a_ready(const Unit&) const {}
    __device__ __forceinline__ void done(const Unit&) const {}
};

__device__ __forceinline__ unsigned cvt_pk_bf16(float lo, float hi) { unsigned r; asm volatile("v_cvt_pk_bf16_f32 %0, %1, %2" : "=v"(r) : "v"(lo), "v"(hi)); return r; }
constexpr int M_TOK = 65536, NPROMPT = 32768, DMODEL = 1024;
struct EpiH {
    static constexpr bool PERM = true, AFTER_DRAIN = false;
    bf16_t* O; int ldc; int nvalid; float c1; bf16_t* KD; bf16_t* VD;
    __device__ __forceinline__ void operator()(const f32x4 (&acc)[2][2][4][2], const Unit& u, int wr, int wc, int fr, int fq) const {
        const int row0 = u.pm * BM + wr * 64 + fr;
        const int col0 = u.pn * BM + wc * 32 + 8 * fq;
        const float sc = (u.pn < 2) ? c1 : (u.pn == 6 ? 0.125f : 1.0f);
        const bool dense = (u.pn >= 2) && (u.pn < 6);
        bf16_t* db = (u.pn < 4) ? KD : VD;
        const int crel = col0 - ((u.pn < 4) ? 512 : 1024);
#pragma unroll
        for (int ai = 0; ai < 2; ++ai)
#pragma unroll
            for (int m = 0; m < 4; ++m) { const int row = row0 + ai * HALF + m * 16; bf16_t* rowp = O + (size_t)row * ldc + col0;
#pragma unroll
                for (int bj = 0; bj < 2; ++bj) { if (col0 + bj * HALF < nvalid) { const f32x4 v0 = acc[ai][bj][m][0] * sc, v1 = acc[ai][bj][m][1] * sc;
                    u32x4 w; w.x = cvt_pk_bf16(v0[0], v0[1]); w.y = cvt_pk_bf16(v0[2], v0[3]); w.z = cvt_pk_bf16(v1[0], v1[1]); w.w = cvt_pk_bf16(v1[2], v1[3]);
                    if (dense) { const int cr = crel + bj * HALF; __builtin_nontemporal_store(w, (u32x4*)(db + ((size_t)(cr >> 7) * M_TOK + row) * 128 + (cr & 127))); }
                    else __builtin_nontemporal_store(w, (u32x4*)(rowp + bj * HALF)); } } }
    }
};
struct EpiHid {
    static constexpr bool PERM = true, AFTER_DRAIN = false;
    bf16_t* O; int ldc;
    __device__ __forceinline__ void operator()(const f32x4 (&acc)[2][2][4][2], const Unit& u, int wr, int wc, int fr, int fq) const {
        const int row0 = u.pm * BM + wr * 64 + fr;
        const int col0 = u.pn * BM + wc * 32 + 8 * fq;
#pragma unroll
        for (int ai = 0; ai < 2; ++ai)
#pragma unroll
            for (int m = 0; m < 4; ++m) { bf16_t* rowp = O + (size_t)(row0 + ai * HALF + m * 16) * ldc + col0;
#pragma unroll
                for (int bj = 0; bj < 2; ++bj) { f32x4 v0 = acc[ai][bj][m][0], v1 = acc[ai][bj][m][1];
#pragma unroll
                    for (int e = 0; e < 4; ++e) { const float a = fmaxf(v0[e], 0.f), b = fmaxf(v1[e], 0.f); v0[e] = a * a; v1[e] = b * b; }
                    u32x4 w; w.x = cvt_pk_bf16(v0[0], v0[1]); w.y = cvt_pk_bf16(v0[2], v0[3]); w.z = cvt_pk_bf16(v1[0], v1[1]); w.w = cvt_pk_bf16(v1[2], v1[3]);
                    __builtin_nontemporal_store(w, (u32x4*)(rowp + bj * HALF)); } }
    }
};
struct EpiRes {
    static constexpr bool PERM = false, AFTER_DRAIN = false;
    const float* xp; const float* xs; float* out; float alpha;
    __device__ __forceinline__ void operator()(const f32x4 (&acc)[2][2][4][2], const Unit& u, int wr, int wc, int fr, int fq) const {
        const int col0 = u.pn * BM + wc * 32 + 4 * fq;
#pragma unroll
        for (int ai = 0; ai < 2; ++ai)
#pragma unroll
            for (int m = 0; m < 4; ++m) { const int row = u.pm * BM + ai * HALF + wr * 64 + m * 16 + fr;
                float* orow = out + (size_t)row * DMODEL;
                const float* xr = xp ? ((row < NPROMPT) ? xp + (size_t)row * DMODEL : xs + (size_t)(row - NPROMPT) * DMODEL) : orow;
#pragma unroll
                for (int bj = 0; bj < 2; ++bj)
#pragma unroll
                    for (int n = 0; n < 2; ++n) { const int c = col0 + bj * HALF + n * 16; const f32x4 xv = *(const f32x4*)(xr + c); *(f32x4*)(orow + c) = xv * alpha + acc[ai][bj][m][n]; } }
    }
};


struct EpiResB {
    static constexpr bool PERM = true, AFTER_DRAIN = false;
    const float* xp; const float* xs; const bf16_t* RB; bf16_t* Y; float alpha; bool nt_out;
    __device__ __forceinline__ void operator()(const f32x4 (&acc)[2][2][4][2], const Unit& u, int wr, int wc, int fr, int fq) const {
        const int col0 = u.pn * BM + wc * 32 + 8 * fq;
#pragma unroll
        for (int ai = 0; ai < 2; ++ai)
#pragma unroll
            for (int m = 0; m < 4; ++m) { const int row = u.pm * BM + ai * HALF + wr * 64 + m * 16 + fr;
#pragma unroll
                for (int bj = 0; bj < 2; ++bj) { const int c = col0 + bj * HALF;
                    f32x4 r0, r1;
                    if (xp) { const float* xr = ((row < NPROMPT) ? xp + (size_t)row * DMODEL : xs + (size_t)(row - NPROMPT) * DMODEL) + c; r0 = *(const f32x4*)xr; r1 = *(const f32x4*)(xr + 4); }
                    else { const u32x4 w = *(const u32x4*)(RB + (size_t)row * DMODEL + c);
                        r0 = (f32x4){__uint_as_float(w.x << 16), __uint_as_float(w.x & 0xffff0000u), __uint_as_float(w.y << 16), __uint_as_float(w.y & 0xffff0000u)};
                        r1 = (f32x4){__uint_as_float(w.z << 16), __uint_as_float(w.z & 0xffff0000u), __uint_as_float(w.w << 16), __uint_as_float(w.w & 0xffff0000u)}; }
                    const f32x4 v0 = r0 * alpha + acc[ai][bj][m][0], v1 = r1 * alpha + acc[ai][bj][m][1];
                    u32x4 o; o.x = cvt_pk_bf16(v0[0], v0[1]); o.y = cvt_pk_bf16(v0[2], v0[3]); o.z = cvt_pk_bf16(v1[0], v1[1]); o.w = cvt_pk_bf16(v1[2], v1[3]);
                    if (nt_out) __builtin_nontemporal_store(o, (u32x4*)(Y + (size_t)row * DMODEL + c)); else *(u32x4*)(Y + (size_t)row * DMODEL + c) = o; } }
    }
};

template <class Epi, class Sched, bool ALIGN_EPI = false, bool SP2 = false>
__device__ __forceinline__ void gemm_phase(PG8_LAS unsigned char* lds, const Gemm g, const Sched& S, const Epi& E, int wave_u) {
    const int tid_l = tid_of(wave_u);
    const int tid = tid_l, wid = __builtin_amdgcn_readfirstlane(tid >> 6), lane = tid & 63, wr = wid >> 2, wc = wid & 3, fr = lane & 15, fq = lane >> 4;
    const int K = g.K, nt = K / BK;
    unsigned voffA[2], voffB[2];
#pragma unroll
    for (int i = 0; i < 2; ++i) { int R, C; stage_rc(tid * 16 + i * 8192, R, C); const int Rb = Epi::PERM ? ((R & ~31) + perm32(R & 31)) : R;
        voffA[i] = (unsigned)(R * K + C) * 2u; voffB[i] = (unsigned)(Rb * K + C) * 2u; }
    const size_t kstep = (size_t)(BK * 2);
    const size_t hstep = (size_t)HALF * K * 2;
    const size_t tstep = 2 * hstep;
    const unsigned ldsw = (unsigned)wid * 1024u;
    const int aoff = lds_byte(wr * 64 + fr, fq * 8), boff = lds_byte(wc * 32 + fr, fq * 8);
#define PG8_SA(b, h) (((b) * 2 + (h)) * HTB)
#define PG8_SB(b, h) ((4 + (b) * 2 + (h)) * HTB)
#define PG8_STAGE(bufoff, gbase, voff) do { _Pragma("unroll") for (int _i = 0; _i < 2; ++_i) \
        __builtin_amdgcn_global_load_lds((const unsigned*)((const char*)(gbase) + (voff)[_i]), (PG8_LAS unsigned*)(lds + (bufoff) + ldsw + _i * 8192), 16, 0, 0); } while (0)
#define PG8_LDA(dst, b, h) do { _Pragma("unroll") for (int m = 0; m < 4; ++m) _Pragma("unroll") for (int k = 0; k < 2; ++k) dst[m][k] = *(const PG8_LAS bf16x8*)(lds + PG8_SA(b, h) + aoff + m * 2048 + k * 1024); } while (0)
#define PG8_LDB(dst, b, h) do { _Pragma("unroll") for (int n = 0; n < 2; ++n) _Pragma("unroll") for (int k = 0; k < 2; ++k) dst[n][k] = *(const PG8_LAS bf16x8*)(lds + PG8_SB(b, h) + boff + n * 2048 + k * 1024); } while (0)
#define PG8_MMA(ai, bj, At, Bt) do { __builtin_amdgcn_s_setprio(1); _Pragma("unroll") for (int m = 0; m < 4; ++m) _Pragma("unroll") for (int n = 0; n < 2; ++n) _Pragma("unroll") for (int k = 0; k < 2; ++k) \
        acc[ai][bj][m][n] = __builtin_amdgcn_mfma_f32_16x16x32_bf16(Bt[n][k], At[m][k], acc[ai][bj][m][n], 0, 0, 0); __builtin_amdgcn_s_setprio(0); } while (0)
#define PG8_WAIT_V(n) asm volatile("s_waitcnt vmcnt(" #n ")" ::: "memory")
#define PG8_WAIT_L(n) asm volatile("s_waitcnt lgkmcnt(" #n ")" ::: "memory")
#define PG8_BAR __builtin_amdgcn_s_barrier()
#define PG8_SCHED __builtin_amdgcn_sched_barrier(0)
    Unit cur, nxt; int ui = 0;
    if (!S.next(0, cur)) return;
    f32x4 acc[2][2][4][2];
#pragma unroll
    for (int a = 0; a < 2; ++a)
#pragma unroll
        for (int b = 0; b < 2; ++b)
#pragma unroll
            for (int m = 0; m < 4; ++m)
#pragma unroll
                for (int n = 0; n < 2; ++n) acc[a][b][m][n] = (f32x4){0.f, 0.f, 0.f, 0.f};
    bf16x8 At[4][2], B0[2][2], B1[2][2];
    const char* cA = (const char*)g.A + (size_t)cur.pm * tstep; const char* cB = (const char*)g.Bt + (size_t)cur.pn * tstep;
    S.a_ready(cur);
    if constexpr (SP2) {
        PG8_STAGE(PG8_SB(0, 0), cB, voffB); PG8_STAGE(PG8_SB(0, 1), cB + hstep, voffB); PG8_STAGE(PG8_SA(0, 0), cA, voffA); PG8_STAGE(PG8_SA(0, 1), cA + hstep, voffA);
        if (wr == 1) PG8_BAR;
        PG8_WAIT_V(2); PG8_BAR;
        PG8_STAGE(PG8_SB(1, 0), cB + kstep, voffB); PG8_STAGE(PG8_SA(1, 0), cA + kstep, voffA); PG8_STAGE(PG8_SB(1, 1), cB + hstep + kstep, voffB);
        PG8_WAIT_V(6); PG8_BAR;
    } else {
        PG8_STAGE(PG8_SB(0, 0), cB, voffB); PG8_STAGE(PG8_SA(0, 0), cA, voffA); PG8_STAGE(PG8_SB(0, 1), cB + hstep, voffB); PG8_STAGE(PG8_SA(0, 1), cA + hstep, voffA);
        if (wr == 1) PG8_BAR;
        PG8_WAIT_V(4); PG8_BAR;
        PG8_STAGE(PG8_SB(1, 0), cB + kstep, voffB); PG8_STAGE(PG8_SA(1, 0), cA + kstep, voffA); PG8_STAGE(PG8_SB(1, 1), cB + hstep + kstep, voffB);
        PG8_WAIT_V(6); PG8_BAR;
    }
    for (;;) {
        const bool has_next = S.next(ui + 1, nxt);
        const char* nA = has_next ? (const char*)g.A + (size_t)nxt.pm * tstep : cA; const char* nB = has_next ? (const char*)g.Bt + (size_t)nxt.pn * tstep : cB;
        for (int t = 0; t < nt; t += 2) {
            const bool last = (t == nt - 2);
            const char* a1 = cA + (size_t)(t + 1) * kstep;
            const char* a2 = last ? nA : cA + (size_t)(t + 2) * kstep; const char* b2 = last ? nB : cB + (size_t)(t + 2) * kstep;
            const char* a3 = a2 + kstep; const char* b3 = b2 + kstep;
            if (last && has_next) S.a_ready(nxt);
            if constexpr (SP2) {
            PG8_LDB(B0, 0, 0); PG8_LDB(B1, 0, 1); PG8_SCHED; PG8_LDA(At, 0, 0); PG8_STAGE(PG8_SA(1, 1), a1 + hstep, voffA);
            PG8_WAIT_V(8); PG8_WAIT_L(0); PG8_BAR; PG8_MMA(0, 0, At, B0); PG8_MMA(0, 1, At, B1); PG8_BAR; PG8_SCHED;
            PG8_LDA(At, 0, 1); PG8_STAGE(PG8_SB(0, 0), b2, voffB); PG8_STAGE(PG8_SB(0, 1), b2 + hstep, voffB); PG8_STAGE(PG8_SA(0, 0), a2, voffA);
            PG8_WAIT_V(8); PG8_WAIT_L(0); PG8_BAR; PG8_MMA(1, 0, At, B0); PG8_MMA(1, 1, At, B1); PG8_BAR; PG8_SCHED;
            PG8_LDB(B0, 1, 0); PG8_LDB(B1, 1, 1); PG8_SCHED; PG8_LDA(At, 1, 0); PG8_STAGE(PG8_SA(0, 1), a2 + hstep, voffA);
            PG8_WAIT_V(8); PG8_WAIT_L(0); PG8_BAR; PG8_MMA(0, 0, At, B0); PG8_MMA(0, 1, At, B1); PG8_BAR; PG8_SCHED;
            PG8_LDA(At, 1, 1); PG8_STAGE(PG8_SB(1, 0), b3, voffB); PG8_STAGE(PG8_SB(1, 1), b3 + hstep, voffB); PG8_STAGE(PG8_SA(1, 0), a3, voffA);
            PG8_WAIT_V(8); PG8_WAIT_L(0); PG8_BAR; PG8_MMA(1, 0, At, B0); PG8_MMA(1, 1, At, B1); PG8_BAR; PG8_SCHED;
            } else {
            PG8_LDB(B0, 0, 0); PG8_SCHED; PG8_LDA(At, 0, 0); PG8_STAGE(PG8_SA(1, 1), a1 + hstep, voffA);
            PG8_WAIT_L(8); PG8_BAR; PG8_WAIT_L(0); PG8_MMA(0, 0, At, B0); PG8_BAR; PG8_SCHED;
            PG8_LDB(B1, 0, 1); PG8_STAGE(PG8_SB(0, 0), b2, voffB);
            PG8_BAR; PG8_WAIT_L(0); PG8_MMA(0, 1, At, B1); PG8_BAR;
            PG8_LDA(At, 0, 1); PG8_STAGE(PG8_SA(0, 0), a2, voffA);
            PG8_BAR; PG8_WAIT_L(0); PG8_MMA(1, 0, At, B0); PG8_BAR; PG8_SCHED;
            PG8_STAGE(PG8_SB(0, 1), b2 + hstep, voffB);
            PG8_WAIT_V(6); PG8_BAR; PG8_MMA(1, 1, At, B1); PG8_BAR;
            PG8_LDB(B0, 1, 0); PG8_SCHED; PG8_LDA(At, 1, 0); PG8_STAGE(PG8_SA(0, 1), a2 + hstep, voffA);
            PG8_WAIT_L(8); PG8_BAR; PG8_WAIT_L(0); PG8_MMA(0, 0, At, B0); PG8_BAR; PG8_SCHED;
            PG8_LDB(B1, 1, 1); PG8_STAGE(PG8_SB(1, 0), b3, voffB);
            PG8_BAR; PG8_WAIT_L(0); PG8_MMA(0, 1, At, B1); PG8_BAR;
            PG8_LDA(At, 1, 1); PG8_STAGE(PG8_SA(1, 0), a3, voffA);
            PG8_BAR; PG8_WAIT_L(0); PG8_MMA(1, 0, At, B0); PG8_BAR; PG8_SCHED;
            PG8_STAGE(PG8_SB(1, 1), b3 + hstep, voffB);
            PG8_WAIT_V(6); PG8_BAR; PG8_MMA(1, 1, At, B1); PG8_BAR;
            }
        }
        if constexpr (ALIGN_EPI) { if (wr == 0) PG8_BAR; }
        if constexpr (!Epi::AFTER_DRAIN) { E(acc, cur, wr, wc, fr, fq); S.done(cur); }
        if (!has_next) break;
#pragma unroll
        for (int a = 0; a < 2; ++a)
#pragma unroll
            for (int b = 0; b < 2; ++b)
#pragma unroll
                for (int m = 0; m < 4; ++m)
#pragma unroll
                    for (int n = 0; n < 2; ++n) acc[a][b][m][n] = (f32x4){0.f, 0.f, 0.f, 0.f};
        cur = nxt; cA = nA; cB = nB; ++ui;
        if constexpr (ALIGN_EPI) { if (wr == 1) PG8_BAR; }
    }
    PG8_WAIT_V(0);
    if constexpr (!ALIGN_EPI) { if (wr == 0) PG8_BAR; }
    PG8_BAR;
    if constexpr (Epi::AFTER_DRAIN) { E.fused(acc, cur, wr, wc, fr, fq, lds, wid, lane); S.done(cur); }
#undef PG8_SA
#undef PG8_SB
#undef PG8_STAGE
#undef PG8_LDA
#undef PG8_LDB
#undef PG8_MMA
#undef PG8_WAIT_V
#undef PG8_WAIT_L
#undef PG8_BAR
#undef PG8_SCHED
}
}
#define LAS __attribute__((address_space(3)))
typedef unsigned short bf16;
typedef float f32x4 __attribute__((ext_vector_type(4)));
typedef float f32x16 __attribute__((ext_vector_type(16)));
typedef short bf16x8 __attribute__((ext_vector_type(8)));
typedef short s16x4 __attribute__((ext_vector_type(4)));
typedef unsigned u32x4 __attribute__((ext_vector_type(4)));
typedef unsigned u32x2 __attribute__((ext_vector_type(2)));
using pg8::cvt_pk_bf16;

constexpr int NTHREADS = 512, NWAVES = 8;
constexpr int M = 65536, D = 1024, FF = 4096, DIN = 3104, DIN_PAD = 3328, LDH = 3104;
constexpr int NSEQ = 10, S_P = 16384, S_S = 4096, NPR = 32768;
constexpr int O_DQ = 0, O_DK = 512, O_DV = 1024, O_GQ = 1536, O_GK = 1792, O_GV = 2048, O_GR = 2560, O_LRF = 3072, O_LRB = 3088;
constexpr float LN_EPS = 1e-5f;
constexpr float ALPHA = 1.189207115002721f;
constexpr float LAM_INIT = 0.2f;
constexpr float C1 = 0.125f * 1.4426950408889634f;

constexpr size_t MiB = 1u << 20;
constexpr size_t WS_CTL = 0;
constexpr size_t WS_WIN = 2 * MiB, WS_WO = 9 * MiB, WS_W1 = 11 * MiB, WS_W2 = 19 * MiB, WS_GG = 27 * MiB;
constexpr size_t WS_H = 32 * MiB;
constexpr size_t WS_XB = 420 * MiB;
constexpr size_t WS_MIX = 548 * MiB;
constexpr size_t WS_ST = 676 * MiB;
constexpr size_t WS_X1B = 676 * MiB;
constexpr size_t WS_HID = 32 * MiB;
constexpr size_t WS_KD = 832 * MiB, WS_VD = 896 * MiB;
constexpr size_t WS_END = 960 * MiB;
static_assert(WS_H + (size_t)M * LDH * 2 <= WS_XB && WS_HID + (size_t)M * FF * 2 <= WS_MIX && WS_X1B + (size_t)M * D * 2 <= WS_END, "ws map");

constexpr int RING_BYTES = 131072;
constexpr int LDS_BYTES = 160 * 1024;

struct Params {
    const float* in[20];
    float* out;
    unsigned char* ws;
    int ph_lo, ph_hi;
};

__device__ __forceinline__ float wave_sum(float v) {
#pragma unroll
    for (int o = 1; o < 64; o <<= 1) v += __shfl_xor(v, o);
    return v;
}
__device__ __forceinline__ const float* xrow_ptr(const Params& p, int m) { return (m < NPR) ? p.in[0] + (size_t)m * D : p.in[1] + (size_t)(m - NPR) * D; }

__device__ __forceinline__ void p0_transpose_item(const float* W, int K, int N, bf16* WT, LAS float* scr, int item, int lane) {
    const int nblk = N / 32, kb = item / nblk, nb = item % nblk, k0 = 64 * kb, n0 = 32 * nb;
#pragma unroll 8
    for (int i = 0; i < 32; ++i) { const int kk = 2 * i + (lane >> 5); scr[kk * 33 + (lane & 31)] = W[(size_t)(k0 + kk) * N + n0 + (lane & 31)]; }
    asm volatile("s_waitcnt vmcnt(0) lgkmcnt(0)" ::: "memory");
    const int c = lane & 7;
#pragma unroll
    for (int j = 0; j < 4; ++j) { const int n = (lane >> 3) + 8 * j; const LAS float* s = scr + (8 * c) * 33 + n;
        u32x4 o; o.x = cvt_pk_bf16(s[0 * 33], s[1 * 33]); o.y = cvt_pk_bf16(s[2 * 33], s[3 * 33]); o.z = cvt_pk_bf16(s[4 * 33], s[5 * 33]); o.w = cvt_pk_bf16(s[6 * 33], s[7 * 33]);
        *(u32x4*)(WT + (size_t)(n0 + n) * K + k0 + 8 * c) = o; }
    asm volatile("s_waitcnt lgkmcnt(0)" ::: "memory");
}

__device__ __forceinline__ void ln_row(const float* in, float* outf, bf16* outb, const float* g, const float* b, int lane) {
    const f32x4* xr = (const f32x4*)in + lane;
    f32x4 v[4]; float s = 0.f;
#pragma unroll
    for (int j = 0; j < 4; ++j) { v[j] = xr[64 * j]; s += (v[j].x + v[j].y) + (v[j].z + v[j].w); }
    const float mean = wave_sum(s) * (1.f / D); float s2 = 0.f;
#pragma unroll
    for (int j = 0; j < 4; ++j) { v[j] = v[j] - mean; s2 += (v[j].x * v[j].x + v[j].y * v[j].y) + (v[j].z * v[j].z + v[j].w * v[j].w); }
    const float rstd = 1.f / sqrtf(wave_sum(s2) * (1.f / D) + LN_EPS);
#pragma unroll
    for (int j = 0; j < 4; ++j) {
        const f32x4 g4 = ((const f32x4*)g)[lane + 64 * j], b4 = ((const f32x4*)b)[lane + 64 * j];
        const f32x4 o = v[j] * rstd * g4 + b4;
        ((f32x4*)outf)[lane + 64 * j] = o;
        if (outb) { u32x2 w; w.x = cvt_pk_bf16(o.x, o.y); w.y = cvt_pk_bf16(o.z, o.w); ((u32x2*)outb)[lane + 64 * j] = w; }
    }
}

__device__ __forceinline__ void ln_row_b(const bf16* in, float* outf, bf16* outb, const float* g, const float* b, int lane) {
    const u32x4 wa = ((const u32x4*)in)[lane], wb = ((const u32x4*)in)[64 + lane];
    float v[16];
#pragma unroll
    for (int i = 0; i < 4; ++i) { v[2 * i] = __uint_as_float(wa[i] << 16); v[2 * i + 1] = __uint_as_float(wa[i] & 0xffff0000u); v[8 + 2 * i] = __uint_as_float(wb[i] << 16); v[8 + 2 * i + 1] = __uint_as_float(wb[i] & 0xffff0000u); }
    float s = 0.f;
#pragma unroll
    for (int i = 0; i < 16; ++i) s += v[i];
    const float mean = wave_sum(s) * (1.f / D); float s2 = 0.f;
#pragma unroll
    for (int i = 0; i < 16; ++i) { v[i] -= mean; s2 += v[i] * v[i]; }
    const float rstd = 1.f / sqrtf(wave_sum(s2) * (1.f / D) + LN_EPS);
#pragma unroll
    for (int h = 0; h < 2; ++h) {
        const int e0 = h * 512 + 8 * lane;
        const f32x4 g0 = *(const f32x4*)(g + e0), g1 = *(const f32x4*)(g + e0 + 4), b0 = *(const f32x4*)(b + e0), b1 = *(const f32x4*)(b + e0 + 4);
        const f32x4 o0 = (f32x4){v[8 * h + 0], v[8 * h + 1], v[8 * h + 2], v[8 * h + 3]} * rstd * g0 + b0;
        const f32x4 o1 = (f32x4){v[8 * h + 4], v[8 * h + 5], v[8 * h + 6], v[8 * h + 7]} * rstd * g1 + b1;
        if (outf) { *(f32x4*)(outf + e0) = o0; *(f32x4*)(outf + e0 + 4) = o1; }
        if (outb) { u32x4 w; w.x = cvt_pk_bf16(o0.x, o0.y); w.y = cvt_pk_bf16(o0.z, o0.w); w.z = cvt_pk_bf16(o1.x, o1.y); w.w = cvt_pk_bf16(o1.z, o1.w); *(u32x4*)(outb + e0) = w; }
    }
}

__device__ __forceinline__ void ln_rows4_b(const bf16* in, float* outf, bf16* outb, const float* g, const float* b, int lane) {
    u32x4 wa[4], wb[4];
#pragma unroll
    for (int r = 0; r < 4; ++r) { wa[r] = __builtin_nontemporal_load((const u32x4*)(in + (size_t)r * D) + lane); wb[r] = __builtin_nontemporal_load((const u32x4*)(in + (size_t)r * D) + 64 + lane); }
    float v[4][16], s[4], s2[4];
#pragma unroll
    for (int r = 0; r < 4; ++r) { s[r] = 0.f;
#pragma unroll
        for (int i = 0; i < 4; ++i) { v[r][2 * i] = __uint_as_float(wa[r][i] << 16); v[r][2 * i + 1] = __uint_as_float(wa[r][i] & 0xffff0000u); v[r][8 + 2 * i] = __uint_as_float(wb[r][i] << 16); v[r][8 + 2 * i + 1] = __uint_as_float(wb[r][i] & 0xffff0000u); }
#pragma unroll
        for (int i = 0; i < 16; ++i) s[r] += v[r][i]; }
#pragma unroll
    for (int o = 1; o < 64; o <<= 1) {
#pragma unroll
        for (int r = 0; r < 4; ++r) s[r] += __shfl_xor(s[r], o); }
#pragma unroll
    for (int r = 0; r < 4; ++r) { const float mean = s[r] * (1.f / D); s2[r] = 0.f;
#pragma unroll
        for (int i = 0; i < 16; ++i) { v[r][i] -= mean; s2[r] += v[r][i] * v[r][i]; } }
#pragma unroll
    for (int o = 1; o < 64; o <<= 1) {
#pragma unroll
        for (int r = 0; r < 4; ++r) s2[r] += __shfl_xor(s2[r], o); }
#pragma unroll
    for (int h = 0; h < 2; ++h) {
        const int e0 = h * 512 + 8 * lane;
        const f32x4 g0 = *(const f32x4*)(g + e0), g1 = *(const f32x4*)(g + e0 + 4), b0 = *(const f32x4*)(b + e0), b1 = *(const f32x4*)(b + e0 + 4);
#pragma unroll
        for (int r = 0; r < 4; ++r) {
            const float rstd = 1.f / sqrtf(s2[r] * (1.f / D) + LN_EPS);
            const f32x4 o0 = (f32x4){v[r][8 * h + 0], v[r][8 * h + 1], v[r][8 * h + 2], v[r][8 * h + 3]} * rstd * g0 + b0;
            const f32x4 o1 = (f32x4){v[r][8 * h + 4], v[r][8 * h + 5], v[r][8 * h + 6], v[r][8 * h + 7]} * rstd * g1 + b1;
            if (outf) { __builtin_nontemporal_store(o0, (f32x4*)(outf + (size_t)r * D + e0)); __builtin_nontemporal_store(o1, (f32x4*)(outf + (size_t)r * D + e0 + 4)); }
            if (outb) { u32x4 w; w.x = cvt_pk_bf16(o0.x, o0.y); w.y = cvt_pk_bf16(o0.z, o0.w); w.z = cvt_pk_bf16(o1.x, o1.y); w.w = cvt_pk_bf16(o1.z, o1.w); *(u32x4*)(outb + (size_t)r * D + e0) = w; }
        }
    }
}
#define RLX_AGENT __ATOMIC_RELAXED, __HIP_MEMORY_SCOPE_AGENT
#define XB_TMO      128
#define XB_XCNT(j)  (256  + 64 * (j))
#define XB_XSUB(j)  (1280 + 64 * (j))
#define XB_XGEN(j)  (2304 + 64 * (j))
#define XB_TOP      3328
#define XB_TOPGEN   3392
#define XCD_BAR_WORDS 3456
#define XB_SPIN_CAP (1u << 18)

__device__ __forceinline__ unsigned xb_ld(unsigned* p)              { return __hip_atomic_load(p, __ATOMIC_RELAXED, __HIP_MEMORY_SCOPE_AGENT); }
__device__ __forceinline__ unsigned xb_add(unsigned* p, unsigned v) { return __hip_atomic_fetch_add(p, v, __ATOMIC_RELAXED, __HIP_MEMORY_SCOPE_AGENT); }
__device__ __forceinline__ unsigned xb_xcc_id() { return (unsigned)__builtin_amdgcn_s_getreg((3 << 11) | 20) & 0xFu; }
#define XB_SPIN(cond, bar) do { unsigned _sp = 0; while (cond) { __builtin_amdgcn_s_sleep(1); \
    if ((++_sp & 255u) == 0u) { if (xb_ld(&(bar)[XB_TMO])) break; if (_sp > XB_SPIN_CAP) { atomicAdd(&(bar)[XB_TMO], 1u); break; } } } } while (0)

struct XcdBarrier {
    unsigned* bar; unsigned x; int wv;
    volatile LAS unsigned* st;
};

__device__ __forceinline__ XcdBarrier xcd_barrier_post(unsigned* bar, volatile LAS unsigned* st, int wave_u) {
    XcdBarrier b; b.bar = bar; b.x = xb_xcc_id(); b.st = st; b.wv = wave_u;
    if (tid_of(wave_u) == 0) (void)xb_add(&bar[XB_XCNT(b.x)], 1u);
    return b;
}
__device__ __forceinline__ void xcd_barrier_complete(unsigned* bar, unsigned x, unsigned& nloc, unsigned& nx) {
    const unsigned G = gridDim.x * gridDim.y * gridDim.z;
    unsigned sum, cnt, mine, sp = 0u;
    for (;;) {
        sum = 0u; cnt = 0u; mine = 0u;
#pragma unroll
        for (unsigned j = 0; j < 16; ++j) { const unsigned c = xb_ld(&bar[XB_XCNT(j)]); sum += c; cnt += (c > 0u) ? 1u : 0u; mine = (j == x) ? c : mine; }
        if (sum == G) break;
        __builtin_amdgcn_s_sleep(1);
        if ((++sp & 255u) == 0u) { if (xb_ld(&bar[XB_TMO])) break; if (sp > XB_SPIN_CAP) { atomicAdd(&bar[XB_TMO], 1u); break; } }
    }
    nloc = mine > 0u ? mine : 1u; nx = cnt > 0u ? cnt : 1u;
}

__device__ __forceinline__ void xcd_barrier(const XcdBarrier& b) {
    asm volatile("s_waitcnt vmcnt(0)" ::: "memory");
    __syncthreads();
    if (tid_of(b.wv) == 0) {
        unsigned* bar = b.bar;
        __builtin_amdgcn_s_waitcnt(0);
        unsigned nloc = b.st[0], nx = b.st[1];
        if (nloc == 0u) { xcd_barrier_complete(bar, b.x, nloc, nx); b.st[0] = nloc; b.st[1] = nx; }
        const unsigned old = xb_add(&bar[XB_XSUB(b.x)], 1u);
        const unsigned gen = old / nloc;
        if (old + 1u == (gen + 1u) * nloc) {
            __builtin_amdgcn_fence(__ATOMIC_RELEASE, "agent");
            asm volatile("s_waitcnt vmcnt(0)" ::: "memory");
            const unsigned og = xb_add(&bar[XB_TOP], 1u);
            const unsigned tg = og / nx;
            if (og + 1u == (tg + 1u) * nx) xb_add(&bar[XB_TOPGEN], 1u);
            else XB_SPIN(xb_ld(&bar[XB_TOPGEN]) == tg, bar);
            __builtin_amdgcn_fence(__ATOMIC_ACQUIRE, "agent");
            xb_add(&bar[XB_XGEN(b.x)], 1u);
            asm volatile("s_waitcnt vmcnt(0)" ::: "memory");
        } else {
            XB_SPIN(xb_ld(&bar[XB_XGEN(b.x)]) == gen, bar);
            __builtin_amdgcn_fence(__ATOMIC_ACQUIRE, "agent");
            asm volatile("s_waitcnt vmcnt(0)" ::: "memory");
        }
    }
    __syncthreads();
}
#ifndef ATT_REPS
#define ATT_REPS 1
#endif
namespace att {
typedef short v4i16_t __attribute__((ext_vector_type(4)));
typedef float f32x2 __attribute__((ext_vector_type(2)));
typedef __bf16 bf16x2_t __attribute__((ext_vector_type(2)));
__device__ __forceinline__ unsigned cvtpk_n(float lo, float hi) { const f32x2 v = {lo, hi}; return __builtin_bit_cast(unsigned, __builtin_convertvector(v, bf16x2_t)); }
constexpr int KSTR = 272, VSTR = 320;
constexpr int KBUF = 64 * KSTR, VBUF = 64 * VSTR, BUFB = KBUF + VBUF;
constexpr int XS = 132;
constexpr int TILEB = 32768;
constexpr int L_RED = 4 * TILEB;
constexpr int L_CTL = 160 * 1024 - 256;
constexpr float SKIP_T = 38.f;
constexpr int CW_UNIT = 160, CW_KN = 64;
__device__ __forceinline__ int crow(int r, int hi) { return (r & 3) + 8 * (r >> 2) + 4 * hi; }
__device__ __forceinline__ s16x4 vtr(LAS unsigned char* p) { return __builtin_bit_cast(s16x4, __builtin_amdgcn_ds_read_tr16_b64_v4i16((LAS v4i16_t*)p)); }
__device__ __forceinline__ float bf_lo(unsigned w) { return __uint_as_float(w << 16); }
__device__ __forceinline__ float bf_hi(unsigned w) { return __uint_as_float(w & 0xffff0000u); }

__device__ __forceinline__ void knorm_phase(const bf16* KD, unsigned* ctl, int bid, int G, int wave_u) {
    const int tid_l = tid_of(wave_u);
    const int gt = bid * NTHREADS + tid_l, NTH = G * NTHREADS;
    for (int idx = gt; idx < M * 8; idx += NTH) {
        const int row = idx >> 3, hc = idx & 7;
        const u32x4* kp = (const u32x4*)(KD + ((size_t)(hc >> 1) * M + row) * 128 + (hc & 1) * 64);
        float ss = 0.f;
#pragma unroll
        for (int i = 0; i < 8; ++i) { const u32x4 w = kp[i];
#pragma unroll
            for (int e = 0; e < 4; ++e) { const float a = bf_lo(w[e]), b = bf_hi(w[e]); ss = fmaf(a, a, ss); ss = fmaf(b, b, ss); } }
        float nr = sqrtf(ss);
        nr = fmaxf(nr, __shfl_xor(nr, 8)); nr = fmaxf(nr, __shfl_xor(nr, 16)); nr = fmaxf(nr, __shfl_xor(nr, 32));
        const int seq = (row < NPR) ? (row >> 14) : 2 + ((row - NPR) >> 12);
        if ((tid_l & 63) < 8) atomicMax(ctl + CW_KN + seq * 8 + hc, __float_as_uint(nr));
    }
}

__device__ __forceinline__ void attn_unit(const bf16* Hb, const bf16* KD, const bf16* VD, bf16* MIX, int row0, int S, int head, int qb, float lam, const float* dng, float kn0, float kn1, LAS unsigned char* lds, int wave_u) {
    const int tid_l = tid_of(wave_u);
    const int tid = tid_l, lane = tid & 63, wid = __builtin_amdgcn_readfirstlane(tid >> 6), r32 = lane & 31, hh = lane >> 5;
    const int c = wid >> 2, qs = wid & 3;
    const int q0 = qb * 128 + qs * 32;
    const float slope2 = __uint_as_float(__builtin_amdgcn_readfirstlane(__float_as_uint(exp2f(-2.f * (float)(head + 1)) * 1.4426950408889634f)));
    lam = __uint_as_float(__builtin_amdgcn_readfirstlane(__float_as_uint(lam)));
    bf16x8 qr[4];
    float mub;
    float m;
    {   const bf16* Qp = Hb + (size_t)(row0 + q0 + r32) * LDH + O_DQ + head * 128 + c * 64 + hh * 8;
        const bf16* Kp = KD + ((size_t)head * M + row0 + q0 + r32) * 128 + c * 64 + hh * 8;
        float qq = 0.f, dot = 0.f;
#pragma unroll
        for (int d0 = 0; d0 < 4; ++d0) { qr[d0] = *(const bf16x8*)(Qp + d0 * 16); const u32x4 qw = __builtin_bit_cast(u32x4, qr[d0]); const u32x4 kw = *(const u32x4*)(Kp + d0 * 16);
#pragma unroll
            for (int e = 0; e < 4; ++e) { const float qa = bf_lo(qw[e]), qb_ = bf_hi(qw[e]), ka = bf_lo(kw[e]), kb = bf_hi(kw[e]);
                qq = fmaf(qa, qa, qq); qq = fmaf(qb_, qb_, qq); dot = fmaf(qa, ka, dot); dot = fmaf(qb_, kb, dot); } }
        qq += __shfl_xor(qq, 32); dot += __shfl_xor(dot, 32);
        m = dot;
        float am = sqrtf(qq) * (c ? kn1 : kn0) * 1.001f + 0.01f, bm = dot;
        mub = am;
        float sp = am - dot;
#pragma unroll
        for (int o = 1; o < 32; o <<= 1) { am = fmaxf(am, __shfl_xor(am, o)); bm = fminf(bm, __shfl_xor(bm, o)); sp = fmaxf(sp, __shfl_xor(sp, o)); }
        LAS float* red = (LAS float*)(lds + L_RED);
        if (lane == 0) { red[wid * 4] = am; red[wid * 4 + 1] = bm; red[wid * 4 + 2] = sp; }
    }
    __syncthreads();
    int tlo, thi; bool fast;
    {   LAS float* red = (LAS float*)(lds + L_RED); float am = red[0], bm = red[1], sp = red[2];
#pragma unroll
        for (int w = 1; w < 8; ++w) { am = fmaxf(am, red[4 * w]); bm = fminf(bm, red[4 * w + 1]); sp = fmaxf(sp, red[4 * w + 2]); }
        fast = sp < 100.f;
        const float Wf = (sp + SKIP_T) / slope2 + 1.f; (void)am; (void)bm;
        const int W = (Wf < 1.0e6f) ? (int)Wf : 1000000;
        const int Q0 = qb * 128, NTall = S / 64;
        int lo = Q0 - 63 - W; lo = lo > 0 ? (lo + 63) / 64 : 0;
        int hi_ = (Q0 + 127 + W) / 64; hi_ = hi_ < NTall - 1 ? hi_ : NTall - 1;
        tlo = __builtin_amdgcn_readfirstlane(lo); thi = __builtin_amdgcn_readfirstlane(hi_);
    }
    if (((thi - tlo + 1) & 1) != 0) { if (tlo > 0) --tlo; else ++thi; }
    const int drow = 8 * wid + (lane >> 4);
    const int f0 = ((drow & 3) << 2) | ((drow >> 2) & 3), f1 = (((drow + 4) & 3) << 2) | (((drow + 4) >> 2) & 3);
    const unsigned kg0 = (unsigned)((((size_t)head * M + row0 + drow) * 128 + ((lane & 15) ^ f0) * 8) * 2);
    const unsigned kg1 = (unsigned)((((size_t)head * M + row0 + drow + 4) * 128 + ((lane & 15) ^ f1) * 8) * 2);
    const char* Kc = (const char*)KD; const char* Vc = (const char*)VD;
    const int dmaw = wid * 2048;
#define ATT_DMA(t, st) do { const unsigned off_ = (unsigned)(t) * 16384u; LAS unsigned char* S_ = lds + (st) * TILEB + dmaw; \
        __builtin_amdgcn_global_load_lds((const unsigned*)(Kc + (size_t)(kg0 + off_)), (LAS unsigned*)(S_), 16, 0, 0); \
        __builtin_amdgcn_global_load_lds((const unsigned*)(Kc + (size_t)(kg1 + off_)), (LAS unsigned*)(S_ + 1024), 16, 0, 0); \
        __builtin_amdgcn_global_load_lds((const unsigned*)(Vc + (size_t)(kg0 + off_)), (LAS unsigned*)(S_ + 16384), 16, 0, 0); \
        __builtin_amdgcn_global_load_lds((const unsigned*)(Vc + (size_t)(kg1 + off_)), (LAS unsigned*)(S_ + 16384 + 1024), 16, 0, 0); } while (0)
    ATT_DMA(tlo, 0); ATT_DMA(tlo + 1, 1);
    asm volatile("s_waitcnt vmcnt(0)" ::: "memory");
    __syncthreads();
    float l = 0.f;
    f32x16 o[4];
#pragma unroll
    for (int b = 0; b < 4; ++b)
#pragma unroll
        for (int r = 0; r < 16; ++r) o[b][r] = 0.f;
    const int fk = ((r32 & 3) << 2) | ((r32 >> 2) & 3);
    const int kbase = 256 * r32 + 16 * ((c * 8 + hh) ^ fk);
    const int q4 = (lane & 15) >> 2, pp4 = lane & 3, g1 = (lane >> 4) & 1;
    const int vlow0 = (2 * g1 + (pp4 >> 1)) ^ hh;
    const int vbase0 = 16384 + 256 * (4 * hh + q4) + 64 * q4 + 16 * vlow0 + 8 * (pp4 & 1);
    const int vbase1 = 16384 + 256 * (4 * hh + q4 + 8) + 64 * q4 + 16 * (vlow0 ^ 2) + 8 * (pp4 & 1);
    f32x2 l2 = (f32x2){0.f, 0.f};
#define ATT_CINIT(P0, P1, T) do { const int krel_ = (T) * 64 - q0; const float dbase_ = (float)(krel_ + 4 * hh - r32); \
        if (krel_ + 63 <= 0 || krel_ >= 31) { const float sg_ = (krel_ + 63 <= 0) ? slope2 : -slope2; const float base_ = fmaf(sg_, dbase_, -m); \
            _Pragma("unroll") for (int r = 0; r < 16; ++r) { const float cr = (float)((r & 3) + 8 * (r >> 2)); P0[r] = fmaf(sg_, cr, base_); P1[r] = fmaf(sg_, cr + 32.f, base_); } } \
        else { _Pragma("unroll") for (int r = 0; r < 16; ++r) { const float cr = (float)((r & 3) + 8 * (r >> 2)); P0[r] = fmaf(fabsf(dbase_ + cr), -slope2, -m); P1[r] = fmaf(fabsf(dbase_ + cr + 32.f), -slope2, -m); } } } while (0)
#define ATT_SB() __builtin_amdgcn_sched_barrier(0)
#define ATT_EXPPACK(P, S8, W) do { float e0 = __builtin_amdgcn_exp2f(P[S8 + 0]), e1 = __builtin_amdgcn_exp2f(P[S8 + 1]), e2 = __builtin_amdgcn_exp2f(P[S8 + 2]), e3 = __builtin_amdgcn_exp2f(P[S8 + 3]), \
        e4 = __builtin_amdgcn_exp2f(P[S8 + 4]), e5 = __builtin_amdgcn_exp2f(P[S8 + 5]), e6 = __builtin_amdgcn_exp2f(P[S8 + 6]), e7 = __builtin_amdgcn_exp2f(P[S8 + 7]); \
        l += ((e0 + e1) + (e2 + e3)) + ((e4 + e5) + (e6 + e7)); \
        u32x4 w_; w_.x = cvt_pk_bf16(e0, e1); w_.y = cvt_pk_bf16(e2, e3); w_.z = cvt_pk_bf16(e4, e5); w_.w = cvt_pk_bf16(e6, e7); W = __builtin_bit_cast(bf16x8, w_); } while (0)
#define ATT_VRD(S, L, H) do { _Pragma("unroll") for (int db = 0; db < 4; ++db) { \
        asm volatile("ds_read_b64_tr_b16 %0, %1 offset:%c2" : "=&v"(L[db]) : "v"(va0[db]), "i"(4096 * (S)) : "memory"); \
        asm volatile("ds_read_b64_tr_b16 %0, %1 offset:%c2" : "=&v"(H[db]) : "v"(va1[db]), "i"(4096 * (S)) : "memory"); } } while (0)
#define ATT_WAITV(L, H) asm volatile("s_waitcnt lgkmcnt(0)" : "+v"(L[0]), "+v"(L[1]), "+v"(L[2]), "+v"(L[3]), "+v"(H[0]), "+v"(H[1]), "+v"(H[2]), "+v"(H[3]) : : "memory")
#define ATT_PVM(L, H, PF) do { _Pragma("unroll") for (int db = 0; db < 4; ++db) \
        o[db] = __builtin_amdgcn_mfma_f32_32x32x16_bf16(__builtin_bit_cast(bf16x8, (u32x4){L[db].x, L[db].y, H[db].x, H[db].y}), PF, o[db], 0, 0, 0); } while (0)
#define ATT_TILE(Bt, T) do { \
        f32x16 p0, p1; ATT_CINIT(p0, p1, T); \
        unsigned va0[4], va1[4]; { const unsigned tb_ = (unsigned)(uintptr_t)(Bt); \
            _Pragma("unroll") for (int db = 0; db < 4; ++db) { va0[db] = tb_ + (unsigned)(vbase0 ^ (64 * db)); va1[db] = tb_ + (unsigned)(vbase1 ^ (64 * db)); } } \
        bf16x8 kf[8]; \
        _Pragma("unroll") for (int d0 = 0; d0 < 4; ++d0) { kf[2 * d0] = *(LAS bf16x8*)(Bt + (kbase ^ (32 * d0))); kf[2 * d0 + 1] = *(LAS bf16x8*)(Bt + 8192 + (kbase ^ (32 * d0))); } \
        ATT_SB(); \
        _Pragma("unroll") for (int d0 = 0; d0 < 4; ++d0) { p0 = __builtin_amdgcn_mfma_f32_32x32x16_bf16(kf[2 * d0], qr[d0], p0, 0, 0, 0); p1 = __builtin_amdgcn_mfma_f32_32x32x16_bf16(kf[2 * d0 + 1], qr[d0], p1, 0, 0, 0); } \
        u32x2 vl[4], vh[4], wl[4], wh[4]; \
        ATT_VRD(0, vl, vh); \
        ATT_SB(); \
        float mt = fmaxf(p0[0], p1[0]); \
        _Pragma("unroll") for (int r = 1; r < 16; ++r) mt = fmaxf(mt, fmaxf(p0[r], p1[r])); \
        mt = fmaxf(mt, __shfl_xor(mt, 32)); \
        if (__any(mt > 0.f)) { \
            const float dl = fmaxf(mt, 0.f), alpha = __builtin_amdgcn_exp2f(-dl); \
            m += dl; l *= alpha; \
            _Pragma("unroll") for (int r = 0; r < 16; ++r) { p0[r] -= dl; p1[r] -= dl; } \
            _Pragma("unroll") for (int b = 0; b < 4; ++b) _Pragma("unroll") for (int r = 0; r < 16; ++r) o[b][r] *= alpha; \
        } \
        bf16x8 f0, f1, f2, f3; \
        ATT_EXPPACK(p0, 0, f0); ATT_EXPPACK(p0, 8, f1); ATT_EXPPACK(p1, 0, f2); ATT_EXPPACK(p1, 8, f3); \
        ATT_SB(); \
        ATT_WAITV(vl, vh); ATT_VRD(1, wl, wh); ATT_SB(); ATT_PVM(vl, vh, f0); ATT_SB(); \
        ATT_WAITV(wl, wh); ATT_VRD(2, vl, vh); ATT_SB(); ATT_PVM(wl, wh, f1); ATT_SB(); \
        ATT_WAITV(vl, vh); ATT_VRD(3, wl, wh); ATT_SB(); ATT_PVM(vl, vh, f2); ATT_SB(); \
        ATT_WAITV(wl, wh); ATT_SB(); ATT_PVM(wl, wh, f3); ATT_SB(); \
    } while (0)
#define ATT_TILE_FAST(Bt, T) do { \
        f32x16 p0, p1; \
        { const int krel_ = (T) * 64 - q0; const float dbase_ = (float)(krel_ + 4 * hh - r32); \
          if (krel_ + 63 <= 0 || krel_ >= 31) { const float sg_ = (krel_ + 63 <= 0) ? slope2 : -slope2; const float b0_ = fmaf(sg_, dbase_, -mub), b1_ = fmaf(sg_, 32.f, b0_); \
              _Pragma("unroll") for (int r = 0; r < 16; ++r) { const float cr = (float)((r & 3) + 8 * (r >> 2)); p0[r] = fmaf(sg_, cr, b0_); p1[r] = fmaf(sg_, cr, b1_); } } \
          else { _Pragma("unroll") for (int r = 0; r < 16; ++r) { const float cr = (float)((r & 3) + 8 * (r >> 2)); p0[r] = fmaf(fabsf(dbase_ + cr), -slope2, -mub); p1[r] = fmaf(fabsf(dbase_ + cr + 32.f), -slope2, -mub); } } } \
        unsigned va0[4], va1[4]; { const unsigned tb_ = (unsigned)(uintptr_t)(Bt); \
            _Pragma("unroll") for (int db = 0; db < 4; ++db) { va0[db] = tb_ + (unsigned)(vbase0 ^ (64 * db)); va1[db] = tb_ + (unsigned)(vbase1 ^ (64 * db)); } } \
        bf16x8 kf[8]; \
        _Pragma("unroll") for (int d0 = 0; d0 < 4; ++d0) { kf[2 * d0] = *(LAS bf16x8*)(Bt + (kbase ^ (32 * d0))); kf[2 * d0 + 1] = *(LAS bf16x8*)(Bt + 8192 + (kbase ^ (32 * d0))); } \
        ATT_SB(); \
        _Pragma("unroll") for (int d0 = 0; d0 < 4; ++d0) { p0 = __builtin_amdgcn_mfma_f32_32x32x16_bf16(kf[2 * d0], qr[d0], p0, 0, 0, 0); p1 = __builtin_amdgcn_mfma_f32_32x32x16_bf16(kf[2 * d0 + 1], qr[d0], p1, 0, 0, 0); } \
        u32x2 vl[4], vh[4], wl[4], wh[4]; \
        ATT_VRD(0, vl, vh); \
        ATT_SB(); \
        bf16x8 f0, f1, f2, f3; \
        ATT_EXPPACK2(p0, 0, f0); ATT_EXPPACK2(p0, 8, f1); ATT_EXPPACK2(p1, 0, f2); ATT_EXPPACK2(p1, 8, f3); \
        ATT_SB(); \
        ATT_WAITV(vl, vh); ATT_VRD(1, wl, wh); ATT_SB(); ATT_PVM(vl, vh, f0); ATT_SB(); \
        ATT_WAITV(wl, wh); ATT_VRD(2, vl, vh); ATT_SB(); ATT_PVM(wl, wh, f1); ATT_SB(); \
        ATT_WAITV(vl, vh); ATT_VRD(3, wl, wh); ATT_SB(); ATT_PVM(vl, vh, f2); ATT_SB(); \
        ATT_WAITV(wl, wh); ATT_SB(); ATT_PVM(wl, wh, f3); ATT_SB(); \
    } while (0)
#define ATT_EXPPACK2(P, S8, W) do { f32x2 ea_ = (f32x2){__builtin_amdgcn_exp2f(P[S8 + 0]), __builtin_amdgcn_exp2f(P[S8 + 1])}, eb_ = (f32x2){__builtin_amdgcn_exp2f(P[S8 + 2]), __builtin_amdgcn_exp2f(P[S8 + 3])}, \
        ec_ = (f32x2){__builtin_amdgcn_exp2f(P[S8 + 4]), __builtin_amdgcn_exp2f(P[S8 + 5])}, ed_ = (f32x2){__builtin_amdgcn_exp2f(P[S8 + 6]), __builtin_amdgcn_exp2f(P[S8 + 7])}; \
        l2 += (ea_ + eb_) + (ec_ + ed_); \
        u32x4 w_; w_.x = cvt_pk_bf16(ea_.x, ea_.y); w_.y = cvt_pk_bf16(eb_.x, eb_.y); w_.z = cvt_pk_bf16(ec_.x, ec_.y); w_.w = cvt_pk_bf16(ed_.x, ed_.y); W = __builtin_bit_cast(bf16x8, w_); } while (0)
#define ATT_CINITH(P, T, H) do { const int krel_ = (T) * 64 - q0; const float dbase_ = (float)(krel_ + 4 * hh - r32 + 32 * (H)); \
          if (krel_ + 63 <= 0 || krel_ >= 31) { const float sg_ = (krel_ + 63 <= 0) ? slope2 : -slope2; const float b0_ = fmaf(sg_, dbase_, -mref); \
              _Pragma("unroll") for (int r = 0; r < 16; ++r) { const float cr = (float)((r & 3) + 8 * (r >> 2)); P[r] = fmaf(sg_, cr, b0_); } } \
          else { _Pragma("unroll") for (int r = 0; r < 16; ++r) { const float cr = (float)((r & 3) + 8 * (r >> 2)); P[r] = fmaf(fabsf(dbase_ + cr), -slope2, -mref); } } } while (0)
#define ATT_SGB(mask, n) __builtin_amdgcn_sched_group_barrier(mask, n, 0)
#define ATT_KLD(Bt, H) do { _Pragma("unroll") for (int d0 = 0; d0 < 4; ++d0) kf[d0] = *(LAS bf16x8*)(Bt + 8192 * (H) + (kbase ^ (32 * d0))); } while (0)
#define ATT_QK(P) do { _Pragma("unroll") for (int d0 = 0; d0 < 4; ++d0) P = __builtin_amdgcn_mfma_f32_32x32x16_bf16(kf[d0], qr[d0], P, 0, 0, 0); } while (0)
#define ATT_VADDR(Bt) do { const unsigned tb_ = (unsigned)(uintptr_t)(Bt); \
            _Pragma("unroll") for (int db = 0; db < 4; ++db) { va0[db] = tb_ + (unsigned)(vbase0 ^ (64 * db)); va1[db] = tb_ + (unsigned)(vbase1 ^ (64 * db)); } } while (0)
#define ATT_PAIR_FAST(BtA, BtB, T) do { \
        f32x16 a0, a1, b0, b1; bf16x8 kf[4]; unsigned va0[4], va1[4]; u32x2 vl[4], vh[4], wl[4], wh[4]; \
        bf16x8 fa0, fa1, fa2, fa3, fb0, fb1, fb2, fb3; \
        ATT_CINITH(a0, T, 0); ATT_CINITH(a1, T, 1); ATT_VADDR(BtA); \
        ATT_KLD(BtA, 0); ATT_SB(); ATT_QK(a0); ATT_VRD(0, vl, vh); ATT_KLD(BtA, 1); ATT_SB(); \
        ATT_QK(a1); ATT_EXPPACK2(a0, 0, fa0); ATT_EXPPACK2(a0, 8, fa1); \
        _Pragma("unroll") for (int i_ = 0; i_ < 4; ++i_) { ATT_SGB(0x8, 1); ATT_SGB(0x2, 7); } ATT_SB(); \
        ATT_CINITH(b0, (T) + 1, 0); ATT_WAITV(vl, vh); ATT_VRD(1, wl, wh); ATT_KLD(BtB, 0); ATT_SB(); \
        ATT_PVM(vl, vh, fa0); ATT_QK(b0); ATT_EXPPACK2(a1, 0, fa2); ATT_EXPPACK2(a1, 8, fa3); \
        _Pragma("unroll") for (int i_ = 0; i_ < 8; ++i_) { ATT_SGB(0x8, 1); ATT_SGB(0x2, 4); } ATT_SB(); \
        ATT_CINITH(b1, (T) + 1, 1); ATT_WAITV(wl, wh); ATT_VRD(2, vl, vh); ATT_KLD(BtB, 1); ATT_SB(); \
        ATT_PVM(wl, wh, fa1); ATT_QK(b1); ATT_EXPPACK2(b0, 0, fb0); ATT_EXPPACK2(b0, 8, fb1); \
        _Pragma("unroll") for (int i_ = 0; i_ < 8; ++i_) { ATT_SGB(0x8, 1); ATT_SGB(0x2, 4); } ATT_SB(); \
        ATT_WAITV(vl, vh); ATT_VRD(3, wl, wh); ATT_SB(); \
        ATT_PVM(vl, vh, fa2); ATT_EXPPACK2(b1, 0, fb2); \
        _Pragma("unroll") for (int i_ = 0; i_ < 4; ++i_) { ATT_SGB(0x8, 1); ATT_SGB(0x2, 4); } ATT_SB(); \
        ATT_WAITV(wl, wh); ATT_VRD(8, vl, vh); ATT_SB(); \
        ATT_PVM(wl, wh, fa3); ATT_EXPPACK2(b1, 8, fb3); \
        _Pragma("unroll") for (int i_ = 0; i_ < 4; ++i_) { ATT_SGB(0x8, 1); ATT_SGB(0x2, 4); } ATT_SB(); \
        ATT_WAITV(vl, vh); ATT_VRD(9, wl, wh); ATT_SB(); ATT_PVM(vl, vh, fb0); ATT_SB(); \
        ATT_WAITV(wl, wh); ATT_VRD(10, vl, vh); ATT_SB(); ATT_PVM(wl, wh, fb1); ATT_SB(); \
        ATT_WAITV(vl, vh); ATT_VRD(11, wl, wh); ATT_SB(); ATT_PVM(vl, vh, fb2); ATT_SB(); \
        ATT_WAITV(wl, wh); ATT_SB(); ATT_PVM(wl, wh, fb3); ATT_SB(); \
    } while (0)
    if (fast) {
    for (int t = tlo; t <= thi; t += 2) {
        const int pbuf = ((t - tlo) >> 1) & 1;
        if (t + 2 <= thi) { ATT_DMA(t + 2, 2 * (pbuf ^ 1)); ATT_DMA(t + 3, 2 * (pbuf ^ 1) + 1); }
        LAS unsigned char* BA = lds + (2 * pbuf) * TILEB;
        LAS unsigned char* BB = BA + TILEB;
#ifndef ATT_DUP
#define ATT_DUP 1
#endif
        _Pragma("nounroll") for (int dup_ = ATT_DUP - 1; dup_ >= 0; --dup_) { const float mref = mub + (dup_ ? 1000.f : 0.f); ATT_PAIR_FAST(BA, BB, t); }
        asm volatile("s_waitcnt vmcnt(0)" ::: "memory");
        __syncthreads();
    }
    } else {
    for (int t = tlo; t <= thi; t += 2) {
        const int pbuf = ((t - tlo) >> 1) & 1;
        if (t + 2 <= thi) { ATT_DMA(t + 2, 2 * (pbuf ^ 1)); ATT_DMA(t + 3, 2 * (pbuf ^ 1) + 1); }
        LAS unsigned char* BA = lds + (2 * pbuf) * TILEB;
        LAS unsigned char* BB = BA + TILEB;
        ATT_TILE(BA, t); ATT_TILE(BB, t + 1);
        asm volatile("s_waitcnt vmcnt(0)" ::: "memory");
        __syncthreads();
    }
    }
#undef ATT_DMA
#undef ATT_CINIT
#undef ATT_EXPPACK
#undef ATT_VRD
#undef ATT_WAITV
#undef ATT_PVM
#undef ATT_TILE
#undef ATT_TILE_FAST
#undef ATT_PAIR_FAST
#undef ATT_CINITH
#undef ATT_KLD
#undef ATT_QK
#undef ATT_VADDR
#undef ATT_SGB
#undef ATT_EXPPACK2
#undef ATT_SB
    int ln2 = tid_of(wave_u) & 63;
    const int r32e = ln2 & 31, hhe = ln2 >> 5;
    if (fast) l = l2.x + l2.y;
    l += __shfl_xor(l, 32);
    const float rl = 1.f / l;
    LAS float* X = (LAS float*)lds;
    if (c == 1) {
        const float f = rl * lam;
#pragma unroll
        for (int b = 0; b < 4; ++b)
#pragma unroll
            for (int r = 0; r < 16; ++r) X[(qs * 32 + r32e) * XS + 32 * b + crow(r, hhe)] = o[b][r] * f;
    }
    __syncthreads();
    if (c == 0) {
        float ss = 0.f;
#pragma unroll
        for (int b = 0; b < 4; ++b)
#pragma unroll
            for (int r = 0; r < 16; ++r) { const float v = o[b][r] * rl - X[(qs * 32 + r32e) * XS + 32 * b + crow(r, hhe)]; o[b][r] = v; ss += v * v; }
        ss += __shfl_xor(ss, 32);
        const float rn = (1.f - LAM_INIT) / sqrtf(ss * (1.f / 128.f) + 1e-5f);
        bf16* orow = MIX + (size_t)(row0 + q0 + r32e) * D + head * 128;
#pragma unroll
        for (int b = 0; b < 4; ++b)
#pragma unroll
            for (int rg = 0; rg < 4; ++rg) { const int d = 32 * b + 8 * rg + 4 * hhe; const f32x4 g4 = *(const f32x4*)(dng + d);
                u32x2 w; w.x = cvt_pk_bf16(o[b][4 * rg + 0] * rn * g4.x, o[b][4 * rg + 1] * rn * g4.y); w.y = cvt_pk_bf16(o[b][4 * rg + 2] * rn * g4.z, o[b][4 * rg + 3] * rn * g4.w);
                *(u32x2*)(orow + d) = w; }
    }
    __syncthreads();
}

__device__ __forceinline__ void attn_phase(const Params& p, const bf16* Hb, const bf16* KD, const bf16* VD, bf16* MIX, unsigned* ctl, LAS unsigned char* lds, int bid, int G, int wave_u) {
    float s1 = 0.f, s2 = 0.f;
    for (int i = 0; i < 64; ++i) { s1 += p.in[4][i] * p.in[5][i]; s2 += p.in[6][i] * p.in[7][i]; }
    const float lam = expf(s1) - expf(s2) + LAM_INIT;
    LAS int* slot = (LAS int*)(lds + L_CTL);
    const int myx = (int)(__builtin_amdgcn_s_getreg((3 << 11) | 20) & 7u);
    for (int rep = 0; rep < ATT_REPS; ++rep)
    for (int qi = 0; qi < 8; ++qi) {
      const int x = (myx + qi) & 7;
      for (;;) {
        if (tid_of(wave_u) == 0) *slot = (int)atomicAdd(ctl + CW_UNIT + x + 8 * rep, 1u);
        __syncthreads();
        const int j = __builtin_amdgcn_readfirstlane(*slot);
        __syncthreads();
        if (j >= 256) break;
        const int grp = j >> 5, i = j & 31;
        const bool prompt = (grp == 0) | (grp == 1) | (grp == 4) | (grp == 6);
        const int head = (grp == 0 || grp == 2) ? 3 : (grp == 1 || grp == 3) ? 2 : (grp == 4 || grp == 5) ? 1 : 0;
        int seq, qb, row0, S;
        if (prompt) { seq = x & 1; qb = i * 4 + (x >> 1); row0 = seq * S_P; S = S_P; }
        else { seq = 2 + x; qb = i; row0 = NPR + x * S_S; S = S_S; }
        const float kn0 = __uint_as_float(__hip_atomic_load(ctl + CW_KN + seq * 8 + head * 2, __ATOMIC_RELAXED, __HIP_MEMORY_SCOPE_AGENT));
        const float kn1 = __uint_as_float(__hip_atomic_load(ctl + CW_KN + seq * 8 + head * 2 + 1, __ATOMIC_RELAXED, __HIP_MEMORY_SCOPE_AGENT));
        attn_unit(Hb, KD, VD, MIX, row0, S, head, qb, lam, p.in[8], kn0, kn1, lds, wave_u);
      }
    }
}
}
namespace gla {
using att::crow; using att::vtr; using att::VSTR;
constexpr int L_LR = 0, L_B = 4096, L_TOT = 20480, L_BT = 22528, L_QT = 23040, L_KT = 32256, L_V = 41472, L_Z = 82432;
constexpr int L_V2 = 116224, L_LR2 = 136704;
constexpr int QSTR = 144, ZS = 132, SEGC = 16;
constexpr float LOG2E = 1.4426950408889634f, LN2 = 0.6931471805599453f;
__device__ __forceinline__ float bf2f(unsigned h) { return __uint_as_float(h << 16); }
__device__ __forceinline__ float fexp(float x) { return __builtin_amdgcn_exp2f(x * LOG2E); }

struct ChunkRegs { u32x4 v0, v1, q, k, lr; };
template <bool NEEDQ> __device__ __forceinline__ void chunk_load(ChunkRegs& R, const bf16* Hb, int rowbase, int head, int dir, int tid) {
    const int srow = tid >> 4, sch = tid & 15;
    const bf16* Vg = Hb + (size_t)(rowbase + srow) * LDH + O_GV + head * 128 + sch * 8;
    R.v0 = *(const u32x4*)Vg; R.v1 = *(const u32x4*)(Vg + (size_t)32 * LDH);
    const int pr = tid >> 3, dk0 = (tid & 7) * 8;
    R.k = *(const u32x4*)(Hb + (size_t)(rowbase + pr) * LDH + O_GK + head * 64 + dk0);
    if (NEEDQ) R.q = *(const u32x4*)(Hb + (size_t)(rowbase + pr) * LDH + O_GQ + head * 64 + dk0);
    if (tid < 128) R.lr = *(const u32x4*)(Hb + (size_t)(rowbase + (tid >> 1)) * LDH + O_LRF + dir * 16 + (tid & 1) * 8);
}
__device__ __forceinline__ void stage_vlr(const ChunkRegs& R, int buf, LAS unsigned char* lds, int tid) {
    LAS float* LR = (LAS float*)(lds + (buf ? L_LR2 : L_LR));
    { const int srow = tid >> 4, sch = tid & 15; LAS unsigned char* V = lds + (buf ? L_V2 : L_V);
      *(LAS u32x4*)(V + srow * VSTR + sch * 16) = R.v0; *(LAS u32x4*)(V + (srow + 32) * VSTR + sch * 16) = R.v1; }
    if (tid < 128) { const int tok = tid >> 1, hf = tid & 1;
#pragma unroll
        for (int i = 0; i < 4; ++i) { const unsigned ww = R.lr[i]; LR[tok * 16 + hf * 8 + 2 * i] = bf2f(ww & 0xffffu); LR[tok * 16 + hf * 8 + 2 * i + 1] = bf2f(ww >> 16); } }
}
template <bool NEEDQ> __device__ __forceinline__ float chunk_front(const ChunkRegs& C, const ChunkRegs& N, bool stage_next, int cur, int dir, const bf16x8& bhi, const bf16x8& blo, float biasd, LAS unsigned char* lds, int tid) {
    LAS float* LR = (LAS float*)(lds + (cur ? L_LR2 : L_LR)); LAS float* Bm = (LAS float*)(lds + L_B); LAS float* TOT = (LAS float*)(lds + L_TOT); LAS float* BT = (LAS float*)(lds + L_BT);
    const int d = tid & 63, grp = tid >> 6;
    if (grp < 4) { const int ln = tid & 63, r32_ = ln & 31, hh_ = ln >> 5, pblk = grp >> 1, dblk = grp & 1;
        const f32x4 a0 = *(const LAS f32x4*)(LR + (32 * pblk + r32_) * 16 + 8 * hh_), a1 = *(const LAS f32x4*)(LR + (32 * pblk + r32_) * 16 + 8 * hh_ + 4);
        u32x4 aw; aw.x = att::cvtpk_n(a0.x, a0.y); aw.y = att::cvtpk_n(a0.z, a0.w); aw.z = att::cvtpk_n(a1.x, a1.y); aw.w = att::cvtpk_n(a1.z, a1.w);
        f32x16 zc;
#pragma unroll
        for (int r = 0; r < 16; ++r) zc[r] = biasd;
        zc = __builtin_amdgcn_mfma_f32_32x32x16_bf16(__builtin_bit_cast(bf16x8, aw), bhi, zc, 0, 0, 0);
        zc = __builtin_amdgcn_mfma_f32_32x32x16_bf16(__builtin_bit_cast(bf16x8, aw), blo, zc, 0, 0, 0);
#pragma unroll
        for (int r = 0; r < 16; ++r) Bm[(32 * pblk + crow(r, hh_)) * 64 + 32 * dblk + r32_] = zc[r]; }
    __syncthreads();
    float la[8];
#pragma unroll
    for (int i = 0; i < 8; ++i) { const int p = grp * 8 + i; const float z = Bm[p * 64 + d];
        const float t = __builtin_amdgcn_exp2f(-fabsf(z) * LOG2E);
        la[i] = (fminf(z, 0.f) * LOG2E - __builtin_amdgcn_logf(1.f + t)) * (1.f / 16.f); }
    if (dir == 0) {
#pragma unroll
        for (int i = 1; i < 8; ++i) la[i] += la[i - 1];
        TOT[grp * 64 + d] = la[7];
    } else {
#pragma unroll
        for (int i = 6; i >= 0; --i) la[i] += la[i + 1];
        TOT[grp * 64 + d] = la[0];
    }
    __syncthreads();
    float pre = 0.f, tot = 0.f;
#pragma unroll
    for (int g = 0; g < 8; ++g) { const float tv = TOT[g * 64 + d]; tot += tv; if (dir == 0 ? (g < grp) : (g > grp)) pre += tv; }
#pragma unroll
    for (int i = 0; i < 8; ++i) Bm[(grp * 8 + i) * 64 + d] = la[i] + pre;
    if (grp == 0) BT[d] = __builtin_amdgcn_exp2f(tot);
    __syncthreads();
    { const int pr = tid >> 3, dk0 = (tid & 7) * 8;
      float qt[8], kt[8];
#pragma unroll
      for (int i = 0; i < 8; ++i) { const unsigned wk = C.k[i >> 1]; const float bb = Bm[pr * 64 + dk0 + i];
          kt[i] = bf2f((i & 1) ? (wk >> 16) : (wk & 0xffffu)) * __builtin_amdgcn_exp2f(-bb);
          if (NEEDQ) { const unsigned wq = C.q[i >> 1]; qt[i] = bf2f((i & 1) ? (wq >> 16) : (wq & 0xffffu)) * __builtin_amdgcn_exp2f(bb); } }
      u32x4 wk4; wk4.x = cvt_pk_bf16(kt[0], kt[1]); wk4.y = cvt_pk_bf16(kt[2], kt[3]); wk4.z = cvt_pk_bf16(kt[4], kt[5]); wk4.w = cvt_pk_bf16(kt[6], kt[7]);
      *(LAS u32x4*)(lds + L_KT + pr * QSTR + dk0 * 2) = wk4;
      if (NEEDQ) { u32x4 wq4; wq4.x = cvt_pk_bf16(qt[0], qt[1]); wq4.y = cvt_pk_bf16(qt[2], qt[3]); wq4.z = cvt_pk_bf16(qt[4], qt[5]); wq4.w = cvt_pk_bf16(qt[6], qt[7]);
          *(LAS u32x4*)(lds + L_QT + pr * QSTR + dk0 * 2) = wq4; } }
    if (stage_next) stage_vlr(N, cur ^ 1, lds, tid);
    __syncthreads();
    return tot;
}
__device__ __forceinline__ void state_update(f32x16& S, int mb, int nb, int LV, LAS unsigned char* lds, int hh, int q4, int pp4, int g1) {
#pragma unroll
    for (int s = 0; s < 4; ++s) {
        LAS unsigned char* kb = lds + L_KT + (16 * s + 8 * hh + q4) * QSTR + (32 * mb + 16 * g1 + 4 * pp4) * 2;
        LAS unsigned char* vb = lds + LV + (16 * s + 8 * hh + q4) * VSTR + (32 * nb + 16 * g1 + 4 * pp4) * 2;
        const s16x4 alo = vtr(kb), ahi = vtr(kb + 4 * QSTR), blo = vtr(vb), bhi = vtr(vb + 4 * VSTR);
        S = __builtin_amdgcn_mfma_f32_32x32x16_bf16((bf16x8){alo[0], alo[1], alo[2], alo[3], ahi[0], ahi[1], ahi[2], ahi[3]},
                                                    (bf16x8){blo[0], blo[1], blo[2], blo[3], bhi[0], bhi[1], bhi[2], bhi[3]}, S, 0, 0, 0);
    }
    LAS float* BT = (LAS float*)(lds + L_BT);
#pragma unroll
    for (int r = 0; r < 16; ++r) S[r] *= BT[32 * mb + crow(r, hh)];
}
__device__ __forceinline__ void load_gate_b(bf16x8& bhi, bf16x8& blo, float& biasd, const Params& p, int head, int dir, int tid) {
    const float* wa2 = dir ? p.in[11] : p.in[9]; const float* ba = dir ? p.in[12] : p.in[10];
    const int ln = tid & 63, r32_ = ln & 31, hh_ = ln >> 5, dblk = (tid >> 6) & 1, dcol = head * 64 + 32 * dblk + r32_;
    float wv[8], hf[8];
#pragma unroll
    for (int j = 0; j < 8; ++j) { wv[j] = wa2[(8 * hh_ + j) * 256 + dcol]; hf[j] = __uint_as_float(att::cvtpk_n(wv[j], 0.f) << 16); }
    u32x4 h4, l4;
    h4.x = att::cvtpk_n(hf[0], hf[1]); h4.y = att::cvtpk_n(hf[2], hf[3]); h4.z = att::cvtpk_n(hf[4], hf[5]); h4.w = att::cvtpk_n(hf[6], hf[7]);
    l4.x = att::cvtpk_n(wv[0] - hf[0], wv[1] - hf[1]); l4.y = att::cvtpk_n(wv[2] - hf[2], wv[3] - hf[3]); l4.z = att::cvtpk_n(wv[4] - hf[4], wv[5] - hf[5]); l4.w = att::cvtpk_n(wv[6] - hf[6], wv[7] - hf[7]);
    bhi = __builtin_bit_cast(bf16x8, h4); blo = __builtin_bit_cast(bf16x8, l4); biasd = ba[dcol];
}

__device__ __forceinline__ void passA(const Params& p, const bf16* Hb, float* SEG, float* LG, LAS unsigned char* lds, int bid, int G, int wave_u) {
    const int tid_l = tid_of(wave_u);
    const int tid = tid_l, lane = tid & 63, wid = __builtin_amdgcn_readfirstlane(tid >> 6), r32 = lane & 31, hh = lane >> 5;
    const int mb = wid >> 2, nb = wid & 3, q4 = (lane & 15) >> 2, pp4 = lane & 3, g1 = (lane >> 4) & 1;
    for (int si = bid; si < 512; si += G) {
        const int dir = si & 1, head = (si >> 1) & 3, sg = si >> 3;
        bf16x8 bhi, blo; float biasd; load_gate_b(bhi, blo, biasd, p, head, dir, tid);
        f32x16 S;
#pragma unroll
        for (int r = 0; r < 16; ++r) S[r] = 0.f;
        float lg = 0.f;
        ChunkRegs R;
        chunk_load<false>(R, Hb, (sg * SEGC + (dir ? SEGC - 1 : 0)) * 64, head, dir, tid);
        __syncthreads();
        stage_vlr(R, 0, lds, tid);
        __syncthreads();
        for (int n = 0; n < SEGC; ++n) {
            const ChunkRegs C = R; const int cur = n & 1;
            if (n + 1 < SEGC) chunk_load<false>(R, Hb, (sg * SEGC + (dir ? SEGC - 2 - n : n + 1)) * 64, head, dir, tid);
            lg += chunk_front<false>(C, R, n + 1 < SEGC, cur, dir, bhi, blo, biasd, lds, tid);
            state_update(S, mb, nb, cur ? L_V2 : L_V, lds, hh, q4, pp4, g1);
        }
        float* Up = SEG + (size_t)si * 8192;
#pragma unroll
        for (int r = 0; r < 16; ++r) Up[(32 * mb + crow(r, hh)) * 128 + 32 * nb + r32] = S[r];
        if (tid < 64) LG[si * 64 + tid] = lg;
    }
}
__device__ __forceinline__ void passB(float* SEG, const float* LG, int bid, int G, int wave_u) {
    const int tid_l = tid_of(wave_u);
    const int gt = bid * NTHREADS + tid_l, NTH = G * NTHREADS;
    for (int v = gt; v < 80 * 2048; v += NTH) {
        const int chain = v >> 11, e4 = v & 2047, dir = chain & 1, head = (chain >> 1) & 3, seq = chain >> 3;
        const int sg0 = seq < 2 ? seq * 16 : 32 + (seq - 2) * 4, ns = seq < 2 ? 16 : 4;
        f32x4 S = (f32x4){0.f, 0.f, 0.f, 0.f};
        for (int n = 0; n < ns; ++n) { const int si = ((sg0 + (dir ? ns - 1 - n : n)) * 4 + head) * 2 + dir;
            float* ptr = SEG + (size_t)si * 8192 + e4 * 4; const f32x4 u = *(const f32x4*)ptr; const float g = __builtin_amdgcn_exp2f(LG[si * 64 + (e4 >> 5)]);
            *(f32x4*)ptr = S; S = S * g + u; }
    }
}
__device__ __forceinline__ void passC(const Params& p, const bf16* Hb, const float* SEG, float* Z0, bf16* MIX, LAS unsigned char* lds, int bid, int G, int wave_u) {
    const int tid_l = tid_of(wave_u);
    const int tid = tid_l, lane = tid & 63, wid = __builtin_amdgcn_readfirstlane(tid >> 6), r32 = lane & 31, hh = lane >> 5;
    const int pb = wid >> 2, db = wid & 3, q4 = (lane & 15) >> 2, pp4 = lane & 3, g1 = (lane >> 4) & 1;
    for (int item = bid; item < 256; item += G) {
        const int head = item & 3, sg = item >> 2;
        for (int dir = 0; dir < 2; ++dir) {
            bf16x8 bhi, blo; float biasd; load_gate_b(bhi, blo, biasd, p, head, dir, tid);
            f32x16 S0, S1;
            { const float* Sp = SEG + (size_t)((sg * 4 + head) * 2 + dir) * 8192 + 32 * db + r32;
#pragma unroll
              for (int r = 0; r < 16; ++r) { S0[r] = Sp[crow(r, hh) * 128]; S1[r] = Sp[(32 + crow(r, hh)) * 128]; } }
            ChunkRegs R;
            chunk_load<true>(R, Hb, (sg * SEGC + (dir ? SEGC - 1 : 0)) * 64, head, dir, tid);
            __syncthreads();
            stage_vlr(R, 0, lds, tid);
            __syncthreads();
            for (int n = 0; n < SEGC; ++n) {
                const int rowbase = (sg * SEGC + (dir ? SEGC - 1 - n : n)) * 64;
                const ChunkRegs C = R; const int cur = n & 1; const int LV = cur ? L_V2 : L_V;
                if (n + 1 < SEGC) chunk_load<true>(R, Hb, (sg * SEGC + (dir ? SEGC - 2 - n : n + 1)) * 64, head, dir, tid);
                f32x16 Z;
                float* Zg = Z0 + (size_t)(rowbase + 32 * pb) * 512 + head * 128 + 32 * db + r32;
                if (dir == 0) {
#pragma unroll
                    for (int r = 0; r < 16; ++r) Z[r] = 0.f;
                } else {
#pragma unroll
                    for (int r = 0; r < 16; ++r) Z[r] = Zg[(size_t)crow(r, hh) * 512];
                }
                (void)chunk_front<true>(C, R, n + 1 < SEGC, cur, dir, bhi, blo, biasd, lds, tid);
                for (int mbp = 0; mbp < 2; ++mbp) {
                    if (dir == 0 ? (mbp > pb) : (mbp < pb)) continue;
                    f32x16 X;
#pragma unroll
                    for (int r = 0; r < 16; ++r) X[r] = 0.f;
#pragma unroll
                    for (int s = 0; s < 4; ++s) {
                        const bf16x8 a = *(LAS bf16x8*)(lds + L_KT + (32 * mbp + r32) * QSTR + (16 * s + 8 * hh) * 2);
                        const bf16x8 b = *(LAS bf16x8*)(lds + L_QT + (32 * pb + r32) * QSTR + (16 * s + 8 * hh) * 2);
                        X = __builtin_amdgcn_mfma_f32_32x32x16_bf16(a, b, X, 0, 0, 0);
                    }
#pragma unroll
                    for (int r = 0; r < 16; ++r) { const int pk = 32 * mbp + crow(r, hh), pq = 32 * pb + r32; const bool keep = dir == 0 ? (pk <= pq) : (pk >= pq); X[r] = keep ? X[r] : 0.f; }
#pragma unroll
                    for (int s2 = 0; s2 < 2; ++s2) {
                        u32x4 ww; ww.x = cvt_pk_bf16(X[8 * s2 + 0], X[8 * s2 + 1]); ww.y = cvt_pk_bf16(X[8 * s2 + 2], X[8 * s2 + 3]); ww.z = cvt_pk_bf16(X[8 * s2 + 4], X[8 * s2 + 5]); ww.w = cvt_pk_bf16(X[8 * s2 + 6], X[8 * s2 + 7]);
                        LAS unsigned char* vb = lds + LV + (32 * mbp + 16 * s2 + 4 * hh + q4) * VSTR + (32 * db + 16 * g1 + 4 * pp4) * 2;
                        const s16x4 lo = vtr(vb), hi = vtr(vb + 8 * VSTR);
                        Z = __builtin_amdgcn_mfma_f32_32x32x16_bf16(__builtin_bit_cast(bf16x8, ww), (bf16x8){lo[0], lo[1], lo[2], lo[3], hi[0], hi[1], hi[2], hi[3]}, Z, 0, 0, 0);
                    }
                }
#pragma unroll
                for (int mbs = 0; mbs < 2; ++mbs)
#pragma unroll
                    for (int s2 = 0; s2 < 2; ++s2) {
                        u32x4 ww;
                        if (mbs == 0) { ww.x = cvt_pk_bf16(S0[8 * s2 + 0], S0[8 * s2 + 1]); ww.y = cvt_pk_bf16(S0[8 * s2 + 2], S0[8 * s2 + 3]); ww.z = cvt_pk_bf16(S0[8 * s2 + 4], S0[8 * s2 + 5]); ww.w = cvt_pk_bf16(S0[8 * s2 + 6], S0[8 * s2 + 7]); }
                        else { ww.x = cvt_pk_bf16(S1[8 * s2 + 0], S1[8 * s2 + 1]); ww.y = cvt_pk_bf16(S1[8 * s2 + 2], S1[8 * s2 + 3]); ww.z = cvt_pk_bf16(S1[8 * s2 + 4], S1[8 * s2 + 5]); ww.w = cvt_pk_bf16(S1[8 * s2 + 6], S1[8 * s2 + 7]); }
                        LAS unsigned char* qa = lds + L_QT + (32 * pb + r32) * QSTR + (32 * mbs + 16 * s2 + 4 * hh) * 2;
                        const u32x2 alo = *(LAS u32x2*)qa, ahi = *(LAS u32x2*)(qa + 16);
                        const u32x4 aw = (u32x4){alo.x, alo.y, ahi.x, ahi.y};
                        Z = __builtin_amdgcn_mfma_f32_32x32x16_bf16(__builtin_bit_cast(bf16x8, aw), __builtin_bit_cast(bf16x8, ww), Z, 0, 0, 0);
                    }
                state_update(S0, 0, db, LV, lds, hh, q4, pp4, g1);
                state_update(S1, 1, db, LV, lds, hh, q4, pp4, g1);
                if (dir == 0) {
#pragma unroll
                    for (int r = 0; r < 16; ++r) Zg[(size_t)crow(r, hh) * 512] = Z[r];
                } else {
                    LAS float* Zl = (LAS float*)(lds + L_Z);
#pragma unroll
                    for (int r = 0; r < 16; ++r) Zl[(32 * pb + crow(r, hh)) * ZS + 32 * db + r32] = Z[r];
                    __syncthreads();
                    { const int pr = tid >> 3, dv0 = (tid & 7) * 16;
                      float v[16]; float ss = 0.f;
#pragma unroll
                      for (int i = 0; i < 16; ++i) { v[i] = Zl[pr * ZS + dv0 + i]; ss += v[i] * v[i]; }
                      ss += __shfl_xor(ss, 1); ss += __shfl_xor(ss, 2); ss += __shfl_xor(ss, 4);
                      const float rn = __builtin_amdgcn_rsqf(ss * (1.f / 128.f) + 1e-5f);
                      const bf16* grp_ = Hb + (size_t)(rowbase + pr) * LDH + O_GR + head * 128 + dv0;
                      const u32x4 g0 = *(const u32x4*)grp_, g1v = *(const u32x4*)(grp_ + 8);
                      const float* gn = p.in[13] + dv0;
                      float o[16];
#pragma unroll
                      for (int i = 0; i < 16; ++i) { const unsigned wv = (i < 8) ? g0[i >> 1] : g1v[(i - 8) >> 1]; const float gr = bf2f((i & 1) ? (wv >> 16) : (wv & 0xffffu));
                          const float sl = gr * __builtin_amdgcn_rcpf(1.f + fexp(-gr)); o[i] = v[i] * rn * gn[i] * sl; }
                      u32x4 a, b; a.x = cvt_pk_bf16(o[0], o[1]); a.y = cvt_pk_bf16(o[2], o[3]); a.z = cvt_pk_bf16(o[4], o[5]); a.w = cvt_pk_bf16(o[6], o[7]);
                      b.x = cvt_pk_bf16(o[8], o[9]); b.y = cvt_pk_bf16(o[10], o[11]); b.z = cvt_pk_bf16(o[12], o[13]); b.w = cvt_pk_bf16(o[14], o[15]);
                      bf16* orow = MIX + (size_t)(rowbase + pr) * D + 512 + head * 128 + dv0;
                      *(u32x4*)orow = a; *(u32x4*)(orow + 8) = b; }
                }
            }
        }
    }
}
}
__global__ void __launch_bounds__(NTHREADS) mega(Params p) {
    extern __shared__ __attribute__((aligned(16))) unsigned char lds_raw[];
    LAS unsigned char* lds = (LAS unsigned char*)lds_raw;
    cg::grid_group grid = cg::this_grid();
    const int tid = threadIdx.x, lane = tid & 63, wave = __builtin_amdgcn_readfirstlane(tid >> 6);
    const int G = gridDim.x, bid = blockIdx.x;
    unsigned char* ws = p.ws;
    bf16* WTin = (bf16*)(ws + WS_WIN); bf16* WTo = (bf16*)(ws + WS_WO); bf16* WT1 = (bf16*)(ws + WS_W1); bf16* WT2 = (bf16*)(ws + WS_W2);
    bf16* Hb = (bf16*)(ws + WS_H); bf16* XB = (bf16*)(ws + WS_XB); bf16* MIX = (bf16*)(ws + WS_MIX); bf16* X1B = (bf16*)(ws + WS_X1B); bf16* HID = (bf16*)(ws + WS_HID);
    float* ST = (float*)(ws + WS_ST); float* SEG = (float*)(ws + WS_ST + 128 * MiB); float* LG = (float*)(ws + WS_GG);
    unsigned* ctl = (unsigned*)(ws + WS_CTL);
    bf16* Y1B = (bf16*)p.out;
    bf16* Y2B = (bf16*)(ws + WS_MIX);
    bf16* KD = (bf16*)(ws + WS_KD); bf16* VD = (bf16*)(ws + WS_VD);
    const int lo = p.ph_lo, hi = p.ph_hi;
    volatile LAS unsigned* xst = (volatile LAS unsigned*)(lds + 160 * 1024 - 128);
    if (tid < 2) xst[tid] = 0u;
    __syncthreads();
    const XcdBarrier xbar = xcd_barrier_post(ctl + 1024, xst, wave);
    if (hi > 1000) grid.sync();
#ifndef R_P0
#define R_P0 1
#endif
#ifndef R_G1
#define R_G1 1
#endif
#ifndef R_G2
#define R_G2 1
#endif
#define IN(k) (lo <= (k) && (k) < hi)
#define SEAM(k) do { if (IN(k) && IN((k) + 1)) { xcd_barrier(xbar); } } while (0)
    const int gw = bid * NWAVES + wave, NGW = G * NWAVES;

for (int rp_ = 0; rp_ < R_P0; ++rp_) {     if (IN(0)) {
        if (bid == 0 && tid < 256) ctl[tid] = 0u;
        LAS float* scr = (LAS float*)(lds + wave * 16384);
        constexpr int I_IN = (D / 64) * (DIN / 32), I_O = (D / 64) * (D / 32), I_1 = (D / 64) * (FF / 32), I_2 = (FF / 64) * (D / 32);
        constexpr int NITEMS = I_IN + I_O + I_1 + I_2;
        for (int it = gw; it < NITEMS; it += NGW) {
            int r = it;
            if (r < I_IN) { p0_transpose_item(p.in[2], D, DIN, WTin, scr, r, lane); continue; } r -= I_IN;
            if (r < I_O) { p0_transpose_item(p.in[3], D, D, WTo, scr, r, lane); continue; } r -= I_O;
            if (r < I_1) { p0_transpose_item(p.in[16], D, FF, WT1, scr, r, lane); continue; } r -= I_1;
            p0_transpose_item(p.in[17], FF, D, WT2, scr, r, lane);
        }
        { u32x4* z = (u32x4*)(WTin + (size_t)DIN * D); const int nz = (DIN_PAD - DIN) * D * 2 / 16;
          for (int i = bid * NTHREADS + tid; i < nz; i += G * NTHREADS) z[i] = (u32x4){0u, 0u, 0u, 0u}; }
        { const int ln0 = tid_of(wave) & 63;
        for (int m = gw * 2; m < M; m += NGW * 2) {
            f32x4 v[2][4];
#pragma unroll
            for (int r = 0; r < 2; ++r) { const f32x4* xr = (const f32x4*)xrow_ptr(p, m + r) + ln0;
#pragma unroll
                for (int j = 0; j < 4; ++j) v[r][j] = __builtin_nontemporal_load(xr + 64 * j); }
#pragma unroll
            for (int r = 0; r < 2; ++r) { u32x2* o = (u32x2*)(XB + (size_t)(m + r) * D) + ln0;
#pragma unroll
                for (int j = 0; j < 4; ++j) { u32x2 w; w.x = cvt_pk_bf16(v[r][j].x, v[r][j].y); w.y = cvt_pk_bf16(v[r][j].z, v[r][j].w); o[64 * j] = w; } }
        } }
#if MIXER_STAGE < 1
        { u32x4* z = (u32x4*)MIX; const size_t nz = (size_t)M * D * 2 / 16;
          for (size_t i = (size_t)bid * NTHREADS + tid; i < nz; i += (size_t)G * NTHREADS) z[i] = (u32x4){0u, 0u, 0u, 0u}; }
#endif
    } }
    SEAM(0);
for (int rp_ = 0; rp_ < R_G1; ++rp_) {     if (IN(1)) {
#if MIXER_STAGE >= 1
        pg8::Gemm g{XB, WTin, M, DIN_PAD, D}; pg8::StaticOrder S; S.init(M, DIN_PAD, G, bid);
        pg8::EpiH E{Hb, LDH, DIN, C1, KD, VD};
        pg8::gemm_phase<pg8::EpiH, pg8::StaticOrder, true, true>(lds, g, S, E, wave);
#endif
    } }
    SEAM(1);
#ifndef GLA_REPS
#define GLA_REPS 1
#endif
#ifndef ATT_REPS
#define ATT_REPS 1
#endif
    for (int rep = 0; rep < GLA_REPS; ++rep) {
    if (IN(2)) {
#if MIXER_STAGE >= 1
        if (rep == 0) att::knorm_phase(KD, ctl, bid, G, wave);
#endif
#if MIXER_STAGE >= 2
        gla::passA(p, Hb, SEG, LG, lds, bid, G, wave);
#endif
    }
    SEAM(2);
    if (IN(3)) {
#if MIXER_STAGE >= 2
        gla::passB(SEG, LG, bid, G, wave);
#endif
    }
    SEAM(3);
    }
    if (IN(4)) {
#if MIXER_STAGE >= 2
        for (int rep = 0; rep < GLA_REPS; ++rep) gla::passC(p, Hb, SEG, ST, MIX, lds, bid, G, wave);
#endif
#if MIXER_STAGE >= 1
        att::attn_phase(p, Hb, KD, VD, MIX, ctl, lds, bid, G, wave);
#endif
    }
    SEAM(4);
for (int rp_ = 0; rp_ < R_G1; ++rp_) {     if (IN(5)) {
        pg8::Gemm g{MIX, WTo, M, D, D}; pg8::StaticOrder S; S.init(M, D, G, bid);
        pg8::EpiResB E{nullptr, nullptr, XB, Y1B, ALPHA, false};
        pg8::gemm_phase<pg8::EpiResB, pg8::StaticOrder, true, true>(lds, g, S, E, wave);
    } }
    SEAM(5);
for (int rp_ = 0; rp_ < R_P0; ++rp_) {     if (IN(6)) { const int ln_ = tid_of(wave) & 63; for (int m = gw * 4; m < M; m += NGW * 4) ln_rows4_b(Y1B + (size_t)m * D, nullptr, X1B + (size_t)m * D, p.in[14], p.in[15], ln_); } }
    SEAM(6);
for (int rp_ = 0; rp_ < R_G2; ++rp_) {     if (IN(7)) {
        pg8::Gemm g{X1B, WT1, M, FF, D}; pg8::StaticOrder S; S.init(M, FF, G, bid);
        pg8::EpiHid E{HID, FF};
        pg8::gemm_phase<pg8::EpiHid, pg8::StaticOrder, true, true>(lds, g, S, E, wave);
    } }
    SEAM(7);
for (int rp_ = 0; rp_ < R_G2; ++rp_) {     if (IN(8)) {
        pg8::Gemm g{HID, WT2, M, D, FF}; pg8::StaticOrder S; S.init(M, D, G, bid);
        pg8::EpiResB E{nullptr, nullptr, X1B, Y2B, ALPHA, true};
        pg8::gemm_phase<pg8::EpiResB, pg8::StaticOrder, true, true>(lds, g, S, E, wave);
    } }
    SEAM(8);
for (int rp_ = 0; rp_ < R_P0; ++rp_) {     if (IN(9)) { const int ln_ = tid_of(wave) & 63; for (int m = gw * 4; m < M; m += NGW * 4) ln_rows4_b(Y2B + (size_t)m * D, p.out + (size_t)m * D, nullptr, p.in[18], p.in[19], ln_); } }
#undef IN
#undef SEAM
}

extern "C" void kernel_launch(void* const* d_in, const int* in_sizes, int n_in, void* d_out, int out_size,
                              void* d_ws, size_t ws_size, hipStream_t stream) {
    static int grid = 0;
    if (grid == 0) {
        if (n_in != 20 || out_size != M * D || ws_size < WS_END) { fprintf(stderr, "kernel_launch: unexpected shapes (n_in %d out %d ws %zu)\n", n_in, out_size, ws_size); grid = -1; return; }
        int dev = 0, cus = 0, per_cu = 0;
        (void)hipGetDevice(&dev);
        (void)hipDeviceGetAttribute(&cus, hipDeviceAttributeMultiprocessorCount, dev);
        (void)hipFuncSetAttribute((const void*)mega, hipFuncAttributeMaxDynamicSharedMemorySize, LDS_BYTES);
        (void)hipOccupancyMaxActiveBlocksPerMultiprocessor(&per_cu, (const void*)mega, NTHREADS, LDS_BYTES);
        (void)hipGetLastError();
        grid = cus;
        fprintf(stderr, "kernel_launch: grid %d (cus %d, occupancy query %d/CU), ws %zu\n", grid, cus, per_cu, ws_size);
    }
    if (grid < 0) return;
    (void)hipMemsetAsync(d_ws, 0, 65536, stream);
    Params p{};
    for (int i = 0; i < 20; ++i) p.in[i] = (const float*)d_in[i];
    p.out = (float*)d_out; p.ws = (unsigned char*)d_ws; p.ph_lo = 0; p.ph_hi = 10;
    void* args[] = {&p};
    hipError_t e = hipLaunchCooperativeKernel((const void*)mega, dim3(grid), dim3(NTHREADS), args, LDS_BYTES, stream);
    if (e != hipSuccess) fprintf(stderr, "cooperative launch failed: %s\n", hipGetErrorString(e));
}
```

```cpp
#include <hip/hip_runtime.h>
#include <hip/hip_cooperative_groups.h>
#include <cstdio>
#include <cstdint>
namespace cg = cooperative_groups;
__device__ __forceinline__ int tid_of(int wave_u) { int t; asm volatile("v_mbcnt_lo_u32_b32 %0, -1, 0\n\tv_mbcnt_hi_u32_b32 %0, -1, %0" : "=v"(t)); return t | (wave_u << 6); }
#define MIXER_STAGE 2
namespace pg8 {
#define PG8_LAS __attribute__((address_space(3)))
typedef unsigned short bf16_t;
typedef short bf16x8 __attribute__((ext_vector_type(8)));
typedef float f32x4 __attribute__((ext_vector_type(4)));
typedef unsigned u32x4 __attribute__((ext_vector_type(4)));
constexpr int BM = 256, BK = 64, HALF = 128, HTB = HALF * BK * 2  , STAGE_BYTES = 8 * HTB, NXCD = 8, WGM = 8;

__host__ __device__ __forceinline__ int lds_byte(int r, int c) { const int st = (r >> 4) * 2 + (c >> 5), rr = r & 15, cc = c & 31, ob = rr * 64 + cc * 2; return st * 1024 + (ob ^ (((ob >> 9) & 1) << 5)); }
__host__ __device__ __forceinline__ void stage_rc(int b, int& R, int& C) { const int st = b / 1024, sb = b % 1024, swz = sb ^ (((sb >> 9) & 1) << 5); R = (st >> 1) * 16 + swz / 64; C = (st & 1) * 32 + (swz % 64) / 2; }
__host__ __device__ __forceinline__ int perm32(int rho) { const int n = rho >> 4, i = rho & 15; return 8 * (i >> 2) + 4 * n + (i & 3); }

struct Unit { int pm, pn; };
struct Gemm { const bf16_t* A; const bf16_t* Bt; int M, N, K; };

struct StaticOrder {
    int nM, nN, nwg, G, c;
    __host__ __device__ void init(int M, int N, int G_, int c_) { nM = M / BM; nN = N / BM; nwg = nM * nN; G = G_; c = c_; }
    __host__ __device__ bool next(int i, Unit& u) const {
        const long L = (long)i * G + c; if (L >= nwg) return false;
        int wgid = (int)L; { const int q = nwg / NXCD, r = nwg % NXCD, xcd = wgid % NXCD, off = wgid / NXCD; wgid = (xcd < r ? xcd * (q + 1) : r * (q + 1) + (xcd - r) * q) + off; }
        const int nig = WGM * nN, gid = wgid / nig, fm = gid * WGM, gsz = (nM - fm) < WGM ? (nM - fm) : WGM;
        u.pm = fm + ((wgid % nig) % gsz); u.pn = (wgid % nig) / gsz; return true;
    }
    __device__ __forceinline__ void a_ready(const Unit&) const {}
    __device__ __forceinline__ void done(const Unit&) const {}
};

__device__ __forceinline__ unsigned cvt_pk_bf16(float lo, float hi) { unsigned r; asm volatile("v_cvt_pk_bf16_f32 %0, %1, %2" : "=v"(r) : "v"(lo), "v"(hi)); return r; }
constexpr int M_TOK = 65536, NPROMPT = 32768, DMODEL = 1024;
struct EpiH {
    static constexpr bool PERM = true, AFTER_DRAIN = false;
    bf16_t* O; int ldc; int nvalid; float c1; bf16_t* KD; bf16_t* VD;
    __device__ __forceinline__ void operator()(const f32x4 (&acc)[2][2][4][2], const Unit& u, int wr, int wc, int fr, int fq) const {
        const int row0 = u.pm * BM + wr * 64 + fr;
        const int col0 = u.pn * BM + wc * 32 + 8 * fq;
        const float sc = (u.pn < 2) ? c1 : (u.pn == 6 ? 0.125f : 1.0f);
        const bool dense = (u.pn >= 2) && (u.pn < 6);
        bf16_t* db = (u.pn < 4) ? KD : VD;
        const int crel = col0 - ((u.pn < 4) ? 512 : 1024);
#pragma unroll
        for (int ai = 0; ai < 2; ++ai)
#pragma unroll
            for (int m = 0; m < 4; ++m) { const int row = row0 + ai * HALF + m * 16; bf16_t* rowp = O + (size_t)row * ldc + col0;
#pragma unroll
                for (int bj = 0; bj < 2; ++bj) { if (col0 + bj * HALF < nvalid) { const f32x4 v0 = acc[ai][bj][m][0] * sc, v1 = acc[ai][bj][m][1] * sc;
                    u32x4 w; w.x = cvt_pk_bf16(v0[0], v0[1]); w.y = cvt_pk_bf16(v0[2], v0[3]); w.z = cvt_pk_bf16(v1[0], v1[1]); w.w = cvt_pk_bf16(v1[2], v1[3]);
                    if (dense) { const int cr = crel + bj * HALF; __builtin_nontemporal_store(w, (u32x4*)(db + ((size_t)(cr >> 7) * M_TOK + row) * 128 + (cr & 127))); }
                    else __builtin_nontemporal_store(w, (u32x4*)(rowp + bj * HALF)); } } }
    }
};
struct EpiHid {
    static constexpr bool PERM = true, AFTER_DRAIN = false;
    bf16_t* O; int ldc;
    __device__ __forceinline__ void operator()(const f32x4 (&acc)[2][2][4][2], const Unit& u, int wr, int wc, int fr, int fq) const {
        const int row0 = u.pm * BM + wr * 64 + fr;
        const int col0 = u.pn * BM + wc * 32 + 8 * fq;
#pragma unroll
        for (int ai = 0; ai < 2; ++ai)
#pragma unroll
            for (int m = 0; m < 4; ++m) { bf16_t* rowp = O + (size_t)(row0 + ai * HALF + m * 16) * ldc + col0;
#pragma unroll
                for (int bj = 0; bj < 2; ++bj) { f32x4 v0 = acc[ai][bj][m][0], v1 = acc[ai][bj][m][1];
#pragma unroll
                    for (int e = 0; e < 4; ++e) { const float a = fmaxf(v0[e], 0.f), b = fmaxf(v1[e], 0.f); v0[e] = a * a; v1[e] = b * b; }
                    u32x4 w; w.x = cvt_pk_bf16(v0[0], v0[1]); w.y = cvt_pk_bf16(v0[2], v0[3]); w.z = cvt_pk_bf16(v1[0], v1[1]); w.w = cvt_pk_bf16(v1[2], v1[3]);
                    __builtin_nontemporal_store(w, (u32x4*)(rowp + bj * HALF)); } }
    }
};
struct EpiRes {
    static constexpr bool PERM = false, AFTER_DRAIN = false;
    const float* xp; const float* xs; float* out; float alpha;
    __device__ __forceinline__ void operator()(const f32x4 (&acc)[2][2][4][2], const Unit& u, int wr, int wc, int fr, int fq) const {
        const int col0 = u.pn * BM + wc * 32 + 4 * fq;
#pragma unroll
        for (int ai = 0; ai < 2; ++ai)
#pragma unroll
            for (int m = 0; m < 4; ++m) { const int row = u.pm * BM + ai * HALF + wr * 64 + m * 16 + fr;
                float* orow = out + (size_t)row * DMODEL;
                const float* xr = xp ? ((row < NPROMPT) ? xp + (size_t)row * DMODEL : xs + (size_t)(row - NPROMPT) * DMODEL) : orow;
#pragma unroll
                for (int bj = 0; bj < 2; ++bj)
#pragma unroll
                    for (int n = 0; n < 2; ++n) { const int c = col0 + bj * HALF + n * 16; const f32x4 xv = *(const f32x4*)(xr + c); *(f32x4*)(orow + c) = xv * alpha + acc[ai][bj][m][n]; } }
    }
};


struct EpiResB {
    static constexpr bool PERM = true, AFTER_DRAIN = false;
    const float* xp; const float* xs; const bf16_t* RB; bf16_t* Y; float alpha; bool nt_out;
    __device__ __forceinline__ void operator()(const f32x4 (&acc)[2][2][4][2], const Unit& u, int wr, int wc, int fr, int fq) const {
        const int col0 = u.pn * BM + wc * 32 + 8 * fq;
#pragma unroll
        for (int ai = 0; ai < 2; ++ai)
#pragma unroll
            for (int m = 0; m < 4; ++m) { const int row = u.pm * BM + ai * HALF + wr * 64 + m * 16 + fr;
#pragma unroll
                for (int bj = 0; bj < 2; ++bj) { const int c = col0 + bj * HALF;
                    f32x4 r0, r1;
                    if (xp) { const float* xr = ((row < NPROMPT) ? xp + (size_t)row * DMODEL : xs + (size_t)(row - NPROMPT) * DMODEL) + c; r0 = *(const f32x4*)xr; r1 = *(const f32x4*)(xr + 4); }
                    else { const u32x4 w = *(const u32x4*)(RB + (size_t)row * DMODEL + c);
                        r0 = (f32x4){__uint_as_float(w.x << 16), __uint_as_float(w.x & 0xffff0000u), __uint_as_float(w.y << 16), __uint_as_float(w.y & 0xffff0000u)};
                        r1 = (f32x4){__uint_as_float(w.z << 16), __uint_as_float(w.z & 0xffff0000u), __uint_as_float(w.w << 16), __uint_as_float(w.w & 0xffff0000u)}; }
                    const f32x4 v0 = r0 * alpha + acc[ai][bj][m][0], v1 = r1 * alpha + acc[ai][bj][m][1];
                    u32x4 o; o.x = cvt_pk_bf16(v0[0], v0[1]); o.y = cvt_pk_bf16(v0[2], v0[3]); o.z = cvt_pk_bf16(v1[0], v1[1]); o.w = cvt_pk_bf16(v1[2], v1[3]);
                    if (nt_out) __builtin_nontemporal_store(o, (u32x4*)(Y + (size_t)row * DMODEL + c)); else *(u32x4*)(Y + (size_t)row * DMODEL + c) = o; } }
    }
};

template <class Epi, class Sched, bool ALIGN_EPI = false, bool SP2 = false>
__device__ __forceinline__ void gemm_phase(PG8_LAS unsigned char* lds, const Gemm g, const Sched& S, const Epi& E, int wave_u) {
    const int tid_l = tid_of(wave_u);
    const int tid = tid_l, wid = __builtin_amdgcn_readfirstlane(tid >> 6), lane = tid & 63, wr = wid >> 2, wc = wid & 3, fr = lane & 15, fq = lane >> 4;
    const int K = g.K, nt = K / BK;
    unsigned voffA[2], voffB[2];
#pragma unroll
    for (int i = 0; i < 2; ++i) { int R, C; stage_rc(tid * 16 + i * 8192, R, C); const int Rb = Epi::PERM ? ((R & ~31) + perm32(R & 31)) : R;
        voffA[i] = (unsigned)(R * K + C) * 2u; voffB[i] = (unsigned)(Rb * K + C) * 2u; }
    const size_t kstep = (size_t)(BK * 2);
    const size_t hstep = (size_t)HALF * K * 2;
    const size_t tstep = 2 * hstep;
    const unsigned ldsw = (unsigned)wid * 1024u;
    const int aoff = lds_byte(wr * 64 + fr, fq * 8), boff = lds_byte(wc * 32 + fr, fq * 8);
#define PG8_SA(b, h) (((b) * 2 + (h)) * HTB)
#define PG8_SB(b, h) ((4 + (b) * 2 + (h)) * HTB)
#define PG8_STAGE(bufoff, gbase, voff) do { _Pragma("unroll") for (int _i = 0; _i < 2; ++_i) \
        __builtin_amdgcn_global_load_lds((const unsigned*)((const char*)(gbase) + (voff)[_i]), (PG8_LAS unsigned*)(lds + (bufoff) + ldsw + _i * 8192), 16, 0, 0); } while (0)
#define PG8_LDA(dst, b, h) do { _Pragma("unroll") for (int m = 0; m < 4; ++m) _Pragma("unroll") for (int k = 0; k < 2; ++k) dst[m][k] = *(const PG8_LAS bf16x8*)(lds + PG8_SA(b, h) + aoff + m * 2048 + k * 1024); } while (0)
#define PG8_LDB(dst, b, h) do { _Pragma("unroll") for (int n = 0; n < 2; ++n) _Pragma("unroll") for (int k = 0; k < 2; ++k) dst[n][k] = *(const PG8_LAS bf16x8*)(lds + PG8_SB(b, h) + boff + n * 2048 + k * 1024); } while (0)
#define PG8_MMA(ai, bj, At, Bt) do { __builtin_amdgcn_s_setprio(1); _Pragma("unroll") for (int m = 0; m < 4; ++m) _Pragma("unroll") for (int n = 0; n < 2; ++n) _Pragma("unroll") for (int k = 0; k < 2; ++k) \
        acc[ai][bj][m][n] = __builtin_amdgcn_mfma_f32_16x16x32_bf16(Bt[n][k], At[m][k], acc[ai][bj][m][n], 0, 0, 0); __builtin_amdgcn_s_setprio(0); } while (0)
#define PG8_WAIT_V(n) asm volatile("s_waitcnt vmcnt(" #n ")" ::: "memory")
#define PG8_WAIT_L(n) asm volatile("s_waitcnt lgkmcnt(" #n ")" ::: "memory")
#define PG8_BAR __builtin_amdgcn_s_barrier()
#define PG8_SCHED __builtin_amdgcn_sched_barrier(0)
    Unit cur, nxt; int ui = 0;
    if (!S.next(0, cur)) return;
    f32x4 acc[2][2][4][2];
#pragma unroll
    for (int a = 0; a < 2; ++a)
#pragma unroll
        for (int b = 0; b < 2; ++b)
#pragma unroll
            for (int m = 0; m < 4; ++m)
#pragma unroll
                for (int n = 0; n < 2; ++n) acc[a][b][m][n] = (f32x4){0.f, 0.f, 0.f, 0.f};
    bf16x8 At[4][2], B0[2][2], B1[2][2];
    const char* cA = (const char*)g.A + (size_t)cur.pm * tstep; const char* cB = (const char*)g.Bt + (size_t)cur.pn * tstep;
    S.a_ready(cur);
    if constexpr (SP2) {
        PG8_STAGE(PG8_SB(0, 0), cB, voffB); PG8_STAGE(PG8_SB(0, 1), cB + hstep, voffB); PG8_STAGE(PG8_SA(0, 0), cA, voffA); PG8_STAGE(PG8_SA(0, 1), cA + hstep, voffA);
        if (wr == 1) PG8_BAR;
        PG8_WAIT_V(2); PG8_BAR;
        PG8_STAGE(PG8_SB(1, 0), cB + kstep, voffB); PG8_STAGE(PG8_SA(1, 0), cA + kstep, voffA); PG8_STAGE(PG8_SB(1, 1), cB + hstep + kstep, voffB);
        PG8_WAIT_V(6); PG8_BAR;
    } else {
        PG8_STAGE(PG8_SB(0, 0), cB, voffB); PG8_STAGE(PG8_SA(0, 0), cA, voffA); PG8_STAGE(PG8_SB(0, 1), cB + hstep, voffB); PG8_STAGE(PG8_SA(0, 1), cA + hstep, voffA);
        if (wr == 1) PG8_BAR;
        PG8_WAIT_V(4); PG8_BAR;
        PG8_STAGE(PG8_SB(1, 0), cB + kstep, voffB); PG8_STAGE(PG8_SA(1, 0), cA + kstep, voffA); PG8_STAGE(PG8_SB(1, 1), cB + hstep + kstep, voffB);
        PG8_WAIT_V(6); PG8_BAR;
    }
    for (;;) {
        const bool has_next = S.next(ui + 1, nxt);
        const char* nA = has_next ? (const char*)g.A + (size_t)nxt.pm * tstep : cA; const char* nB = has_next ? (const char*)g.Bt + (size_t)nxt.pn * tstep : cB;
        for (int t = 0; t < nt; t += 2) {
            const bool last = (t == nt - 2);
            const char* a1 = cA + (size_t)(t + 1) * kstep;
            const char* a2 = last ? nA : cA + (size_t)(t + 2) * kstep; const char* b2 = last ? nB : cB + (size_t)(t + 2) * kstep;
            const char* a3 = a2 + kstep; const char* b3 = b2 + kstep;
            if (last && has_next) S.a_ready(nxt);
            if constexpr (SP2) {
            PG8_LDB(B0, 0, 0); PG8_LDB(B1, 0, 1); PG8_SCHED; PG8_LDA(At, 0, 0); PG8_STAGE(PG8_SA(1, 1), a1 + hstep, voffA);
            PG8_WAIT_V(8); PG8_WAIT_L(0); PG8_BAR; PG8_MMA(0, 0, At, B0); PG8_MMA(0, 1, At, B1); PG8_BAR; PG8_SCHED;
            PG8_LDA(At, 0, 1); PG8_STAGE(PG8_SB(0, 0), b2, voffB); PG8_STAGE(PG8_SB(0, 1), b2 + hstep, voffB); PG8_STAGE(PG8_SA(0, 0), a2, voffA);
            PG8_WAIT_V(8); PG8_WAIT_L(0); PG8_BAR; PG8_MMA(1, 0, At, B0); PG8_MMA(1, 1, At, B1); PG8_BAR; PG8_SCHED;
            PG8_LDB(B0, 1, 0); PG8_LDB(B1, 1, 1); PG8_SCHED; PG8_LDA(At, 1, 0); PG8_STAGE(PG8_SA(0, 1), a2 + hstep, voffA);
            PG8_WAIT_V(8); PG8_WAIT_L(0); PG8_BAR; PG8_MMA(0, 0, At, B0); PG8_MMA(0, 1, At, B1); PG8_BAR; PG8_SCHED;
            PG8_LDA(At, 1, 1); PG8_STAGE(PG8_SB(1, 0), b3, voffB); PG8_STAGE(PG8_SB(1, 1), b3 + hstep, voffB); PG8_STAGE(PG8_SA(1, 0), a3, voffA);
            PG8_WAIT_V(8); PG8_WAIT_L(0); PG8_BAR; PG8_MMA(1, 0, At, B0); PG8_MMA(1, 1, At, B1); PG8_BAR; PG8_SCHED;
            } else {
            PG8_LDB(B0, 0, 0); PG8_SCHED; PG8_LDA(At, 0, 0); PG8_STAGE(PG8_SA(1, 1), a1 + hstep, voffA);
            PG8_WAIT_L(8); PG8_BAR; PG8_WAIT_L(0); PG8_MMA(0, 0, At, B0); PG8_BAR; PG8_SCHED;
            PG8_LDB(B1, 0, 1); PG8_STAGE(PG8_SB(0, 0), b2, voffB);
            PG8_BAR; PG8_WAIT_L(0); PG8_MMA(0, 1, At, B1); PG8_BAR;
            PG8_LDA(At, 0, 1); PG8_STAGE(PG8_SA(0, 0), a2, voffA);
            PG8_BAR; PG8_WAIT_L(0); PG8_MMA(1, 0, At, B0); PG8_BAR; PG8_SCHED;
            PG8_STAGE(PG8_SB(0, 1), b2 + hstep, voffB);
            PG8_WAIT_V(6); PG8_BAR; PG8_MMA(1, 1, At, B1); PG8_BAR;
            PG8_LDB(B0, 1, 0); PG8_SCHED; PG8_LDA(At, 1, 0); PG8_STAGE(PG8_SA(0, 1), a2 + hstep, voffA);
            PG8_WAIT_L(8); PG8_BAR; PG8_WAIT_L(0); PG8_MMA(0, 0, At, B0); PG8_BAR; PG8_SCHED;
            PG8_LDB(B1, 1, 1); PG8_STAGE(PG8_SB(1, 0), b3, voffB);
            PG8_BAR; PG8_WAIT_L(0); PG8_MMA(0, 1, At, B1); PG8_BAR;
            PG8_LDA(At, 1, 1); PG8_STAGE(PG8_SA(1, 0), a3, voffA);
            PG8_BAR; PG8_WAIT_L(0); PG8_MMA(1, 0, At, B0); PG8_BAR; PG8_SCHED;
            PG8_STAGE(PG8_SB(1, 1), b3 + hstep, voffB);
            PG8_WAIT_V(6); PG8_BAR; PG8_MMA(1, 1, At, B1); PG8_BAR;
            }
        }
        if constexpr (ALIGN_EPI) { if (wr == 0) PG8_BAR; }
        if constexpr (!Epi::AFTER_DRAIN) { E(acc, cur, wr, wc, fr, fq); S.done(cur); }
        if (!has_next) break;
#pragma unroll
        for (int a = 0; a < 2; ++a)
#pragma unroll
            for (int b = 0; b < 2; ++b)
#pragma unroll
                for (int m = 0; m < 4; ++m)
#pragma unroll
                    for (int n = 0; n < 2; ++n) acc[a][b][m][n] = (f32x4){0.f, 0.f, 0.f, 0.f};
        cur = nxt; cA = nA; cB = nB; ++ui;
        if constexpr (ALIGN_EPI) { if (wr == 1) PG8_BAR; }
    }
    PG8_WAIT_V(0);
    if constexpr (!ALIGN_EPI) { if (wr == 0) PG8_BAR; }
    PG8_BAR;
    if constexpr (Epi::AFTER_DRAIN) { E.fused(acc, cur, wr, wc, fr, fq, lds, wid, lane); S.done(cur); }
#undef PG8_SA
#undef PG8_SB
#undef PG8_STAGE
#undef PG8_LDA
#undef PG8_LDB
#undef PG8_MMA
#undef PG8_WAIT_V
#undef PG8_WAIT_L
#undef PG8_BAR
#undef PG8_SCHED
}
}
#define LAS __attribute__((address_space(3)))
typedef unsigned short bf16;
typedef float f32x4 __attribute__((ext_vector_type(4)));
typedef float f32x16 __attribute__((ext_vector_type(16)));
typedef short bf16x8 __attribute__((ext_vector_type(8)));
typedef short s16x4 __attribute__((ext_vector_type(4)));
typedef unsigned u32x4 __attribute__((ext_vector_type(4)));
typedef unsigned u32x2 __attribute__((ext_vector_type(2)));
using pg8::cvt_pk_bf16;

constexpr int NTHREADS = 512, NWAVES = 8;
constexpr int M = 65536, D = 1024, FF = 4096, DIN = 3104, DIN_PAD = 3328, LDH = 3104;
constexpr int NSEQ = 10, S_P = 16384, S_S = 4096, NPR = 32768;
constexpr int O_DQ = 0, O_DK = 512, O_DV = 1024, O_GQ = 1536, O_GK = 1792, O_GV = 2048, O_GR = 2560, O_LRF = 3072, O_LRB = 3088;
constexpr float LN_EPS = 1e-5f;
constexpr float ALPHA = 1.189207115002721f;
constexpr float LAM_INIT = 0.2f;
constexpr float C1 = 0.125f * 1.4426950408889634f;

constexpr size_t MiB = 1u << 20;
constexpr size_t WS_CTL = 0;
constexpr size_t WS_WIN = 2 * MiB, WS_WO = 9 * MiB, WS_W1 = 11 * MiB, WS_W2 = 19 * MiB, WS_GG = 27 * MiB;
constexpr size_t WS_H = 32 * MiB;
constexpr size_t WS_XB = 420 * MiB;
constexpr size_t WS_MIX = 548 * MiB;
constexpr size_t WS_ST = 676 * MiB;
constexpr size_t WS_X1B = 676 * MiB;
constexpr size_t WS_HID = 32 * MiB;
constexpr size_t WS_KD = 832 * MiB, WS_VD = 896 * MiB;
constexpr size_t WS_END = 960 * MiB;
static_assert(WS_H + (size_t)M * LDH * 2 <= WS_XB && WS_HID + (size_t)M * FF * 2 <= WS_MIX && WS_X1B + (size_t)M * D * 2 <= WS_END, "ws map");

constexpr int RING_BYTES = 131072;
constexpr int LDS_BYTES = 160 * 1024;

struct Params {
    const float* in[20];
    float* out;
    unsigned char* ws;
    int ph_lo, ph_hi;
};

__device__ __forceinline__ float wave_sum(float v) {
#pragma unroll
    for (int o = 1; o < 64; o <<= 1) v += __shfl_xor(v, o);
    return v;
}
__device__ __forceinline__ const float* xrow_ptr(const Params& p, int m) { return (m < NPR) ? p.in[0] + (size_t)m * D : p.in[1] + (size_t)(m - NPR) * D; }

__device__ __forceinline__ void p0_transpose_item(const float* W, int K, int N, bf16* WT, LAS float* scr, int item, int lane) {
    const int nblk = N / 32, kb = item / nblk, nb = item % nblk, k0 = 64 * kb, n0 = 32 * nb;
#pragma unroll 8
    for (int i = 0; i < 32; ++i) { const int kk = 2 * i + (lane >> 5); scr[kk * 33 + (lane & 31)] = W[(size_t)(k0 + kk) * N + n0 + (lane & 31)]; }
    asm volatile("s_waitcnt vmcnt(0) lgkmcnt(0)" ::: "memory");
    const int c = lane & 7;
#pragma unroll
    for (int j = 0; j < 4; ++j) { const int n = (lane >> 3) + 8 * j; const LAS float* s = scr + (8 * c) * 33 + n;
        u32x4 o; o.x = cvt_pk_bf16(s[0 * 33], s[1 * 33]); o.y = cvt_pk_bf16(s[2 * 33], s[3 * 33]); o.z = cvt_pk_bf16(s[4 * 33], s[5 * 33]); o.w = cvt_pk_bf16(s[6 * 33], s[7 * 33]);
        *(u32x4*)(WT + (size_t)(n0 + n) * K + k0 + 8 * c) = o; }
    asm volatile("s_waitcnt lgkmcnt(0)" ::: "memory");
}

__device__ __forceinline__ void ln_row(const float* in, float* outf, bf16* outb, const float* g, const float* b, int lane) {
    const f32x4* xr = (const f32x4*)in + lane;
    f32x4 v[4]; float s = 0.f;
#pragma unroll
    for (int j = 0; j < 4; ++j) { v[j] = xr[64 * j]; s += (v[j].x + v[j].y) + (v[j].z + v[j].w); }
    const float mean = wave_sum(s) * (1.f / D); float s2 = 0.f;
#pragma unroll
    for (int j = 0; j < 4; ++j) { v[j] = v[j] - mean; s2 += (v[j].x * v[j].x + v[j].y * v[j].y) + (v[j].z * v[j].z + v[j].w * v[j].w); }
    const float rstd = 1.f / sqrtf(wave_sum(s2) * (1.f / D) + LN_EPS);
#pragma unroll
    for (int j = 0; j < 4; ++j) {
        const f32x4 g4 = ((const f32x4*)g)[lane + 64 * j], b4 = ((const f32x4*)b)[lane + 64 * j];
        const f32x4 o = v[j] * rstd * g4 + b4;
        ((f32x4*)outf)[lane + 64 * j] = o;
        if (outb) { u32x2 w; w.x = cvt_pk_bf16(o.x, o.y); w.y = cvt_pk_bf16(o.z, o.w); ((u32x2*)outb)[lane + 64 * j] = w; }
    }
}

__device__ __forceinline__ void ln_row_b(const bf16* in, float* outf, bf16* outb, const float* g, const float* b, int lane) {
    const u32x4 wa = ((const u32x4*)in)[lane], wb = ((const u32x4*)in)[64 + lane];
    float v[16];
#pragma unroll
    for (int i = 0; i < 4; ++i) { v[2 * i] = __uint_as_float(wa[i] << 16); v[2 * i + 1] = __uint_as_float(wa[i] & 0xffff0000u); v[8 + 2 * i] = __uint_as_float(wb[i] << 16); v[8 + 2 * i + 1] = __uint_as_float(wb[i] & 0xffff0000u); }
    float s = 0.f;
#pragma unroll
    for (int i = 0; i < 16; ++i) s += v[i];
    const float mean = wave_sum(s) * (1.f / D); float s2 = 0.f;
#pragma unroll
    for (int i = 0; i < 16; ++i) { v[i] -= mean; s2 += v[i] * v[i]; }
    const float rstd = 1.f / sqrtf(wave_sum(s2) * (1.f / D) + LN_EPS);
#pragma unroll
    for (int h = 0; h < 2; ++h) {
        const int e0 = h * 512 + 8 * lane;
        const f32x4 g0 = *(const f32x4*)(g + e0), g1 = *(const f32x4*)(g + e0 + 4), b0 = *(const f32x4*)(b + e0), b1 = *(const f32x4*)(b + e0 + 4);
        const f32x4 o0 = (f32x4){v[8 * h + 0], v[8 * h + 1], v[8 * h + 2], v[8 * h + 3]} * rstd * g0 + b0;
        const f32x4 o1 = (f32x4){v[8 * h + 4], v[8 * h + 5], v[8 * h + 6], v[8 * h + 7]} * rstd * g1 + b1;
        if (outf) { *(f32x4*)(outf + e0) = o0; *(f32x4*)(outf + e0 + 4) = o1; }
        if (outb) { u32x4 w; w.x = cvt_pk_bf16(o0.x, o0.y); w.y = cvt_pk_bf16(o0.z, o0.w); w.z = cvt_pk_bf16(o1.x, o1.y); w.w = cvt_pk_bf16(o1.z, o1.w); *(u32x4*)(outb + e0) = w; }
    }
}

__device__ __forceinline__ void ln_rows4_b(const bf16* in, float* outf, bf16* outb, const float* g, const float* b, int lane) {
    u32x4 wa[4], wb[4];
#pragma unroll
    for (int r = 0; r < 4; ++r) { wa[r] = __builtin_nontemporal_load((const u32x4*)(in + (size_t)r * D) + lane); wb[r] = __builtin_nontemporal_load((const u32x4*)(in + (size_t)r * D) + 64 + lane); }
    float v[4][16], s[4], s2[4];
#pragma unroll
    for (int r = 0; r < 4; ++r) { s[r] = 0.f;
#pragma unroll
        for (int i = 0; i < 4; ++i) { v[r][2 * i] = __uint_as_float(wa[r][i] << 16); v[r][2 * i + 1] = __uint_as_float(wa[r][i] & 0xffff0000u); v[r][8 + 2 * i] = __uint_as_float(wb[r][i] << 16); v[r][8 + 2 * i + 1] = __uint_as_float(wb[r][i] & 0xffff0000u); }
#pragma unroll
        for (int i = 0; i < 16; ++i) s[r] += v[r][i]; }
#pragma unroll
    for (int o = 1; o < 64; o <<= 1) {
#pragma unroll
        for (int r = 0; r < 4; ++r) s[r] += __shfl_xor(s[r], o); }
#pragma unroll
    for (int r = 0; r < 4; ++r) { const float mean = s[r] * (1.f / D); s2[r] = 0.f;
#pragma unroll
        for (int i = 0; i < 16; ++i) { v[r][i] -= mean; s2[r] += v[r][i] * v[r][i]; } }
#pragma unroll
    for (int o = 1; o < 64; o <<= 1) {
#pragma unroll
        for (int r = 0; r < 4; ++r) s2[r] += __shfl_xor(s2[r], o); }
#pragma unroll
    for (int h = 0; h < 2; ++h) {
        const int e0 = h * 512 + 8 * lane;
        const f32x4 g0 = *(const f32x4*)(g + e0), g1 = *(const f32x4*)(g + e0 + 4), b0 = *(const f32x4*)(b + e0), b1 = *(const f32x4*)(b + e0 + 4);
#pragma unroll
        for (int r = 0; r < 4; ++r) {
            const float rstd = 1.f / sqrtf(s2[r] * (1.f / D) + LN_EPS);
            const f32x4 o0 = (f32x4){v[r][8 * h + 0], v[r][8 * h + 1], v[r][8 * h + 2], v[r][8 * h + 3]} * rstd * g0 + b0;
            const f32x4 o1 = (f32x4){v[r][8 * h + 4], v[r][8 * h + 5], v[r][8 * h + 6], v[r][8 * h + 7]} * rstd * g1 + b1;
            if (outf) { __builtin_nontemporal_store(o0, (f32x4*)(outf + (size_t)r * D + e0)); __builtin_nontemporal_store(o1, (f32x4*)(outf + (size_t)r * D + e0 + 4)); }
            if (outb) { u32x4 w; w.x = cvt_pk_bf16(o0.x, o0.y); w.y = cvt_pk_bf16(o0.z, o0.w); w.z = cvt_pk_bf16(o1.x, o1.y); w.w = cvt_pk_bf16(o1.z, o1.w); *(u32x4*)(outb + (size_t)r * D + e0) = w; }
        }
    }
}
#define RLX_AGENT __ATOMIC_RELAXED, __HIP_MEMORY_SCOPE_AGENT
#define XB_TMO      128
#define XB_XCNT(j)  (256  + 64 * (j))
#define XB_XSUB(j)  (1280 + 64 * (j))
#define XB_XGEN(j)  (2304 + 64 * (j))
#define XB_TOP      3328
#define XB_TOPGEN   3392
#define XCD_BAR_WORDS 3456
#define XB_SPIN_CAP (1u << 18)

__device__ __forceinline__ unsigned xb_ld(unsigned* p)              { return __hip_atomic_load(p, __ATOMIC_RELAXED, __HIP_MEMORY_SCOPE_AGENT); }
__device__ __forceinline__ unsigned xb_add(unsigned* p, unsigned v) { return __hip_atomic_fetch_add(p, v, __ATOMIC_RELAXED, __HIP_MEMORY_SCOPE_AGENT); }
__device__ __forceinline__ unsigned xb_xcc_id() { return (unsigned)__builtin_amdgcn_s_getreg((3 << 11) | 20) & 0xFu; }
#define XB_SPIN(cond, bar) do { unsigned _sp = 0; while (cond) { __builtin_amdgcn_s_sleep(1); \
    if ((++_sp & 255u) == 0u) { if (xb_ld(&(bar)[XB_TMO])) break; if (_sp > XB_SPIN_CAP) { atomicAdd(&(bar)[XB_TMO], 1u); break; } } } } while (0)

struct XcdBarrier {
    unsigned* bar; unsigned x; int wv;
    volatile LAS unsigned* st;
};

__device__ __forceinline__ XcdBarrier xcd_barrier_post(unsigned* bar, volatile LAS unsigned* st, int wave_u) {
    XcdBarrier b; b.bar = bar; b.x = xb_xcc_id(); b.st = st; b.wv = wave_u;
    if (tid_of(wave_u) == 0) (void)xb_add(&bar[XB_XCNT(b.x)], 1u);
    return b;
}
__device__ __forceinline__ void xcd_barrier_complete(unsigned* bar, unsigned x, unsigned& nloc, unsigned& nx) {
    const unsigned G = gridDim.x * gridDim.y * gridDim.z;
    unsigned sum, cnt, mine, sp = 0u;
    for (;;) {
        sum = 0u; cnt = 0u; mine = 0u;
#pragma unroll
        for (unsigned j = 0; j < 16; ++j) { const unsigned c = xb_ld(&bar[XB_XCNT(j)]); sum += c; cnt += (c > 0u) ? 1u : 0u; mine = (j == x) ? c : mine; }
        if (sum == G) break;
        __builtin_amdgcn_s_sleep(1);
        if ((++sp & 255u) == 0u) { if (xb_ld(&bar[XB_TMO])) break; if (sp > XB_SPIN_CAP) { atomicAdd(&bar[XB_TMO], 1u); break; } }
    }
    nloc = mine > 0u ? mine : 1u; nx = cnt > 0u ? cnt : 1u;
}

__device__ __forceinline__ void xcd_barrier(const XcdBarrier& b) {
    asm volatile("s_waitcnt vmcnt(0)" ::: "memory");
    __syncthreads();
    if (tid_of(b.wv) == 0) {
        unsigned* bar = b.bar;
        __builtin_amdgcn_s_waitcnt(0);
        unsigned nloc = b.st[0], nx = b.st[1];
        if (nloc == 0u) { xcd_barrier_complete(bar, b.x, nloc, nx); b.st[0] = nloc; b.st[1] = nx; }
        const unsigned old = xb_add(&bar[XB_XSUB(b.x)], 1u);
        const unsigned gen = old / nloc;
        if (old + 1u == (gen + 1u) * nloc) {
            __builtin_amdgcn_fence(__ATOMIC_RELEASE, "agent");
            asm volatile("s_waitcnt vmcnt(0)" ::: "memory");
            const unsigned og = xb_add(&bar[XB_TOP], 1u);
            const unsigned tg = og / nx;
            if (og + 1u == (tg + 1u) * nx) xb_add(&bar[XB_TOPGEN], 1u);
            else XB_SPIN(xb_ld(&bar[XB_TOPGEN]) == tg, bar);
            __builtin_amdgcn_fence(__ATOMIC_ACQUIRE, "agent");
            xb_add(&bar[XB_XGEN(b.x)], 1u);
            asm volatile("s_waitcnt vmcnt(0)" ::: "memory");
        } else {
            XB_SPIN(xb_ld(&bar[XB_XGEN(b.x)]) == gen, bar);
            __builtin_amdgcn_fence(__ATOMIC_ACQUIRE, "agent");
            asm volatile("s_waitcnt vmcnt(0)" ::: "memory");
        }
    }
    __syncthreads();
}
#ifndef ATT_REPS
#define ATT_REPS 1
#endif
namespace att {
typedef short v4i16_t __attribute__((ext_vector_type(4)));
typedef float f32x2 __attribute__((ext_vector_type(2)));
typedef __bf16 bf16x2_t __attribute__((ext_vector_type(2)));
__device__ __forceinline__ unsigned cvtpk_n(float lo, float hi) { const f32x2 v = {lo, hi}; return __builtin_bit_cast(unsigned, __builtin_convertvector(v, bf16x2_t)); }
constexpr int KSTR = 272, VSTR = 320;
constexpr int KBUF = 64 * KSTR, VBUF = 64 * VSTR, BUFB = KBUF + VBUF;
constexpr int XS = 132;
constexpr int TILEB = 32768;
constexpr int L_RED = 4 * TILEB;
constexpr int L_CTL = 160 * 1024 - 256;
constexpr float SKIP_T = 38.f;
constexpr int CW_UNIT = 160, CW_KN = 64;
__device__ __forceinline__ int crow(int r, int hi) { return (r & 3) + 8 * (r >> 2) + 4 * hi; }
__device__ __forceinline__ s16x4 vtr(LAS unsigned char* p) { return __builtin_bit_cast(s16x4, __builtin_amdgcn_ds_read_tr16_b64_v4i16((LAS v4i16_t*)p)); }
__device__ __forceinline__ float bf_lo(unsigned w) { return __uint_as_float(w << 16); }
__device__ __forceinline__ float bf_hi(unsigned w) { return __uint_as_float(w & 0xffff0000u); }

__device__ __forceinline__ void knorm_phase(const bf16* KD, unsigned* ctl, int bid, int G, int wave_u) {
    const int tid_l = tid_of(wave_u);
    const int gt = bid * NTHREADS + tid_l, NTH = G * NTHREADS;
    for (int idx = gt; idx < M * 8; idx += NTH) {
        const int row = idx >> 3, hc = idx & 7;
        const u32x4* kp = (const u32x4*)(KD + ((size_t)(hc >> 1) * M + row) * 128 + (hc & 1) * 64);
        float ss = 0.f;
#pragma unroll
        for (int i = 0; i < 8; ++i) { const u32x4 w = kp[i];
#pragma unroll
            for (int e = 0; e < 4; ++e) { const float a = bf_lo(w[e]), b = bf_hi(w[e]); ss = fmaf(a, a, ss); ss = fmaf(b, b, ss); } }
        float nr = sqrtf(ss);
        nr = fmaxf(nr, __shfl_xor(nr, 8)); nr = fmaxf(nr, __shfl_xor(nr, 16)); nr = fmaxf(nr, __shfl_xor(nr, 32));
        const int seq = (row < NPR) ? (row >> 14) : 2 + ((row - NPR) >> 12);
        if ((tid_l & 63) < 8) atomicMax(ctl + CW_KN + seq * 8 + hc, __float_as_uint(nr));
    }
}

__device__ __forceinline__ void attn_unit(const bf16* Hb, const bf16* KD, const bf16* VD, bf16* MIX, int row0, int S, int head, int qb, float lam, const float* dng, float kn0, float kn1, LAS unsigned char* lds, int wave_u) {
    const int tid_l = tid_of(wave_u);
    const int tid = tid_l, lane = tid & 63, wid = __builtin_amdgcn_readfirstlane(tid >> 6), r32 = lane & 31, hh = lane >> 5;
    const int c = wid >> 2, qs = wid & 3;
    const int q0 = qb * 128 + qs * 32;
    const float slope2 = __uint_as_float(__builtin_amdgcn_readfirstlane(__float_as_uint(exp2f(-2.f * (float)(head + 1)) * 1.4426950408889634f)));
    lam = __uint_as_float(__builtin_amdgcn_readfirstlane(__float_as_uint(lam)));
    bf16x8 qr[4];
    float mub;
    float m;
    {   const bf16* Qp = Hb + (size_t)(row0 + q0 + r32) * LDH + O_DQ + head * 128 + c * 64 + hh * 8;
        const bf16* Kp = KD + ((size_t)head * M + row0 + q0 + r32) * 128 + c * 64 + hh * 8;
        float qq = 0.f, dot = 0.f;
#pragma unroll
        for (int d0 = 0; d0 < 4; ++d0) { qr[d0] = *(const bf16x8*)(Qp + d0 * 16); const u32x4 qw = __builtin_bit_cast(u32x4, qr[d0]); const u32x4 kw = *(const u32x4*)(Kp + d0 * 16);
#pragma unroll
            for (int e = 0; e < 4; ++e) { const float qa = bf_lo(qw[e]), qb_ = bf_hi(qw[e]), ka = bf_lo(kw[e]), kb = bf_hi(kw[e]);
                qq = fmaf(qa, qa, qq); qq = fmaf(qb_, qb_, qq); dot = fmaf(qa, ka, dot); dot = fmaf(qb_, kb, dot); } }
        qq += __shfl_xor(qq, 32); dot += __shfl_xor(dot, 32);
        m = dot;
        float am = sqrtf(qq) * (c ? kn1 : kn0) * 1.001f + 0.01f, bm = dot;
        mub = am;
        float sp = am - dot;
#pragma unroll
        for (int o = 1; o < 32; o <<= 1) { am = fmaxf(am, __shfl_xor(am, o)); bm = fminf(bm, __shfl_xor(bm, o)); sp = fmaxf(sp, __shfl_xor(sp, o)); }
        LAS float* red = (LAS float*)(lds + L_RED);
        if (lane == 0) { red[wid * 4] = am; red[wid * 4 + 1] = bm; red[wid * 4 + 2] = sp; }
    }
    __syncthreads();
    int tlo, thi; bool fast;
    {   LAS float* red = (LAS float*)(lds + L_RED); float am = red[0], bm = red[1], sp = red[2];
#pragma unroll
        for (int w = 1; w < 8; ++w) { am = fmaxf(am, red[4 * w]); bm = fminf(bm, red[4 * w + 1]); sp = fmaxf(sp, red[4 * w + 2]); }
        fast = sp < 100.f;
        const float Wf = (sp + SKIP_T) / slope2 + 1.f; (void)am; (void)bm;
        const int W = (Wf < 1.0e6f) ? (int)Wf : 1000000;
        const int Q0 = qb * 128, NTall = S / 64;
        int lo = Q0 - 63 - W; lo = lo > 0 ? (lo + 63) / 64 : 0;
        int hi_ = (Q0 + 127 + W) / 64; hi_ = hi_ < NTall - 1 ? hi_ : NTall - 1;
        tlo = __builtin_amdgcn_readfirstlane(lo); thi = __builtin_amdgcn_readfirstlane(hi_);
    }
    if (((thi - tlo + 1) & 1) != 0) { if (tlo > 0) --tlo; else ++thi; }
    const int drow = 8 * wid + (lane >> 4);
    const int f0 = ((drow & 3) << 2) | ((drow >> 2) & 3), f1 = (((drow + 4) & 3) << 2) | (((drow + 4) >> 2) & 3);
    const unsigned kg0 = (unsigned)((((size_t)head * M + row0 + drow) * 128 + ((lane & 15) ^ f0) * 8) * 2);
    const unsigned kg1 = (unsigned)((((size_t)head * M + row0 + drow + 4) * 128 + ((lane & 15) ^ f1) * 8) * 2);
    const char* Kc = (const char*)KD; const char* Vc = (const char*)VD;
    const int dmaw = wid * 2048;
#define ATT_DMA(t, st) do { const unsigned off_ = (unsigned)(t) * 16384u; LAS unsigned char* S_ = lds + (st) * TILEB + dmaw; \
        __builtin_amdgcn_global_load_lds((const unsigned*)(Kc + (size_t)(kg0 + off_)), (LAS unsigned*)(S_), 16, 0, 0); \
        __builtin_amdgcn_global_load_lds((const unsigned*)(Kc + (size_t)(kg1 + off_)), (LAS unsigned*)(S_ + 1024), 16, 0, 0); \
        __builtin_amdgcn_global_load_lds((const unsigned*)(Vc + (size_t)(kg0 + off_)), (LAS unsigned*)(S_ + 16384), 16, 0, 0); \
        __builtin_amdgcn_global_load_lds((const unsigned*)(Vc + (size_t)(kg1 + off_)), (LAS unsigned*)(S_ + 16384 + 1024), 16, 0, 0); } while (0)
    ATT_DMA(tlo, 0); ATT_DMA(tlo + 1, 1);
    asm volatile("s_waitcnt vmcnt(0)" ::: "memory");
    __syncthreads();
    float l = 0.f;
    f32x16 o[4];
#pragma unroll
    for (int b = 0; b < 4; ++b)
#pragma unroll
        for (int r = 0; r < 16; ++r) o[b][r] = 0.f;
    const int fk = ((r32 & 3) << 2) | ((r32 >> 2) & 3);
    const int kbase = 256 * r32 + 16 * ((c * 8 + hh) ^ fk);
    const int q4 = (lane & 15) >> 2, pp4 = lane & 3, g1 = (lane >> 4) & 1;
    const int vlow0 = (2 * g1 + (pp4 >> 1)) ^ hh;
    const int vbase0 = 16384 + 256 * (4 * hh + q4) + 64 * q4 + 16 * vlow0 + 8 * (pp4 & 1);
    const int vbase1 = 16384 + 256 * (4 * hh + q4 + 8) + 64 * q4 + 16 * (vlow0 ^ 2) + 8 * (pp4 & 1);
    f32x2 l2 = (f32x2){0.f, 0.f};
#define ATT_CINIT(P0, P1, T) do { const int krel_ = (T) * 64 - q0; const float dbase_ = (float)(krel_ + 4 * hh - r32); \
        if (krel_ + 63 <= 0 || krel_ >= 31) { const float sg_ = (krel_ + 63 <= 0) ? slope2 : -slope2; const float base_ = fmaf(sg_, dbase_, -m); \
            _Pragma("unroll") for (int r = 0; r < 16; ++r) { const float cr = (float)((r & 3) + 8 * (r >> 2)); P0[r] = fmaf(sg_, cr, base_); P1[r] = fmaf(sg_, cr + 32.f, base_); } } \
        else { _Pragma("unroll") for (int r = 0; r < 16; ++r) { const float cr = (float)((r & 3) + 8 * (r >> 2)); P0[r] = fmaf(fabsf(dbase_ + cr), -slope2, -m); P1[r] = fmaf(fabsf(dbase_ + cr + 32.f), -slope2, -m); } } } while (0)
#define ATT_SB() __builtin_amdgcn_sched_barrier(0)
#define ATT_EXPPACK(P, S8, W) do { float e0 = __builtin_amdgcn_exp2f(P[S8 + 0]), e1 = __builtin_amdgcn_exp2f(P[S8 + 1]), e2 = __builtin_amdgcn_exp2f(P[S8 + 2]), e3 = __builtin_amdgcn_exp2f(P[S8 + 3]), \
        e4 = __builtin_amdgcn_exp2f(P[S8 + 4]), e5 = __builtin_amdgcn_exp2f(P[S8 + 5]), e6 = __builtin_amdgcn_exp2f(P[S8 + 6]), e7 = __builtin_amdgcn_exp2f(P[S8 + 7]); \
        l += ((e0 + e1) + (e2 + e3)) + ((e4 + e5) + (e6 + e7)); \
        u32x4 w_; w_.x = cvt_pk_bf16(e0, e1); w_.y = cvt_pk_bf16(e2, e3); w_.z = cvt_pk_bf16(e4, e5); w_.w = cvt_pk_bf16(e6, e7); W = __builtin_bit_cast(bf16x8, w_); } while (0)
#define ATT_VRD(S, L, H) do { _Pragma("unroll") for (int db = 0; db < 4; ++db) { \
        asm volatile("ds_read_b64_tr_b16 %0, %1 offset:%c2" : "=&v"(L[db]) : "v"(va0[db]), "i"(4096 * (S)) : "memory"); \
        asm volatile("ds_read_b64_tr_b16 %0, %1 offset:%c2" : "=&v"(H[db]) : "v"(va1[db]), "i"(4096 * (S)) : "memory"); } } while (0)
#define ATT_WAITV(L, H) asm volatile("s_waitcnt lgkmcnt(0)" : "+v"(L[0]), "+v"(L[1]), "+v"(L[2]), "+v"(L[3]), "+v"(H[0]), "+v"(H[1]), "+v"(H[2]), "+v"(H[3]) : : "memory")
#define ATT_PVM(L, H, PF) do { _Pragma("unroll") for (int db = 0; db < 4; ++db) \
        o[db] = __builtin_amdgcn_mfma_f32_32x32x16_bf16(__builtin_bit_cast(bf16x8, (u32x4){L[db].x, L[db].y, H[db].x, H[db].y}), PF, o[db], 0, 0, 0); } while (0)
#define ATT_TILE(Bt, T) do { \
        f32x16 p0, p1; ATT_CINIT(p0, p1, T); \
        unsigned va0[4], va1[4]; { const unsigned tb_ = (unsigned)(uintptr_t)(Bt); \
            _Pragma("unroll") for (int db = 0; db < 4; ++db) { va0[db] = tb_ + (unsigned)(vbase0 ^ (64 * db)); va1[db] = tb_ + (unsigned)(vbase1 ^ (64 * db)); } } \
        bf16x8 kf[8]; \
        _Pragma("unroll") for (int d0 = 0; d0 < 4; ++d0) { kf[2 * d0] = *(LAS bf16x8*)(Bt + (kbase ^ (32 * d0))); kf[2 * d0 + 1] = *(LAS bf16x8*)(Bt + 8192 + (kbase ^ (32 * d0))); } \
        ATT_SB(); \
        _Pragma("unroll") for (int d0 = 0; d0 < 4; ++d0) { p0 = __builtin_amdgcn_mfma_f32_32x32x16_bf16(kf[2 * d0], qr[d0], p0, 0, 0, 0); p1 = __builtin_amdgcn_mfma_f32_32x32x16_bf16(kf[2 * d0 + 1], qr[d0], p1, 0, 0, 0); } \
        u32x2 vl[4], vh[4], wl[4], wh[4]; \
        ATT_VRD(0, vl, vh); \
        ATT_SB(); \
        float mt = fmaxf(p0[0], p1[0]); \
        _Pragma("unroll") for (int r = 1; r < 16; ++r) mt = fmaxf(mt, fmaxf(p0[r], p1[r])); \
        mt = fmaxf(mt, __shfl_xor(mt, 32)); \
        if (__any(mt > 0.f)) { \
            const float dl = fmaxf(mt, 0.f), alpha = __builtin_amdgcn_exp2f(-dl); \
            m += dl; l *= alpha; \
            _Pragma("unroll") for (int r = 0; r < 16; ++r) { p0[r] -= dl; p1[r] -= dl; } \
            _Pragma("unroll") for (int b = 0; b < 4; ++b) _Pragma("unroll") for (int r = 0; r < 16; ++r) o[b][r] *= alpha; \
        } \
        bf16x8 f0, f1, f2, f3; \
        ATT_EXPPACK(p0, 0, f0); ATT_EXPPACK(p0, 8, f1); ATT_EXPPACK(p1, 0, f2); ATT_EXPPACK(p1, 8, f3); \
        ATT_SB(); \
        ATT_WAITV(vl, vh); ATT_VRD(1, wl, wh); ATT_SB(); ATT_PVM(vl, vh, f0); ATT_SB(); \
        ATT_WAITV(wl, wh); ATT_VRD(2, vl, vh); ATT_SB(); ATT_PVM(wl, wh, f1); ATT_SB(); \
        ATT_WAITV(vl, vh); ATT_VRD(3, wl, wh); ATT_SB(); ATT_PVM(vl, vh, f2); ATT_SB(); \
        ATT_WAITV(wl, wh); ATT_SB(); ATT_PVM(wl, wh, f3); ATT_SB(); \
    } while (0)
#define ATT_TILE_FAST(Bt, T) do { \
        f32x16 p0, p1; \
        { const int krel_ = (T) * 64 - q0; const float dbase_ = (float)(krel_ + 4 * hh - r32); \
          if (krel_ + 63 <= 0 || krel_ >= 31) { const float sg_ = (krel_ + 63 <= 0) ? slope2 : -slope2; const float b0_ = fmaf(sg_, dbase_, -mub), b1_ = fmaf(sg_, 32.f, b0_); \
              _Pragma("unroll") for (int r = 0; r < 16; ++r) { const float cr = (float)((r & 3) + 8 * (r >> 2)); p0[r] = fmaf(sg_, cr, b0_); p1[r] = fmaf(sg_, cr, b1_); } } \
          else { _Pragma("unroll") for (int r = 0; r < 16; ++r) { const float cr = (float)((r & 3) + 8 * (r >> 2)); p0[r] = fmaf(fabsf(dbase_ + cr), -slope2, -mub); p1[r] = fmaf(fabsf(dbase_ + cr + 32.f), -slope2, -mub); } } } \
        unsigned va0[4], va1[4]; { const unsigned tb_ = (unsigned)(uintptr_t)(Bt); \
            _Pragma("unroll") for (int db = 0; db < 4; ++db) { va0[db] = tb_ + (unsigned)(vbase0 ^ (64 * db)); va1[db] = tb_ + (unsigned)(vbase1 ^ (64 * db)); } } \
        bf16x8 kf[8]; \
        _Pragma("unroll") for (int d0 = 0; d0 < 4; ++d0) { kf[2 * d0] = *(LAS bf16x8*)(Bt + (kbase ^ (32 * d0))); kf[2 * d0 + 1] = *(LAS bf16x8*)(Bt + 8192 + (kbase ^ (32 * d0))); } \
        ATT_SB(); \
        _Pragma("unroll") for (int d0 = 0; d0 < 4; ++d0) { p0 = __builtin_amdgcn_mfma_f32_32x32x16_bf16(kf[2 * d0], qr[d0], p0, 0, 0, 0); p1 = __builtin_amdgcn_mfma_f32_32x32x16_bf16(kf[2 * d0 + 1], qr[d0], p1, 0, 0, 0); } \
        u32x2 vl[4], vh[4], wl[4], wh[4]; \
        ATT_VRD(0, vl, vh); \
        ATT_SB(); \
        bf16x8 f0, f1, f2, f3; \
        ATT_EXPPACK2(p0, 0, f0); ATT_EXPPACK2(p0, 8, f1); ATT_EXPPACK2(p1, 0, f2); ATT_EXPPACK2(p1, 8, f3); \
        ATT_SB(); \
        ATT_WAITV(vl, vh); ATT_VRD(1, wl, wh); ATT_SB(); ATT_PVM(vl, vh, f0); ATT_SB(); \
        ATT_WAITV(wl, wh); ATT_VRD(2, vl, vh); ATT_SB(); ATT_PVM(wl, wh, f1); ATT_SB(); \
        ATT_WAITV(vl, vh); ATT_VRD(3, wl, wh); ATT_SB(); ATT_PVM(vl, vh, f2); ATT_SB(); \
        ATT_WAITV(wl, wh); ATT_SB(); ATT_PVM(wl, wh, f3); ATT_SB(); \
    } while (0)
#define ATT_EXPPACK2(P, S8, W) do { f32x2 ea_ = (f32x2){__builtin_amdgcn_exp2f(P[S8 + 0]), __builtin_amdgcn_exp2f(P[S8 + 1])}, eb_ = (f32x2){__builtin_amdgcn_exp2f(P[S8 + 2]), __builtin_amdgcn_exp2f(P[S8 + 3])}, \
        ec_ = (f32x2){__builtin_amdgcn_exp2f(P[S8 + 4]), __builtin_amdgcn_exp2f(P[S8 + 5])}, ed_ = (f32x2){__builtin_amdgcn_exp2f(P[S8 + 6]), __builtin_amdgcn_exp2f(P[S8 + 7])}; \
        l2 += (ea_ + eb_) + (ec_ + ed_); \
        u32x4 w_; w_.x = cvt_pk_bf16(ea_.x, ea_.y); w_.y = cvt_pk_bf16(eb_.x, eb_.y); w_.z = cvt_pk_bf16(ec_.x, ec_.y); w_.w = cvt_pk_bf16(ed_.x, ed_.y); W = __builtin_bit_cast(bf16x8, w_); } while (0)
#define ATT_CINITH(P, T, H) do { const int krel_ = (T) * 64 - q0; const float dbase_ = (float)(krel_ + 4 * hh - r32 + 32 * (H)); \
          if (krel_ + 63 <= 0 || krel_ >= 31) { const float sg_ = (krel_ + 63 <= 0) ? slope2 : -slope2; const float b0_ = fmaf(sg_, dbase_, -mref); \
              _Pragma("unroll") for (int r = 0; r < 16; ++r) { const float cr = (float)((r & 3) + 8 * (r >> 2)); P[r] = fmaf(sg_, cr, b0_); } } \
          else { _Pragma("unroll") for (int r = 0; r < 16; ++r) { const float cr = (float)((r & 3) + 8 * (r >> 2)); P[r] = fmaf(fabsf(dbase_ + cr), -slope2, -mref); } } } while (0)
#define ATT_SGB(mask, n) __builtin_amdgcn_sched_group_barrier(mask, n, 0)
#define ATT_KLD(Bt, H) do { _Pragma("unroll") for (int d0 = 0; d0 < 4; ++d0) kf[d0] = *(LAS bf16x8*)(Bt + 8192 * (H) + (kbase ^ (32 * d0))); } while (0)
#define ATT_QK(P) do { _Pragma("unroll") for (int d0 = 0; d0 < 4; ++d0) P = __builtin_amdgcn_mfma_f32_32x32x16_bf16(kf[d0], qr[d0], P, 0, 0, 0); } while (0)
#define ATT_VADDR(Bt) do { const unsigned tb_ = (unsigned)(uintptr_t)(Bt); \
            _Pragma("unroll") for (int db = 0; db < 4; ++db) { va0[db] = tb_ + (unsigned)(vbase0 ^ (64 * db)); va1[db] = tb_ + (unsigned)(vbase1 ^ (64 * db)); } } while (0)
#define ATT_PAIR_FAST(BtA, BtB, T) do { \
        f32x16 a0, a1, b0, b1; bf16x8 kf[4]; unsigned va0[4], va1[4]; u32x2 vl[4], vh[4], wl[4], wh[4]; \
        bf16x8 fa0, fa1, fa2, fa3, fb0, fb1, fb2, fb3; \
        ATT_CINITH(a0, T, 0); ATT_CINITH(a1, T, 1); ATT_VADDR(BtA); \
        ATT_KLD(BtA, 0); ATT_SB(); ATT_QK(a0); ATT_VRD(0, vl, vh); ATT_KLD(BtA, 1); ATT_SB(); \
        ATT_QK(a1); ATT_EXPPACK2(a0, 0, fa0); ATT_EXPPACK2(a0, 8, fa1); \
        _Pragma("unroll") for (int i_ = 0; i_ < 4; ++i_) { ATT_SGB(0x8, 1); ATT_SGB(0x2, 7); } ATT_SB(); \
        ATT_CINITH(b0, (T) + 1, 0); ATT_WAITV(vl, vh); ATT_VRD(1, wl, wh); ATT_KLD(BtB, 0); ATT_SB(); \
        ATT_PVM(vl, vh, fa0); ATT_QK(b0); ATT_EXPPACK2(a1, 0, fa2); ATT_EXPPACK2(a1, 8, fa3); \
        _Pragma("unroll") for (int i_ = 0; i_ < 8; ++i_) { ATT_SGB(0x8, 1); ATT_SGB(0x2, 4); } ATT_SB(); \
        ATT_CINITH(b1, (T) + 1, 1); ATT_WAITV(wl, wh); ATT_VRD(2, vl, vh); ATT_KLD(BtB, 1); ATT_SB(); \
        ATT_PVM(wl, wh, fa1); ATT_QK(b1); ATT_EXPPACK2(b0, 0, fb0); ATT_EXPPACK2(b0, 8, fb1); \
        _Pragma("unroll") for (int i_ = 0; i_ < 8; ++i_) { ATT_SGB(0x8, 1); ATT_SGB(0x2, 4); } ATT_SB(); \
        ATT_WAITV(vl, vh); ATT_VRD(3, wl, wh); ATT_SB(); \
        ATT_PVM(vl, vh, fa2); ATT_EXPPACK2(b1, 0, fb2); \
        _Pragma("unroll") for (int i_ = 0; i_ < 4; ++i_) { ATT_SGB(0x8, 1); ATT_SGB(0x2, 4); } ATT_SB(); \
        ATT_WAITV(wl, wh); ATT_VRD(8, vl, vh); ATT_SB(); \
        ATT_PVM(wl, wh, fa3); ATT_EXPPACK2(b1, 8, fb3); \
        _Pragma("unroll") for (int i_ = 0; i_ < 4; ++i_) { ATT_SGB(0x8, 1); ATT_SGB(0x2, 4); } ATT_SB(); \
        ATT_WAITV(vl, vh); ATT_VRD(9, wl, wh); ATT_SB(); ATT_PVM(vl, vh, fb0); ATT_SB(); \
        ATT_WAITV(wl, wh); ATT_VRD(10, vl, vh); ATT_SB(); ATT_PVM(wl, wh, fb1); ATT_SB(); \
        ATT_WAITV(vl, vh); ATT_VRD(11, wl, wh); ATT_SB(); ATT_PVM(vl, vh, fb2); ATT_SB(); \
        ATT_WAITV(wl, wh); ATT_SB(); ATT_PVM(wl, wh, fb3); ATT_SB(); \
    } while (0)
    if (fast) {
    for (int t = tlo; t <= thi; t += 2) {
        const int pbuf = ((t - tlo) >> 1) & 1;
        if (t + 2 <= thi) { ATT_DMA(t + 2, 2 * (pbuf ^ 1)); ATT_DMA(t + 3, 2 * (pbuf ^ 1) + 1); }
        LAS unsigned char* BA = lds + (2 * pbuf) * TILEB;
        LAS unsigned char* BB = BA + TILEB;
#ifndef ATT_DUP
#define ATT_DUP 1
#endif
        _Pragma("nounroll") for (int dup_ = ATT_DUP - 1; dup_ >= 0; --dup_) { const float mref = mub + (dup_ ? 1000.f : 0.f); ATT_PAIR_FAST(BA, BB, t); }
        asm volatile("s_waitcnt vmcnt(0)" ::: "memory");
        __syncthreads();
    }
    } else {
    for (int t = tlo; t <= thi; t += 2) {
        const int pbuf = ((t - tlo) >> 1) & 1;
        if (t + 2 <= thi) { ATT_DMA(t + 2, 2 * (pbuf ^ 1)); ATT_DMA(t + 3, 2 * (pbuf ^ 1) + 1); }
        LAS unsigned char* BA = lds + (2 * pbuf) * TILEB;
        LAS unsigned char* BB = BA + TILEB;
        ATT_TILE(BA, t); ATT_TILE(BB, t + 1);
        asm volatile("s_waitcnt vmcnt(0)" ::: "memory");
        __syncthreads();
    }
    }
#undef ATT_DMA
#undef ATT_CINIT
#undef ATT_EXPPACK
#undef ATT_VRD
#undef ATT_WAITV
#undef ATT_PVM
#undef ATT_TILE
#undef ATT_TILE_FAST
#undef ATT_PAIR_FAST
#undef ATT_CINITH
#undef ATT_KLD
#undef ATT_QK
#undef ATT_VADDR
#undef ATT_SGB
#undef ATT_EXPPACK2
#undef ATT_SB
    int ln2 = tid_of(wave_u) & 63;
    const int r32e = ln2 & 31, hhe = ln2 >> 5;
    if (fast) l = l2.x + l2.y;
    l += __shfl_xor(l, 32);
    const float rl = 1.f / l;
    LAS float* X = (LAS float*)lds;
    if (c == 1) {
        const float f = rl * lam;
#pragma unroll
        for (int b = 0; b < 4; ++b)
#pragma unroll
            for (int r = 0; r < 16; ++r) X[(qs * 32 + r32e) * XS + 32 * b + crow(r, hhe)] = o[b][r] * f;
    }
    __syncthreads();
    if (c == 0) {
        float ss = 0.f;
#pragma unroll
        for (int b = 0; b < 4; ++b)
#pragma unroll
            for (int r = 0; r < 16; ++r) { const float v = o[b][r] * rl - X[(qs * 32 + r32e) * XS + 32 * b + crow(r, hhe)]; o[b][r] = v; ss += v * v; }
        ss += __shfl_xor(ss, 32);
        const float rn = (1.f - LAM_INIT) / sqrtf(ss * (1.f / 128.f) + 1e-5f);
        bf16* orow = MIX + (size_t)(row0 + q0 + r32e) * D + head * 128;
#pragma unroll
        for (int b = 0; b < 4; ++b)
#pragma unroll
            for (int rg = 0; rg < 4; ++rg) { const int d = 32 * b + 8 * rg + 4 * hhe; const f32x4 g4 = *(const f32x4*)(dng + d);
                u32x2 w; w.x = cvt_pk_bf16(o[b][4 * rg + 0] * rn * g4.x, o[b][4 * rg + 1] * rn * g4.y); w.y = cvt_pk_bf16(o[b][4 * rg + 2] * rn * g4.z, o[b][4 * rg + 3] * rn * g4.w);
                *(u32x2*)(orow + d) = w; }
    }
    __syncthreads();
}

__device__ __forceinline__ void attn_phase(const Params& p, const bf16* Hb, const bf16* KD, const bf16* VD, bf16* MIX, unsigned* ctl, LAS unsigned char* lds, int bid, int G, int wave_u) {
    float s1 = 0.f, s2 = 0.f;
    for (int i = 0; i < 64; ++i) { s1 += p.in[4][i] * p.in[5][i]; s2 += p.in[6][i] * p.in[7][i]; }
    const float lam = expf(s1) - expf(s2) + LAM_INIT;
    LAS int* slot = (LAS int*)(lds + L_CTL);
    const int myx = (int)(__builtin_amdgcn_s_getreg((3 << 11) | 20) & 7u);
    for (int rep = 0; rep < ATT_REPS; ++rep)
    for (int qi = 0; qi < 8; ++qi) {
      const int x = (myx + qi) & 7;
      for (;;) {
        if (tid_of(wave_u) == 0) *slot = (int)atomicAdd(ctl + CW_UNIT + x + 8 * rep, 1u);
        __syncthreads();
        const int j = __builtin_amdgcn_readfirstlane(*slot);
        __syncthreads();
        if (j >= 256) break;
        const int grp = j >> 5, i = j & 31;
        const bool prompt = (grp == 0) | (grp == 1) | (grp == 4) | (grp == 6);
        const int head = (grp == 0 || grp == 2) ? 3 : (grp == 1 || grp == 3) ? 2 : (grp == 4 || grp == 5) ? 1 : 0;
        int seq, qb, row0, S;
        if (prompt) { seq = x & 1; qb = i * 4 + (x >> 1); row0 = seq * S_P; S = S_P; }
        else { seq = 2 + x; qb = i; row0 = NPR + x * S_S; S = S_S; }
        const float kn0 = __uint_as_float(__hip_atomic_load(ctl + CW_KN + seq * 8 + head * 2, __ATOMIC_RELAXED, __HIP_MEMORY_SCOPE_AGENT));
        const float kn1 = __uint_as_float(__hip_atomic_load(ctl + CW_KN + seq * 8 + head * 2 + 1, __ATOMIC_RELAXED, __HIP_MEMORY_SCOPE_AGENT));
        attn_unit(Hb, KD, VD, MIX, row0, S, head, qb, lam, p.in[8], kn0, kn1, lds, wave_u);
      }
    }
}
}
namespace gla {
using att::crow; using att::vtr; using att::VSTR;
constexpr int L_LR = 0, L_B = 4096, L_TOT = 20480, L_BT = 22528, L_QT = 23040, L_KT = 32256, L_V = 41472, L_Z = 82432;
constexpr int L_V2 = 116224, L_LR2 = 136704;
constexpr int QSTR = 144, ZS = 132, SEGC = 16;
constexpr float LOG2E = 1.4426950408889634f, LN2 = 0.6931471805599453f;
__device__ __forceinline__ float bf2f(unsigned h) { return __uint_as_float(h << 16); }
__device__ __forceinline__ float fexp(float x) { return __builtin_amdgcn_exp2f(x * LOG2E); }

struct ChunkRegs { u32x4 v0, v1, q, k, lr; };
template <bool NEEDQ> __device__ __forceinline__ void chunk_load(ChunkRegs& R, const bf16* Hb, int rowbase, int head, int dir, int tid) {
    const int srow = tid >> 4, sch = tid & 15;
    const bf16* Vg = Hb + (size_t)(rowbase + srow) * LDH + O_GV + head * 128 + sch * 8;
    R.v0 = *(const u32x4*)Vg; R.v1 = *(const u32x4*)(Vg + (size_t)32 * LDH);
    const int pr = tid >> 3, dk0 = (tid & 7) * 8;
    R.k = *(const u32x4*)(Hb + (size_t)(rowbase + pr) * LDH + O_GK + head * 64 + dk0);
    if (NEEDQ) R.q = *(const u32x4*)(Hb + (size_t)(rowbase + pr) * LDH + O_GQ + head * 64 + dk0);
    if (tid < 128) R.lr = *(const u32x4*)(Hb + (size_t)(rowbase + (tid >> 1)) * LDH + O_LRF + dir * 16 + (tid & 1) * 8);
}
__device__ __forceinline__ void stage_vlr(const ChunkRegs& R, int buf, LAS unsigned char* lds, int tid) {
    LAS float* LR = (LAS float*)(lds + (buf ? L_LR2 : L_LR));
    { const int srow = tid >> 4, sch = tid & 15; LAS unsigned char* V = lds + (buf ? L_V2 : L_V);
      *(LAS u32x4*)(V + srow * VSTR + sch * 16) = R.v0; *(LAS u32x4*)(V + (srow + 32) * VSTR + sch * 16) = R.v1; }
    if (tid < 128) { const int tok = tid >> 1, hf = tid & 1;
#pragma unroll
        for (int i = 0; i < 4; ++i) { const unsigned ww = R.lr[i]; LR[tok * 16 + hf * 8 + 2 * i] = bf2f(ww & 0xffffu); LR[tok * 16 + hf * 8 + 2 * i + 1] = bf2f(ww >> 16); } }
}
template <bool NEEDQ> __device__ __forceinline__ float chunk_front(const ChunkRegs& C, const ChunkRegs& N, bool stage_next, int cur, int dir, const bf16x8& bhi, const bf16x8& blo, float biasd, LAS unsigned char* lds, int tid) {
    LAS float* LR = (LAS float*)(lds + (cur ? L_LR2 : L_LR)); LAS float* Bm = (LAS float*)(lds + L_B); LAS float* TOT = (LAS float*)(lds + L_TOT); LAS float* BT = (LAS float*)(lds + L_BT);
    const int d = tid & 63, grp = tid >> 6;
    if (grp < 4) { const int ln = tid & 63, r32_ = ln & 31, hh_ = ln >> 5, pblk = grp >> 1, dblk = grp & 1;
        const f32x4 a0 = *(const LAS f32x4*)(LR + (32 * pblk + r32_) * 16 + 8 * hh_), a1 = *(const LAS f32x4*)(LR + (32 * pblk + r32_) * 16 + 8 * hh_ + 4);
        u32x4 aw; aw.x = att::cvtpk_n(a0.x, a0.y); aw.y = att::cvtpk_n(a0.z, a0.w); aw.z = att::cvtpk_n(a1.x, a1.y); aw.w = att::cvtpk_n(a1.z, a1.w);
        f32x16 zc;
#pragma unroll
        for (int r = 0; r < 16; ++r) zc[r] = biasd;
        zc = __builtin_amdgcn_mfma_f32_32x32x16_bf16(__builtin_bit_cast(bf16x8, aw), bhi, zc, 0, 0, 0);
        zc = __builtin_amdgcn_mfma_f32_32x32x16_bf16(__builtin_bit_cast(bf16x8, aw), blo, zc, 0, 0, 0);
#pragma unroll
        for (int r = 0; r < 16; ++r) Bm[(32 * pblk + crow(r, hh_)) * 64 + 32 * dblk + r32_] = zc[r]; }
    __syncthreads();
    float la[8];
#pragma unroll
    for (int i = 0; i < 8; ++i) { const int p = grp * 8 + i; const float z = Bm[p * 64 + d];
        const float t = __builtin_amdgcn_exp2f(-fabsf(z) * LOG2E);
        la[i] = (fminf(z, 0.f) * LOG2E - __builtin_amdgcn_logf(1.f + t)) * (1.f / 16.f); }
    if (dir == 0) {
#pragma unroll
        for (int i = 1; i < 8; ++i) la[i] += la[i - 1];
        TOT[grp * 64 + d] = la[7];
    } else {
#pragma unroll
        for (int i = 6; i >= 0; --i) la[i] += la[i + 1];
        TOT[grp * 64 + d] = la[0];
    }
    __syncthreads();
    float pre = 0.f, tot = 0.f;
#pragma unroll
    for (int g = 0; g < 8; ++g) { const float tv = TOT[g * 64 + d]; tot += tv; if (dir == 0 ? (g < grp) : (g > grp)) pre += tv; }
#pragma unroll
    for (int i = 0; i < 8; ++i) Bm[(grp * 8 + i) * 64 + d] = la[i] + pre;
    if (grp == 0) BT[d] = __builtin_amdgcn_exp2f(tot);
    __syncthreads();
    { const int pr = tid >> 3, dk0 = (tid & 7) * 8;
      float qt[8], kt[8];
#pragma unroll
      for (int i = 0; i < 8; ++i) { const unsigned wk = C.k[i >> 1]; const float bb = Bm[pr * 64 + dk0 + i];
          kt[i] = bf2f((i & 1) ? (wk >> 16) : (wk & 0xffffu)) * __builtin_amdgcn_exp2f(-bb);
          if (NEEDQ) { const unsigned wq = C.q[i >> 1]; qt[i] = bf2f((i & 1) ? (wq >> 16) : (wq & 0xffffu)) * __builtin_amdgcn_exp2f(bb); } }
      u32x4 wk4; wk4.x = cvt_pk_bf16(kt[0], kt[1]); wk4.y = cvt_pk_bf16(kt[2], kt[3]); wk4.z = cvt_pk_bf16(kt[4], kt[5]); wk4.w = cvt_pk_bf16(kt[6], kt[7]);
      *(LAS u32x4*)(lds + L_KT + pr * QSTR + dk0 * 2) = wk4;
      if (NEEDQ) { u32x4 wq4; wq4.x = cvt_pk_bf16(qt[0], qt[1]); wq4.y = cvt_pk_bf16(qt[2], qt[3]); wq4.z = cvt_pk_bf16(qt[4], qt[5]); wq4.w = cvt_pk_bf16(qt[6], qt[7]);
          *(LAS u32x4*)(lds + L_QT + pr * QSTR + dk0 * 2) = wq4; } }
    if (stage_next) stage_vlr(N, cur ^ 1, lds, tid);
    __syncthreads();
    return tot;
}
__device__ __forceinline__ void state_update(f32x16& S, int mb, int nb, int LV, LAS unsigned char* lds, int hh, int q4, int pp4, int g1) {
#pragma unroll
    for (int s = 0; s < 4; ++s) {
        LAS unsigned char* kb = lds + L_KT + (16 * s + 8 * hh + q4) * QSTR + (32 * mb + 16 * g1 + 4 * pp4) * 2;
        LAS unsigned char* vb = lds + LV + (16 * s + 8 * hh + q4) * VSTR + (32 * nb + 16 * g1 + 4 * pp4) * 2;
        const s16x4 alo = vtr(kb), ahi = vtr(kb + 4 * QSTR), blo = vtr(vb), bhi = vtr(vb + 4 * VSTR);
        S = __builtin_amdgcn_mfma_f32_32x32x16_bf16((bf16x8){alo[0], alo[1], alo[2], alo[3], ahi[0], ahi[1], ahi[2], ahi[3]},
                                                    (bf16x8){blo[0], blo[1], blo[2], blo[3], bhi[0], bhi[1], bhi[2], bhi[3]}, S, 0, 0, 0);
    }
    LAS float* BT = (LAS float*)(lds + L_BT);
#pragma unroll
    for (int r = 0; r < 16; ++r) S[r] *= BT[32 * mb + crow(r, hh)];
}
__device__ __forceinline__ void load_gate_b(bf16x8& bhi, bf16x8& blo, float& biasd, const Params& p, int head, int dir, int tid) {
    const float* wa2 = dir ? p.in[11] : p.in[9]; const float* ba = dir ? p.in[12] : p.in[10];
    const int ln = tid & 63, r32_ = ln & 31, hh_ = ln >> 5, dblk = (tid >> 6) & 1, dcol = head * 64 + 32 * dblk + r32_;
    float wv[8], hf[8];
#pragma unroll
    for (int j = 0; j < 8; ++j) { wv[j] = wa2[(8 * hh_ + j) * 256 + dcol]; hf[j] = __uint_as_float(att::cvtpk_n(wv[j], 0.f) << 16); }
    u32x4 h4, l4;
    h4.x = att::cvtpk_n(hf[0], hf[1]); h4.y = att::cvtpk_n(hf[2], hf[3]); h4.z = att::cvtpk_n(hf[4], hf[5]); h4.w = att::cvtpk_n(hf[6], hf[7]);
    l4.x = att::cvtpk_n(wv[0] - hf[0], wv[1] - hf[1]); l4.y = att::cvtpk_n(wv[2] - hf[2], wv[3] - hf[3]); l4.z = att::cvtpk_n(wv[4] - hf[4], wv[5] - hf[5]); l4.w = att::cvtpk_n(wv[6] - hf[6], wv[7] - hf[7]);
    bhi = __builtin_bit_cast(bf16x8, h4); blo = __builtin_bit_cast(bf16x8, l4); biasd = ba[dcol];
}

__device__ __forceinline__ void passA(const Params& p, const bf16* Hb, float* SEG, float* LG, LAS unsigned char* lds, int bid, int G, int wave_u) {
    const int tid_l = tid_of(wave_u);
    const int tid = tid_l, lane = tid & 63, wid = __builtin_amdgcn_readfirstlane(tid >> 6), r32 = lane & 31, hh = lane >> 5;
    const int mb = wid >> 2, nb = wid & 3, q4 = (lane & 15) >> 2, pp4 = lane & 3, g1 = (lane >> 4) & 1;
    for (int si = bid; si < 512; si += G) {
        const int dir = si & 1, head = (si >> 1) & 3, sg = si >> 3;
        bf16x8 bhi, blo; float biasd; load_gate_b(bhi, blo, biasd, p, head, dir, tid);
        f32x16 S;
#pragma unroll
        for (int r = 0; r < 16; ++r) S[r] = 0.f;
        float lg = 0.f;
        ChunkRegs R;
        chunk_load<false>(R, Hb, (sg * SEGC + (dir ? SEGC - 1 : 0)) * 64, head, dir, tid);
        __syncthreads();
        stage_vlr(R, 0, lds, tid);
        __syncthreads();
        for (int n = 0; n < SEGC; ++n) {
            const ChunkRegs C = R; const int cur = n & 1;
            if (n + 1 < SEGC) chunk_load<false>(R, Hb, (sg * SEGC + (dir ? SEGC - 2 - n : n + 1)) * 64, head, dir, tid);
            lg += chunk_front<false>(C, R, n + 1 < SEGC, cur, dir, bhi, blo, biasd, lds, tid);
            state_update(S, mb, nb, cur ? L_V2 : L_V, lds, hh, q4, pp4, g1);
        }
        float* Up = SEG + (size_t)si * 8192;
#pragma unroll
        for (int r = 0; r < 16; ++r) Up[(32 * mb + crow(r, hh)) * 128 + 32 * nb + r32] = S[r];
        if (tid < 64) LG[si * 64 + tid] = lg;
    }
}
__device__ __forceinline__ void passB(float* SEG, const float* LG, int bid, int G, int wave_u) {
    const int tid_l = tid_of(wave_u);
    const int gt = bid * NTHREADS + tid_l, NTH = G * NTHREADS;
    for (int v = gt; v < 80 * 2048; v += NTH) {
        const int chain = v >> 11, e4 = v & 2047, dir = chain & 1, head = (chain >> 1) & 3, seq = chain >> 3;
        const int sg0 = seq < 2 ? seq * 16 : 32 + (seq - 2) * 4, ns = seq < 2 ? 16 : 4;
        f32x4 S = (f32x4){0.f, 0.f, 0.f, 0.f};
        for (int n = 0; n < ns; ++n) { const int si = ((sg0 + (dir ? ns - 1 - n : n)) * 4 + head) * 2 + dir;
            float* ptr = SEG + (size_t)si * 8192 + e4 * 4; const f32x4 u = *(const f32x4*)ptr; const float g = __builtin_amdgcn_exp2f(LG[si * 64 + (e4 >> 5)]);
            *(f32x4*)ptr = S; S = S * g + u; }
    }
}
__device__ __forceinline__ void passC(const Params& p, const bf16* Hb, const float* SEG, float* Z0, bf16* MIX, LAS unsigned char* lds, int bid, int G, int wave_u) {
    const int tid_l = tid_of(wave_u);
    const int tid = tid_l, lane = tid & 63, wid = __builtin_amdgcn_readfirstlane(tid >> 6), r32 = lane & 31, hh = lane >> 5;
    const int pb = wid >> 2, db = wid & 3, q4 = (lane & 15) >> 2, pp4 = lane & 3, g1 = (lane >> 4) & 1;
    for (int item = bid; item < 256; item += G) {
        const int head = item & 3, sg = item >> 2;
        for (int dir = 0; dir < 2; ++dir) {
            bf16x8 bhi, blo; float biasd; load_gate_b(bhi, blo, biasd, p, head, dir, tid);
            f32x16 S0, S1;
            { const float* Sp = SEG + (size_t)((sg * 4 + head) * 2 + dir) * 8192 + 32 * db + r32;
#pragma unroll
              for (int r = 0; r < 16; ++r) { S0[r] = Sp[crow(r, hh) * 128]; S1[r] = Sp[(32 + crow(r, hh)) * 128]; } }
            ChunkRegs R;
            chunk_load<true>(R, Hb, (sg * SEGC + (dir ? SEGC - 1 : 0)) * 64, head, dir, tid);
            __syncthreads();
            stage_vlr(R, 0, lds, tid);
            __syncthreads();
            for (int n = 0; n < SEGC; ++n) {
                const int rowbase = (sg * SEGC + (dir ? SEGC - 1 - n : n)) * 64;
                const ChunkRegs C = R; const int cur = n & 1; const int LV = cur ? L_V2 : L_V;
                if (n + 1 < SEGC) chunk_load<true>(R, Hb, (sg * SEGC + (dir ? SEGC - 2 - n : n + 1)) * 64, head, dir, tid);
                f32x16 Z;
                float* Zg = Z0 + (size_t)(rowbase + 32 * pb) * 512 + head * 128 + 32 * db + r32;
                if (dir == 0) {
#pragma unroll
                    for (int r = 0; r < 16; ++r) Z[r] = 0.f;
                } else {
#pragma unroll
                    for (int r = 0; r < 16; ++r) Z[r] = Zg[(size_t)crow(r, hh) * 512];
                }
                (void)chunk_front<true>(C, R, n + 1 < SEGC, cur, dir, bhi, blo, biasd, lds, tid);
                for (int mbp = 0; mbp < 2; ++mbp) {
                    if (dir == 0 ? (mbp > pb) : (mbp < pb)) continue;
                    f32x16 X;
#pragma unroll
                    for (int r = 0; r < 16; ++r) X[r] = 0.f;
#pragma unroll
                    for (int s = 0; s < 4; ++s) {
                        const bf16x8 a = *(LAS bf16x8*)(lds + L_KT + (32 * mbp + r32) * QSTR + (16 * s + 8 * hh) * 2);
                        const bf16x8 b = *(LAS bf16x8*)(lds + L_QT + (32 * pb + r32) * QSTR + (16 * s + 8 * hh) * 2);
                        X = __builtin_amdgcn_mfma_f32_32x32x16_bf16(a, b, X, 0, 0, 0);
                    }
#pragma unroll
                    for (int r = 0; r < 16; ++r) { const int pk = 32 * mbp + crow(r, hh), pq = 32 * pb + r32; const bool keep = dir == 0 ? (pk <= pq) : (pk >= pq); X[r] = keep ? X[r] : 0.f; }
#pragma unroll
                    for (int s2 = 0; s2 < 2; ++s2) {
                        u32x4 ww; ww.x = cvt_pk_bf16(X[8 * s2 + 0], X[8 * s2 + 1]); ww.y = cvt_pk_bf16(X[8 * s2 + 2], X[8 * s2 + 3]); ww.z = cvt_pk_bf16(X[8 * s2 + 4], X[8 * s2 + 5]); ww.w = cvt_pk_bf16(X[8 * s2 + 6], X[8 * s2 + 7]);
                        LAS unsigned char* vb = lds + LV + (32 * mbp + 16 * s2 + 4 * hh + q4) * VSTR + (32 * db + 16 * g1 + 4 * pp4) * 2;
                        const s16x4 lo = vtr(vb), hi = vtr(vb + 8 * VSTR);
                        Z = __builtin_amdgcn_mfma_f32_32x32x16_bf16(__builtin_bit_cast(bf16x8, ww), (bf16x8){lo[0], lo[1], lo[2], lo[3], hi[0], hi[1], hi[2], hi[3]}, Z, 0, 0, 0);
                    }
                }
#pragma unroll
                for (int mbs = 0; mbs < 2; ++mbs)
#pragma unroll
                    for (int s2 = 0; s2 < 2; ++s2) {
                        u32x4 ww;
                        if (mbs == 0) { ww.x = cvt_pk_bf16(S0[8 * s2 + 0], S0[8 * s2 + 1]); ww.y = cvt_pk_bf16(S0[8 * s2 + 2], S0[8 * s2 + 3]); ww.z = cvt_pk_bf16(S0[8 * s2 + 4], S0[8 * s2 + 5]); ww.w = cvt_pk_bf16(S0[8 * s2 + 6], S0[8 * s2 + 7]); }
                        else { ww.x = cvt_pk_bf16(S1[8 * s2 + 0], S1[8 * s2 + 1]); ww.y = cvt_pk_bf16(S1[8 * s2 + 2], S1[8 * s2 + 3]); ww.z = cvt_pk_bf16(S1[8 * s2 + 4], S1[8 * s2 + 5]); ww.w = cvt_pk_bf16(S1[8 * s2 + 6], S1[8 * s2 + 7]); }
                        LAS unsigned char* qa = lds + L_QT + (32 * pb + r32) * QSTR + (32 * mbs + 16 * s2 + 4 * hh) * 2;
                        const u32x2 alo = *(LAS u32x2*)qa, ahi = *(LAS u32x2*)(qa + 16);
                        const u32x4 aw = (u32x4){alo.x, alo.y, ahi.x, ahi.y};
                        Z = __builtin_amdgcn_mfma_f32_32x32x16_bf16(__builtin_bit_cast(bf16x8, aw), __builtin_bit_cast(bf16x8, ww), Z, 0, 0, 0);
                    }
                state_update(S0, 0, db, LV, lds, hh, q4, pp4, g1);
                state_update(S1, 1, db, LV, lds, hh, q4, pp4, g1);
                if (dir == 0) {
#pragma unroll
                    for (int r = 0; r < 16; ++r) Zg[(size_t)crow(r, hh) * 512] = Z[r];
                } else {
                    LAS float* Zl = (LAS float*)(lds + L_Z);
#pragma unroll
                    for (int r = 0; r < 16; ++r) Zl[(32 * pb + crow(r, hh)) * ZS + 32 * db + r32] = Z[r];
                    __syncthreads();
                    { const int pr = tid >> 3, dv0 = (tid & 7) * 16;
                      float v[16]; float ss = 0.f;
#pragma unroll
                      for (int i = 0; i < 16; ++i) { v[i] = Zl[pr * ZS + dv0 + i]; ss += v[i] * v[i]; }
                      ss += __shfl_xor(ss, 1); ss += __shfl_xor(ss, 2); ss += __shfl_xor(ss, 4);
                      const float rn = __builtin_amdgcn_rsqf(ss * (1.f / 128.f) + 1e-5f);
                      const bf16* grp_ = Hb + (size_t)(rowbase + pr) * LDH + O_GR + head * 128 + dv0;
                      const u32x4 g0 = *(const u32x4*)grp_, g1v = *(const u32x4*)(grp_ + 8);
                      const float* gn = p.in[13] + dv0;
                      float o[16];
#pragma unroll
                      for (int i = 0; i < 16; ++i) { const unsigned wv = (i < 8) ? g0[i >> 1] : g1v[(i - 8) >> 1]; const float gr = bf2f((i & 1) ? (wv >> 16) : (wv & 0xffffu));
                          const float sl = gr * __builtin_amdgcn_rcpf(1.f + fexp(-gr)); o[i] = v[i] * rn * gn[i] * sl; }
                      u32x4 a, b; a.x = cvt_pk_bf16(o[0], o[1]); a.y = cvt_pk_bf16(o[2], o[3]); a.z = cvt_pk_bf16(o[4], o[5]); a.w = cvt_pk_bf16(o[6], o[7]);
                      b.x = cvt_pk_bf16(o[8], o[9]); b.y = cvt_pk_bf16(o[10], o[11]); b.z = cvt_pk_bf16(o[12], o[13]); b.w = cvt_pk_bf16(o[14], o[15]);
                      bf16* orow = MIX + (size_t)(rowbase + pr) * D + 512 + head * 128 + dv0;
                      __builtin_nontemporal_store(a, (u32x4*)orow); __builtin_nontemporal_store(b, (u32x4*)(orow + 8)); }
                }
            }
        }
    }
}
}
__global__ void __launch_bounds__(NTHREADS) mega(Params p) {
    extern __shared__ __attribute__((aligned(16))) unsigned char lds_raw[];
    LAS unsigned char* lds = (LAS unsigned char*)lds_raw;
    cg::grid_group grid = cg::this_grid();
    const int tid = threadIdx.x, lane = tid & 63, wave = __builtin_amdgcn_readfirstlane(tid >> 6);
    const int G = gridDim.x, bid = blockIdx.x;
    unsigned char* ws = p.ws;
    bf16* WTin = (bf16*)(ws + WS_WIN); bf16* WTo = (bf16*)(ws + WS_WO); bf16* WT1 = (bf16*)(ws + WS_W1); bf16* WT2 = (bf16*)(ws + WS_W2);
    bf16* Hb = (bf16*)(ws + WS_H); bf16* XB = (bf16*)(ws + WS_XB); bf16* MIX = (bf16*)(ws + WS_MIX); bf16* X1B = (bf16*)(ws + WS_X1B); bf16* HID = (bf16*)(ws + WS_HID);
    float* ST = (float*)(ws + WS_ST); float* SEG = (float*)(ws + WS_ST + 128 * MiB); float* LG = (float*)(ws + WS_GG);
    unsigned* ctl = (unsigned*)(ws + WS_CTL);
    bf16* Y1B = (bf16*)p.out;
    bf16* Y2B = (bf16*)(ws + WS_MIX);
    bf16* KD = (bf16*)(ws + WS_KD); bf16* VD = (bf16*)(ws + WS_VD);
    const int lo = p.ph_lo, hi = p.ph_hi;
    volatile LAS unsigned* xst = (volatile LAS unsigned*)(lds + 160 * 1024 - 128);
    if (tid < 2) xst[tid] = 0u;
    __syncthreads();
    const XcdBarrier xbar = xcd_barrier_post(ctl + 1024, xst, wave);
    if (hi > 1000) grid.sync();
#ifndef R_P0
#define R_P0 1
#endif
#ifndef R_G1
#define R_G1 1
#endif
#ifndef R_G2
#define R_G2 1
#endif
#define IN(k) (lo <= (k) && (k) < hi)
#define SEAM(k) do { if (IN(k) && IN((k) + 1)) { xcd_barrier(xbar); } } while (0)
    const int gw = bid * NWAVES + wave, NGW = G * NWAVES;

for (int rp_ = 0; rp_ < R_P0; ++rp_) {     if (IN(0)) {
        if (bid == 0 && tid < 256) ctl[tid] = 0u;
        LAS float* scr = (LAS float*)(lds + wave * 16384);
        constexpr int I_IN = (D / 64) * (DIN / 32), I_O = (D / 64) * (D / 32), I_1 = (D / 64) * (FF / 32), I_2 = (FF / 64) * (D / 32);
        constexpr int NITEMS = I_IN + I_O + I_1 + I_2;
        for (int it = gw; it < NITEMS; it += NGW) {
            int r = it;
            if (r < I_IN) { p0_transpose_item(p.in[2], D, DIN, WTin, scr, r, lane); continue; } r -= I_IN;
            if (r < I_O) { p0_transpose_item(p.in[3], D, D, WTo, scr, r, lane); continue; } r -= I_O;
            if (r < I_1) { p0_transpose_item(p.in[16], D, FF, WT1, scr, r, lane); continue; } r -= I_1;
            p0_transpose_item(p.in[17], FF, D, WT2, scr, r, lane);
        }
        { u32x4* z = (u32x4*)(WTin + (size_t)DIN * D); const int nz = (DIN_PAD - DIN) * D * 2 / 16;
          for (int i = bid * NTHREADS + tid; i < nz; i += G * NTHREADS) z[i] = (u32x4){0u, 0u, 0u, 0u}; }
        { const int ln0 = tid_of(wave) & 63;
        for (int m = gw * 2; m < M; m += NGW * 2) {
            f32x4 v[2][4];
#pragma unroll
            for (int r = 0; r < 2; ++r) { const f32x4* xr = (const f32x4*)xrow_ptr(p, m + r) + ln0;
#pragma unroll
                for (int j = 0; j < 4; ++j) v[r][j] = __builtin_nontemporal_load(xr + 64 * j); }
#pragma unroll
            for (int r = 0; r < 2; ++r) { u32x2* o = (u32x2*)(XB + (size_t)(m + r) * D) + ln0;
#pragma unroll
                for (int j = 0; j < 4; ++j) { u32x2 w; w.x = cvt_pk_bf16(v[r][j].x, v[r][j].y); w.y = cvt_pk_bf16(v[r][j].z, v[r][j].w); o[64 * j] = w; } }
        } }
#if MIXER_STAGE < 1
        { u32x4* z = (u32x4*)MIX; const size_t nz = (size_t)M * D * 2 / 16;
          for (size_t i = (size_t)bid * NTHREADS + tid; i < nz; i += (size_t)G * NTHREADS) z[i] = (u32x4){0u, 0u, 0u, 0u}; }
#endif
    } }
    SEAM(0);
for (int rp_ = 0; rp_ < R_G1; ++rp_) {     if (IN(1)) {
#if MIXER_STAGE >= 1
        pg8::Gemm g{XB, WTin, M, DIN_PAD, D}; pg8::StaticOrder S; S.init(M, DIN_PAD, G, bid);
        pg8::EpiH E{Hb, LDH, DIN, C1, KD, VD};
        pg8::gemm_phase<pg8::EpiH, pg8::StaticOrder, true, true>(lds, g, S, E, wave);
#endif
    } }
    SEAM(1);
#ifndef GLA_REPS
#define GLA_REPS 1
#endif
#ifndef ATT_REPS
#define ATT_REPS 1
#endif
    for (int rep = 0; rep < GLA_REPS; ++rep) {
    if (IN(2)) {
#if MIXER_STAGE >= 1
        if (rep == 0) att::knorm_phase(KD, ctl, bid, G, wave);
#endif
#if MIXER_STAGE >= 2
        gla::passA(p, Hb, SEG, LG, lds, bid, G, wave);
#endif
    }
    SEAM(2);
    if (IN(3)) {
#if MIXER_STAGE >= 2
        gla::passB(SEG, LG, bid, G, wave);
#endif
    }
    SEAM(3);
    }
    if (IN(4)) {
#if MIXER_STAGE >= 2
        for (int rep = 0; rep < GLA_REPS; ++rep) gla::passC(p, Hb, SEG, ST, MIX, lds, bid, G, wave);
#endif
#if MIXER_STAGE >= 1
        att::attn_phase(p, Hb, KD, VD, MIX, ctl, lds, bid, G, wave);
#endif
    }
    SEAM(4);
for (int rp_ = 0; rp_ < R_G1; ++rp_) {     if (IN(5)) {
        pg8::Gemm g{MIX, WTo, M, D, D}; pg8::StaticOrder S; S.init(M, D, G, bid);
        pg8::EpiResB E{nullptr, nullptr, XB, Y1B, ALPHA, false};
        pg8::gemm_phase<pg8::EpiResB, pg8::StaticOrder, true, true>(lds, g, S, E, wave);
    } }
    SEAM(5);
for (int rp_ = 0; rp_ < R_P0; ++rp_) {     if (IN(6)) { const int ln_ = tid_of(wave) & 63; for (int m = gw * 4; m < M; m += NGW * 4) ln_rows4_b(Y1B + (size_t)m * D, nullptr, X1B + (size_t)m * D, p.in[14], p.in[15], ln_); } }
    SEAM(6);
for (int rp_ = 0; rp_ < R_G2; ++rp_) {     if (IN(7)) {
        pg8::Gemm g{X1B, WT1, M, FF, D}; pg8::StaticOrder S; S.init(M, FF, G, bid);
        pg8::EpiHid E{HID, FF};
        pg8::gemm_phase<pg8::EpiHid, pg8::StaticOrder, true, true>(lds, g, S, E, wave);
    } }
    SEAM(7);
for (int rp_ = 0; rp_ < R_G2; ++rp_) {     if (IN(8)) {
        pg8::Gemm g{HID, WT2, M, D, FF}; pg8::StaticOrder S; S.init(M, D, G, bid);
        pg8::EpiResB E{nullptr, nullptr, X1B, Y2B, ALPHA, true};
        pg8::gemm_phase<pg8::EpiResB, pg8::StaticOrder, true, true>(lds, g, S, E, wave);
    } }
    SEAM(8);
for (int rp_ = 0; rp_ < R_P0; ++rp_) {     if (IN(9)) { const int ln_ = tid_of(wave) & 63; for (int m = gw * 4; m < M; m += NGW * 4) ln_rows4_b(Y2B + (size_t)m * D, p.out + (size_t)m * D, nullptr, p.in[18], p.in[19], ln_); } }
#undef IN
#undef SEAM
}

extern "C" void kernel_launch(void* const* d_in, const int* in_sizes, int n_in, void* d_out, int out_size,
                              void* d_ws, size_t ws_size, hipStream_t stream) {
    static int grid = 0;
    if (grid == 0) {
        if (n_in != 20 || out_size != M * D || ws_size < WS_END) { fprintf(stderr, "kernel_launch: unexpected shapes (n_in %d out %d ws %zu)\n", n_in, out_size, ws_size); grid = -1; return; }
        int dev = 0, cus = 0, per_cu = 0;
        (void)hipGetDevice(&dev);
        (void)hipDeviceGetAttribute(&cus, hipDeviceAttributeMultiprocessorCount, dev);
        (void)hipFuncSetAttribute((const void*)mega, hipFuncAttributeMaxDynamicSharedMemorySize, LDS_BYTES);
        (void)hipOccupancyMaxActiveBlocksPerMultiprocessor(&per_cu, (const void*)mega, NTHREADS, LDS_BYTES);
        (void)hipGetLastError();
        grid = cus;
        fprintf(stderr, "kernel_launch: grid %d (cus %d, occupancy query %d/CU), ws %zu\n", grid, cus, per_cu, ws_size);
    }
    if (grid < 0) return;
    (void)hipMemsetAsync(d_ws, 0, 65536, stream);
    Params p{};
    for (int i = 0; i < 20; ++i) p.in[i] = (const float*)d_in[i];
    p.out = (float*)d_out; p.ws = (unsigned char*)d_ws; p.ph_lo = 0; p.ph_hi = 10;
    void* args[] = {&p};
    hipError_t e = hipLaunchCooperativeKernel((const void*)mega, dim3(grid), dim3(NTHREADS), args, LDS_BYTES, stream);
    if (e != hipSuccess) fprintf(stderr, "cooperative launch failed: %s\n", hipGetErrorString(e));
}
```
